# Optimizing an MI355X kernel written in HIP

```python
import math
import jax, jax.numpy as jnp
from jax import lax
import numpy as np

D_MODEL = 1024
BATCH = 2
SEQ = 8192
DEPTH = 2

SB_HEADS = 8
SB_HEAD_DIM = 64
SB_WIDTH = SB_HEADS * SB_HEAD_DIM
SB_BLOCK = 128
HG_HEADS = 4
HG_DK = 128
HG_DV = 128
HG_WIDTH_K = HG_HEADS * HG_DK
HG_WIDTH_V = HG_HEADS * HG_DV
HG_CHUNK = 64
HG_F_FLOOR = 1e-30
SSD_HEADS = 8
SSD_HEAD_DIM = 64
SSD_WIDTH = SSD_HEADS * SSD_HEAD_DIM
SSD_GROUPS = 2
SSD_STATE = 64
SSD_CONV = 4
SSD_CHUNK = 128
SSD_CONV_DIM = SSD_WIDTH + 2 * SSD_GROUPS * SSD_STATE
N_BRANCHES = 3
IN_SIZES = (SB_WIDTH, SB_WIDTH, SB_WIDTH,
            HG_WIDTH_K, HG_WIDTH_K, HG_WIDTH_V, HG_WIDTH_V,
            SSD_WIDTH, SSD_CONV_DIM, SSD_HEADS,
            D_MODEL, D_MODEL, D_MODEL)
IN_COLS = 3 * SB_WIDTH + 2 * HG_WIDTH_K + 2 * HG_WIDTH_V + SSD_WIDTH + SSD_CONV_DIM + SSD_HEADS + N_BRANCHES * D_MODEL
PEER_HEADS = 8
PEER_NKEYS = 128
PEER_EXPERTS = PEER_NKEYS * PEER_NKEYS
PEER_QDIM = 256
PEER_TOPK = 16
PEER_TOKEN_BLOCK = 128
EPS = 1e-6
NEG_BIG = -1e30

kernel_name = 'sb_hgrn2_ssd_peer_hybrid'


def rmsnorm(x, w):
    xf = x.astype(jnp.float32)
    y = xf * lax.rsqrt(jnp.mean(xf * xf, axis=-1, keepdims=True) + EPS)
    return (y * w.astype(jnp.float32)).astype(x.dtype)


def stick_breaking_attention(q, k, v):
    Bsz, S, H, Dh = q.shape
    nb = S // SB_BLOCK
    scale = Dh ** -0.5
    kf = k.astype(jnp.float32)
    vf = v.astype(jnp.float32)
    qb = q.astype(jnp.float32).reshape(Bsz, nb, SB_BLOCK, H, Dh).transpose(1, 0, 2, 3, 4)
    key_pos = jnp.arange(S)

    def block(args):
        q_blk, blk = args
        q_pos = blk * SB_BLOCK + jnp.arange(SB_BLOCK)
        z = jnp.einsum('bqhd,bkhd->bhqk', q_blk, kf) * scale
        before = key_pos[None, :] < q_pos[:, None]
        log_beta = jax.nn.log_sigmoid(z)
        log_rest = jnp.where(before, jax.nn.log_sigmoid(-z), 0.0)
        tail = lax.cumsum(log_rest, axis=3, reverse=True) - log_rest
        a = jnp.exp(jnp.where(before, log_beta + tail, NEG_BIG))
        return jnp.einsum('bhqk,bkhd->bqhd', a, vf)

    out = lax.map(block, (qb, jnp.arange(nb)))
    return out.transpose(1, 0, 2, 3, 4).reshape(Bsz, S, H * Dh).astype(q.dtype)


def hgrn2_mixer(q_raw, f_raw, i_raw, g_raw, lb, norm_w):
    Bsz, S, _ = q_raw.shape
    nc = S // HG_CHUNK
    f32 = jnp.float32
    lb = lb.astype(f32).reshape(HG_HEADS, HG_DK)
    f_logit = f_raw.astype(f32).reshape(Bsz, S, HG_HEADS, HG_DK)
    f = lb + (1.0 - lb) * jax.nn.sigmoid(f_logit)
    log_f = jnp.log(jnp.maximum(f, HG_F_FLOOR))
    key = (1.0 - lb) * jax.nn.sigmoid(-f_logit)
    q = jax.nn.silu(q_raw.astype(f32)).reshape(Bsz, S, HG_HEADS, HG_DK) * (HG_DK ** -0.5)
    val = i_raw.astype(f32).reshape(Bsz, S, HG_HEADS, HG_DV)

    def chunks(t):
        return t.reshape(Bsz, nc, HG_CHUNK, HG_HEADS, t.shape[-1]).transpose(1, 0, 3, 2, 4)

    causal = jnp.tril(jnp.ones((HG_CHUNK, HG_CHUNK), dtype=bool))

    def step(state, inp):
        qc, kc, vc, gc = inp
        b = jnp.cumsum(gc, axis=2)
        diff = b[:, :, :, None, :] - b[:, :, None, :, :]
        decay = jnp.exp(jnp.where(causal[:, :, None], diff, NEG_BIG))
        scores = jnp.einsum('bhtk,bhtsk,bhsk->bhts', qc, decay, kc)
        o = jnp.einsum('bhts,bhsv->bhtv', scores, vc) + jnp.einsum('bhtk,bhkv->bhtv', qc * jnp.exp(b), state)
        b_last = b[:, :, -1, :]
        new_state = jnp.exp(b_last)[..., None] * state + jnp.einsum('bhsk,bhsv->bhkv', kc * jnp.exp(b_last[:, :, None, :] - b), vc)
        return new_state, o

    state0 = jnp.zeros((Bsz, HG_HEADS, HG_DK, HG_DV), f32)
    _, o = lax.scan(step, state0, (chunks(q), chunks(key), chunks(val), chunks(log_f)))
    o = o.transpose(1, 0, 3, 2, 4).reshape(Bsz, S, HG_HEADS, HG_DV)
    gate = jax.nn.silu(g_raw.astype(f32)).reshape(Bsz, S, HG_HEADS, HG_DV)
    o = rmsnorm(o, norm_w) * gate
    return o.reshape(Bsz, S, HG_WIDTH_V).astype(q_raw.dtype)


def causal_depthwise_conv(x, w, b):
    K, C = w.shape
    y = lax.conv_general_dilated(x, w[:, None, :].astype(x.dtype), window_strides=(1,),
                                 padding=[(K - 1, 0)], dimension_numbers=('NWC', 'WIO', 'NWC'),
                                 feature_group_count=C)
    return y + b.astype(x.dtype)


def segsum(a):
    T = a.shape[-1]
    rep = jnp.broadcast_to(a[..., :, None], a.shape + (T,))
    rep = jnp.where(jnp.tril(jnp.ones((T, T), dtype=bool), -1), rep, 0.0)
    ss = jnp.cumsum(rep, axis=-2)
    return jnp.where(jnp.tril(jnp.ones((T, T), dtype=bool)), ss, NEG_BIG)


def ssd_chunked(x, a, b_h, c_h):
    Bsz, S, H, P = x.shape
    N = b_h.shape[-1]
    L = SSD_CHUNK
    nc = S // L
    x = x.reshape(Bsz, nc, L, H, P)
    b_h = b_h.reshape(Bsz, nc, L, H, N)
    c_h = c_h.reshape(Bsz, nc, L, H, N)
    a = a.reshape(Bsz, nc, L, H).transpose(0, 3, 1, 2)
    a_cum = jnp.cumsum(a, axis=-1)
    seg = jnp.exp(segsum(a))
    scores = jnp.einsum('bclhn,bcshn->bhcls', c_h, b_h) * seg
    y_diag = jnp.einsum('bhcls,bcshp->bclhp', scores, x)
    decay_states = jnp.exp(a_cum[..., -1:] - a_cum)
    states = jnp.einsum('bclhn,bhcl,bclhp->bchpn', b_h, decay_states, x)
    states = jnp.concatenate([jnp.zeros_like(states[:, :1]), states], axis=1)
    chunk_tot = jnp.pad(a_cum[..., -1], ((0, 0), (0, 0), (1, 0)))
    decay_chunk = jnp.exp(segsum(chunk_tot))
    states = jnp.einsum('bhzc,bchpn->bzhpn', decay_chunk, states)[:, :-1]
    y_off = jnp.einsum('bclhn,bchpn,bhcl->bclhp', c_h, states, jnp.exp(a_cum))
    return (y_diag + y_off).reshape(Bsz, S, H, P)


def ssd_mixer(z, xbc, dt_raw, conv_w, conv_b, dt_bias, a_log, d_skip, norm_w):
    Bsz, S, _ = z.shape
    f32 = jnp.float32
    xbc = jax.nn.silu(causal_depthwise_conv(xbc, conv_w, conv_b))
    xs, b_in, c_in = jnp.split(xbc, [SSD_WIDTH, SSD_WIDTH + SSD_GROUPS * SSD_STATE], axis=-1)
    rep = SSD_HEADS // SSD_GROUPS
    xs = xs.astype(f32).reshape(Bsz, S, SSD_HEADS, SSD_HEAD_DIM)
    b_h = jnp.repeat(b_in.astype(f32).reshape(Bsz, S, SSD_GROUPS, SSD_STATE), rep, axis=2)
    c_h = jnp.repeat(c_in.astype(f32).reshape(Bsz, S, SSD_GROUPS, SSD_STATE), rep, axis=2)
    dt = jax.nn.softplus(dt_raw.astype(f32) + dt_bias.astype(f32))
    a = -jnp.exp(a_log.astype(f32)) * dt
    y = ssd_chunked(xs * dt[..., None], a, b_h, c_h)
    y = y + d_skip.astype(f32)[:, None] * xs
    y = y.reshape(Bsz, S, SSD_WIDTH) * jax.nn.silu(z.astype(f32))
    y = rmsnorm(y.reshape(Bsz, S, SSD_GROUPS, SSD_WIDTH // SSD_GROUPS), norm_w.reshape(SSD_GROUPS, -1))
    return y.reshape(Bsz, S, SSD_WIDTH).astype(z.dtype)


def hybrid_mixer(h, lb, w_in, hg_norm_w, conv_w, conv_b, dt_bias, a_log, d_skip, ssd_norm_w,
                 w_branch_sb, w_branch_hg, w_branch_ssd, w_out):
    Bsz, S, _ = h.shape
    proj = h @ w_in
    points = [int(p) for p in np.cumsum(IN_SIZES)[:-1]]
    (sb_q, sb_k, sb_v, hg_f, hg_q, hg_i, hg_g, ssd_z, ssd_xbc, ssd_dt,
     gate_sb, gate_hg, gate_ssd) = jnp.split(proj, points, axis=-1)
    heads = lambda t: t.reshape(Bsz, S, SB_HEADS, SB_HEAD_DIM)
    y_sb = stick_breaking_attention(heads(sb_q), heads(sb_k), heads(sb_v))
    y_hg = hgrn2_mixer(hg_q, hg_f, hg_i, hg_g, lb, hg_norm_w)
    y_ssd = ssd_mixer(ssd_z, ssd_xbc, ssd_dt, conv_w, conv_b, dt_bias, a_log, d_skip, ssd_norm_w)
    merged = (jax.nn.sigmoid(gate_sb) * (y_sb @ w_branch_sb)
              + jax.nn.sigmoid(gate_hg) * (y_hg @ w_branch_hg)
              + jax.nn.sigmoid(gate_ssd) * (y_ssd @ w_branch_ssd))
    return merged @ w_out


def peer_ffn(x, w_q, sub_keys, u, v):
    Bsz, S, D = x.shape
    T = Bsz * S
    xt = x.reshape(T, D)
    q = (xt @ w_q).reshape(T, PEER_HEADS, 2, PEER_QDIM // 2)
    s = jnp.einsum('thpd,hpkd->thpk', q, sub_keys).astype(jnp.float32)
    s1, i1 = lax.top_k(s[:, :, 0], PEER_TOPK)
    s2, i2 = lax.top_k(s[:, :, 1], PEER_TOPK)
    cand_s = (s1[..., :, None] + s2[..., None, :]).reshape(T, PEER_HEADS, PEER_TOPK * PEER_TOPK)
    cand_i = (i1[..., :, None] * PEER_NKEYS + i2[..., None, :]).reshape(T, PEER_HEADS, PEER_TOPK * PEER_TOPK)
    top_s, pos = lax.top_k(cand_s, PEER_TOPK)
    expert_idx = jnp.take_along_axis(cand_i, pos, axis=-1)
    gates = jax.nn.softmax(top_s, axis=-1)
    nb = T // PEER_TOKEN_BLOCK
    HK = PEER_HEADS * PEER_TOPK

    def block(args):
        xb, idx, g = args
        ub = u[idx]
        vb = v[idx]
        act = jax.nn.gelu(jnp.einsum('td,tjd->tj', xb, ub).astype(jnp.float32), approximate=False)
        return jnp.einsum('tj,tjd->td', (g * act).astype(xb.dtype), vb)

    out = lax.map(block, (xt.reshape(nb, PEER_TOKEN_BLOCK, D),
                          expert_idx.reshape(nb, PEER_TOKEN_BLOCK, HK),
                          gates.reshape(nb, PEER_TOKEN_BLOCK, HK)))
    return out.reshape(Bsz, S, D)


def setup_inputs(seed: int = 0) -> dict:
    key = jax.random.key(seed)
    ks = jax.random.split(key, 24)
    f32 = jnp.float32
    nrm = lambda k, shape, scale: jax.random.normal(k, shape, f32) * scale
    dt = jnp.exp(jax.random.uniform(ks[7], (DEPTH, SSD_HEADS), f32, math.log(1e-3), math.log(1e-1)))
    return {
        'x': jax.random.normal(ks[0], (BATCH, SEQ, D_MODEL), f32),
        'norm1_w': 1.0 + nrm(ks[1], (DEPTH, D_MODEL), 0.02),
        'w_in': nrm(ks[2], (DEPTH, D_MODEL, IN_COLS), D_MODEL ** -0.5),
        'hg_lb_logits': nrm(ks[3], (DEPTH, HG_WIDTH_K), 1.0),
        'hg_norm_w': 1.0 + nrm(ks[4], (DEPTH, HG_DV), 0.02),
        'ssd_conv_w': nrm(ks[5], (DEPTH, SSD_CONV, SSD_CONV_DIM), SSD_CONV ** -0.5),
        'ssd_conv_b': nrm(ks[6], (DEPTH, SSD_CONV_DIM), 0.02),
        'ssd_dt_bias': dt + jnp.log(-jnp.expm1(-dt)),
        'ssd_a_log': jnp.log(jax.random.uniform(ks[8], (DEPTH, SSD_HEADS), f32, 1.0, 16.0)),
        'ssd_d': 1.0 + nrm(ks[9], (DEPTH, SSD_HEADS), 0.1),
        'ssd_norm_w': 1.0 + nrm(ks[10], (DEPTH, SSD_WIDTH), 0.02),
        'w_branch_sb': nrm(ks[11], (DEPTH, SB_WIDTH, D_MODEL), SB_WIDTH ** -0.5),
        'w_branch_hg': nrm(ks[12], (DEPTH, HG_WIDTH_V, D_MODEL), HG_WIDTH_V ** -0.5),
        'w_branch_ssd': nrm(ks[13], (DEPTH, SSD_WIDTH, D_MODEL), SSD_WIDTH ** -0.5),
        'w_out': nrm(ks[14], (DEPTH, D_MODEL, D_MODEL), D_MODEL ** -0.5),
        'norm2_w': 1.0 + nrm(ks[15], (DEPTH, D_MODEL), 0.02),
        'peer_w_q': nrm(ks[16], (DEPTH, D_MODEL, PEER_HEADS * PEER_QDIM), D_MODEL ** -0.5),
        'peer_sub_keys': nrm(ks[17], (DEPTH, PEER_HEADS, 2, PEER_NKEYS, PEER_QDIM // 2), (PEER_QDIM // 2) ** -0.5),
        'peer_u': nrm(ks[18], (DEPTH, PEER_EXPERTS, D_MODEL), D_MODEL ** -0.5),
        'peer_v': nrm(ks[19], (DEPTH, PEER_EXPERTS, D_MODEL), PEER_HEADS ** -0.5),
        'final_norm_w': 1.0 + nrm(ks[20], (D_MODEL,), 0.02),
    }


def reference(x, norm1_w, w_in, hg_lb_logits, hg_norm_w, ssd_conv_w, ssd_conv_b, ssd_dt_bias,
              ssd_a_log, ssd_d, ssd_norm_w, w_branch_sb, w_branch_hg, w_branch_ssd, w_out,
              norm2_w, peer_w_q, peer_sub_keys, peer_u, peer_v, final_norm_w):
    gamma = jax.nn.softmax(hg_lb_logits.astype(jnp.float32), axis=0)
    lower_bounds = jnp.cumsum(gamma, axis=0) - gamma[0]
    for l in range(DEPTH):
        h = rmsnorm(x, norm1_w[l])
        x = x + hybrid_mixer(h, lower_bounds[l], w_in[l], hg_norm_w[l], ssd_conv_w[l], ssd_conv_b[l],
                             ssd_dt_bias[l], ssd_a_log[l], ssd_d[l], ssd_norm_w[l],
                             w_branch_sb[l], w_branch_hg[l], w_branch_ssd[l], w_out[l])
        h = rmsnorm(x, norm2_w[l])
        x = x + peer_ffn(h, peer_w_q[l], peer_sub_keys[l], peer_u[l], peer_v[l])
    return rmsnorm(x, final_norm_w)
```

```cpp
#include <hip/hip_runtime.h>
#include <hip/hip_cooperative_groups.h>
#include <cstdio>
#include <cstdint>
namespace cg = cooperative_groups;

#ifndef MK_N_LAUNCHES
#define MK_N_LAUNCHES 1
#endif
#ifndef MK_BARRIER
#define MK_BARRIER 0
#endif

constexpr int TT = 16384;
constexpr int SEQ = 8192;
constexpr int DM = 1024;
constexpr int NP = 7936;
constexpr int C_SBQ = 0, C_SBK = 512, C_SBV = 1024, C_HGF = 1536, C_HGQ = 2048, C_HGI = 2560, C_HGG = 3072, C_SSDZ = 3584, C_XBC = 4096, C_GATE = 4864;
constexpr int W_IN_COLS = 7944, W_DT_COL = 4864, W_GATE_COL = 4872;
constexpr float EPS = 1e-6f;

constexpr size_t MiB = 1u << 20;
constexpr size_t WS_CTL = 0, CTL_ZERO_BYTES = 1 * MiB;
constexpr size_t WS_WIN = 2 * MiB;
constexpr size_t WS_WBR = 34 * MiB;
constexpr size_t WS_WOUT = 40 * MiB;
constexpr size_t WS_WEFF = 44 * MiB;
constexpr size_t WS_XN = 64 * MiB;
constexpr size_t WS_PROJ = 96 * MiB;
constexpr size_t WS_ST = 96 * MiB;
constexpr size_t WS_U16 = 224 * MiB, WS_V16 = 256 * MiB;
constexpr size_t WS_Y = 344 * MiB;
constexpr size_t WS_QT = 392 * MiB;
constexpr size_t WS_OI = 408 * MiB;
constexpr size_t WS_HGS = 424 * MiB;
constexpr size_t WS_CE = 456 * MiB;
constexpr size_t WS_YD = 472 * MiB;
constexpr size_t WS_SSDS = 488 * MiB;
constexpr size_t WS_DT = 496 * MiB;
constexpr size_t WS_DCH = 497 * MiB;
constexpr size_t WS_ATOT = 498 * MiB;
constexpr size_t WS_END = 499 * MiB;

constexpr int RING_BYTES = 131072;
constexpr int LDSCTL_OFF = 143360, MISC_OFF = LDSCTL_OFF + 320;
constexpr int LDS_BYTES = 147456;
constexpr int NWAVES = 8;

#define GAS __attribute__((address_space(1)))
#define LAS __attribute__((address_space(3)))
typedef unsigned short bf16;
typedef unsigned v4u __attribute__((ext_vector_type(4)));
typedef unsigned v2u __attribute__((ext_vector_type(2)));
typedef float f32x4 __attribute__((ext_vector_type(4)));
typedef float f32x2 __attribute__((ext_vector_type(2)));
typedef float f32x16 __attribute__((ext_vector_type(16)));
typedef short bf16x8 __attribute__((ext_vector_type(8)));
typedef short bf16x4 __attribute__((ext_vector_type(4)));
typedef GAS unsigned gu32;
typedef GAS unsigned long long gu64;
#define RLX_AGENT __ATOMIC_RELAXED, __HIP_MEMORY_SCOPE_AGENT
#define LDS_WAIT() asm volatile("s_waitcnt lgkmcnt(0)" ::: "memory")
#define VM_WAIT() asm volatile("s_waitcnt vmcnt(0)" ::: "memory")
__device__ __forceinline__ unsigned f2bf(float f) { unsigned u = __builtin_bit_cast(unsigned, f); return (u + 0x7fffu + ((u >> 16) & 1u)) >> 16; }
__device__ __forceinline__ unsigned pk2(float lo, float hi) { return f2bf(lo) | (f2bf(hi) << 16); }
__device__ __forceinline__ float bf2f(unsigned short v) { return __builtin_bit_cast(float, (unsigned)v << 16); }
__device__ __forceinline__ float bflo(unsigned w) { return __builtin_bit_cast(float, w << 16); }
__device__ __forceinline__ float bfhi(unsigned w) { return __builtin_bit_cast(float, w & 0xffff0000u); }
__device__ __forceinline__ float fexp(float x) { return __builtin_amdgcn_exp2f(x * 1.4426950408889634f); }
__device__ __forceinline__ float frcp(float x) { return __builtin_amdgcn_rcpf(x); }
__device__ __forceinline__ float sigmoidf_(float x) { const float e = fexp(-fabsf(x)), r = frcp(1.f + e); return x >= 0.f ? r : e * r; }
__device__ __forceinline__ float siluf_(float x) { return x * sigmoidf_(x); }
__device__ __forceinline__ bf16x8 pack8(const float* v) { v4u w; w.x = pk2(v[0], v[1]); w.y = pk2(v[2], v[3]); w.z = pk2(v[4], v[5]); w.w = pk2(v[6], v[7]); return __builtin_bit_cast(bf16x8, w); }
__device__ __forceinline__ void unpack8(v4u w, float* v) { v[0] = bflo(w.x); v[1] = bfhi(w.x); v[2] = bflo(w.y); v[3] = bfhi(w.y); v[4] = bflo(w.z); v[5] = bfhi(w.z); v[6] = bflo(w.w); v[7] = bfhi(w.w); }
__device__ __forceinline__ float wave_sum(float v) {
#pragma unroll
    for (int o = 1; o < 64; o <<= 1) v += __shfl_xor(v, o);
    return v;
}
#define MFMA16(a, b, c) __builtin_amdgcn_mfma_f32_16x16x32_bf16((a), (b), (c), 0, 0, 0)
#define MFMA32(a, b, c) __builtin_amdgcn_mfma_f32_32x32x16_bf16((a), (b), (c), 0, 0, 0)
namespace pg8 {
#define PG8_LAS __attribute__((address_space(3)))
typedef unsigned short bf16_t;
typedef short bf16x8 __attribute__((ext_vector_type(8)));
typedef float f32x4 __attribute__((ext_vector_type(4)));
typedef unsigned u32x4 __attribute__((ext_vector_type(4)));
constexpr int BM = 256, BK = 64, HALF = 128, HTB = HALF * BK * 2  , STAGE_BYTES = 8 * HTB, NXCD = 8, WGM = 8;

__host__ __device__ __forceinline__ int lds_byte(int r, int c) { const int st = (r >> 4) * 2 + (c >> 5), rr = r & 15, cc = c & 31, ob = rr * 64 + cc * 2; return st * 1024 + (ob ^ (((ob >> 9) & 1) << 5)); }
__host__ __device__ __forceinline__ void stage_rc(int b, int& R, int& C) { const int st = b / 1024, sb = b % 1024, swz = sb ^ (((sb >> 9) & 1) << 5); R = (st >> 1) * 16 + swz / 64; C = (st & 1) * 32 + (swz % 64) / 2; }
__host__ __device__ __forceinline__ int perm32(int rho) { const int n = rho >> 4, i = rho & 15; return 8 * (i >> 2) + 4 * n + (i & 3); }

struct Unit { int pm, pn; };
struct Gemm { const bf16_t* A; const bf16_t* Bt; int M, N, K; };

struct StaticOrder {
    int nM, nN, nwg, G, c;
    __host__ __device__ void init(int M, int N, int G_, int c_) { nM = M / BM; nN = N / BM; nwg = nM * nN; G = G_; c = c_; }
    __host__ __device__ bool next(int i, Unit& u) const {
        const long L = (long)i * G + c; if (L >= nwg) return false;
        int wgid = (int)L; { const int q = nwg / NXCD, r = nwg % NXCD, xcd = wgid % NXCD, off = wgid / NXCD; wgid = (xcd < r ? xcd * (q + 1) : r * (q + 1) + (xcd - r) * q) + off; }
        const int nig = WGM * nN, gid = wgid / nig, fm = gid * WGM, gsz = (nM - fm) < WGM ? (nM - fm) : WGM;
        u.pm = fm + ((wgid % nig) % gsz); u.pn = (wgid % nig) / gsz; return true;
    }
    __device__ __forceinline__ void a_ready(const Unit&) const {}
    __device__ __forceinline__ void done(const Unit&) const {}
};

__device__ __forceinline__ unsigned cvt_pk_bf16(float lo, float hi) { unsigned r; asm volatile("v_cvt_pk_bf16_f32 %0, %1, %2" : "=v"(r) : "v"(lo), "v"(hi)); return r; }
typedef float f32x2 __attribute__((ext_vector_type(2)));
typedef unsigned u32x2 __attribute__((ext_vector_type(2)));
struct EpiBf16 {
    static constexpr bool PERM = true, AFTER_DRAIN = false;
    bf16_t* O; int ldc;
    __device__ __forceinline__ void operator()(const f32x4 (&acc)[2][2][4][2], const Unit& u, int wr, int wc, int fr, int fq) const {
        const int row0 = u.pm * BM + wr * 64 + fr; const int col0 = u.pn * BM + wc * 32 + 8 * fq;
#pragma unroll
        for (int ai = 0; ai < 2; ++ai)
#pragma unroll
            for (int m = 0; m < 4; ++m) { bf16_t* rowp = O + (size_t)(row0 + ai * HALF + m * 16) * ldc + col0;
#pragma unroll
                for (int bj = 0; bj < 2; ++bj) { const f32x4 v0 = acc[ai][bj][m][0], v1 = acc[ai][bj][m][1];
                    u32x4 w; w.x = cvt_pk_bf16(v0[0], v0[1]); w.y = cvt_pk_bf16(v0[2], v0[3]); w.z = cvt_pk_bf16(v1[0], v1[1]); w.w = cvt_pk_bf16(v1[2], v1[3]);
                    *(u32x4*)(rowp + bj * HALF) = w; } }
    }
};
struct EpiF32 {
    static constexpr bool PERM = false, AFTER_DRAIN = false;
    float* C; int ldc;
    __device__ __forceinline__ void operator()(const f32x4 (&acc)[2][2][4][2], const Unit& u, int wr, int wc, int fr, int fq) const {
        const int row0 = u.pm * BM + wr * 64 + fr, col0 = u.pn * BM + wc * 32 + 4 * fq;
#pragma unroll
        for (int ai = 0; ai < 2; ++ai)
#pragma unroll
            for (int m = 0; m < 4; ++m) { float* rowp = C + (size_t)(row0 + ai * HALF + m * 16) * ldc + col0;
#pragma unroll
                for (int bj = 0; bj < 2; ++bj)
#pragma unroll
                    for (int n = 0; n < 2; ++n) *(f32x4*)(rowp + bj * HALF + n * 16) = acc[ai][bj][m][n]; }
    }
};
struct EpiResF32 {
    static constexpr bool PERM = false, AFTER_DRAIN = false;
    float* C; int ldc;
    __device__ __forceinline__ void operator()(const f32x4 (&acc)[2][2][4][2], const Unit& u, int wr, int wc, int fr, int fq) const {
        const int row0 = u.pm * BM + wr * 64 + fr, col0 = u.pn * BM + wc * 32 + 4 * fq;
#pragma unroll
        for (int ai = 0; ai < 2; ++ai)
#pragma unroll
            for (int m = 0; m < 4; ++m) { float* rowp = C + (size_t)(row0 + ai * HALF + m * 16) * ldc + col0;
                f32x4 old[2][2];
#pragma unroll
                for (int bj = 0; bj < 2; ++bj)
#pragma unroll
                    for (int n = 0; n < 2; ++n) old[bj][n] = *(const f32x4*)(rowp + bj * HALF + n * 16);
#pragma unroll
                for (int bj = 0; bj < 2; ++bj)
#pragma unroll
                    for (int n = 0; n < 2; ++n) *(f32x4*)(rowp + bj * HALF + n * 16) = old[bj][n] + acc[ai][bj][m][n]; }
    }
};
struct EpiMerge {
    static constexpr bool PERM = true, AFTER_DRAIN = false;
    const bf16_t* gate; int ldg;
    bf16_t* O; int ldc;
    __device__ __forceinline__ void operator()(const f32x4 (&acc)[2][2][4][2], const Unit& u, int wr, int wc, int fr, int fq) const {
        const int br = u.pm >> 6, pm = u.pm & 63, pn = u.pn & 3;
        const int row0 = pm * BM + wr * 64 + fr, col0 = pn * BM + wc * 32 + 8 * fq;
#pragma unroll
        for (int ai = 0; ai < 2; ++ai)
#pragma unroll
            for (int m = 0; m < 4; ++m) { const size_t row = (size_t)(row0 + ai * HALF + m * 16);
#pragma unroll
                for (int bj = 0; bj < 2; ++bj) { const int col = col0 + bj * HALF;
                    const u32x4 gw = *(const u32x4*)(gate + row * ldg + br * 1024 + col);
                    float v[8] = {acc[ai][bj][m][0][0], acc[ai][bj][m][0][1], acc[ai][bj][m][0][2], acc[ai][bj][m][0][3], acc[ai][bj][m][1][0], acc[ai][bj][m][1][1], acc[ai][bj][m][1][2], acc[ai][bj][m][1][3]};
                    float g[8]; { g[0] = __builtin_bit_cast(float, gw.x << 16); g[1] = __builtin_bit_cast(float, gw.x & 0xffff0000u); g[2] = __builtin_bit_cast(float, gw.y << 16); g[3] = __builtin_bit_cast(float, gw.y & 0xffff0000u);
                                  g[4] = __builtin_bit_cast(float, gw.z << 16); g[5] = __builtin_bit_cast(float, gw.z & 0xffff0000u); g[6] = __builtin_bit_cast(float, gw.w << 16); g[7] = __builtin_bit_cast(float, gw.w & 0xffff0000u); }
#pragma unroll
                    for (int j = 0; j < 8; ++j) { const float e = __builtin_amdgcn_exp2f(-fabsf(g[j]) * 1.4426950408889634f), r = __builtin_amdgcn_rcpf(1.f + e); v[j] *= (g[j] >= 0.f ? r : e * r); }
                    bf16_t* op = O + row * ldc + col;
                    if (br != 0) { const u32x4 ow = *(const u32x4*)op;
                        v[0] += __builtin_bit_cast(float, ow.x << 16); v[1] += __builtin_bit_cast(float, ow.x & 0xffff0000u); v[2] += __builtin_bit_cast(float, ow.y << 16); v[3] += __builtin_bit_cast(float, ow.y & 0xffff0000u);
                        v[4] += __builtin_bit_cast(float, ow.z << 16); v[5] += __builtin_bit_cast(float, ow.z & 0xffff0000u); v[6] += __builtin_bit_cast(float, ow.w << 16); v[7] += __builtin_bit_cast(float, ow.w & 0xffff0000u); }
                    u32x4 w; w.x = cvt_pk_bf16(v[0], v[1]); w.y = cvt_pk_bf16(v[2], v[3]); w.z = cvt_pk_bf16(v[4], v[5]); w.w = cvt_pk_bf16(v[6], v[7]);
                    *(u32x4*)op = w; } }
    }
};
struct MergeOrder {
    int v, G;
    __device__ __forceinline__ bool next(int i, Unit& u) const { const int bi = i / 3, br = i - bi * 3; const long L = (long)bi * G + v; if (L >= 256) return false;
        u.pm = br * 64 + (int)(L >> 2); u.pn = br * 4 + (int)(L & 3); return true; }
    __device__ __forceinline__ void a_ready(const Unit&) const {}
    __device__ __forceinline__ void done(const Unit&) const {}
};
template <class Epi, class Sched, bool ALIGN_EPI = false, bool SP2 = false>
__device__ __forceinline__ void gemm_phase(PG8_LAS unsigned char* lds, const Gemm g, const Sched& S, const Epi& E) {
    int tid_ = threadIdx.x; asm volatile("" : "+v"(tid_)); const int tid = tid_, wid = __builtin_amdgcn_readfirstlane(tid >> 6), lane = tid & 63, wr = wid >> 2, wc = wid & 3, fr = lane & 15, fq = lane >> 4;
    const int K = g.K, nt = K / BK;
    unsigned voffA[2], voffB[2];
#pragma unroll
    for (int i = 0; i < 2; ++i) { int R, C; stage_rc(tid * 16 + i * 8192, R, C); const int Rb = Epi::PERM ? ((R & ~31) + perm32(R & 31)) : R;
        voffA[i] = (unsigned)(R * K + C) * 2u; voffB[i] = (unsigned)(Rb * K + C) * 2u; }
    const size_t kstep = (size_t)(BK * 2);
    const size_t hstep = (size_t)HALF * K * 2;
    const size_t tstep = 2 * hstep;
    const unsigned ldsw = (unsigned)wid * 1024u;
    const int aoff = lds_byte(wr * 64 + fr, fq * 8), boff = lds_byte(wc * 32 + fr, fq * 8);
#define PG8_SA(b, h) (((b) * 2 + (h)) * HTB)
#define PG8_SB(b, h) ((4 + (b) * 2 + (h)) * HTB)
#define PG8_STAGE(bufoff, gbase, voff) do { _Pragma("unroll") for (int _i = 0; _i < 2; ++_i) \
        __builtin_amdgcn_global_load_lds((const unsigned*)((const char*)(gbase) + (voff)[_i]), (PG8_LAS unsigned*)(lds + (bufoff) + ldsw + _i * 8192), 16, 0, 0); } while (0)
#define PG8_LDA(dst, b, h) do { _Pragma("unroll") for (int m = 0; m < 4; ++m) _Pragma("unroll") for (int k = 0; k < 2; ++k) dst[m][k] = *(const PG8_LAS bf16x8*)(lds + PG8_SA(b, h) + aoff + m * 2048 + k * 1024); } while (0)
#define PG8_LDB(dst, b, h) do { _Pragma("unroll") for (int n = 0; n < 2; ++n) _Pragma("unroll") for (int k = 0; k < 2; ++k) dst[n][k] = *(const PG8_LAS bf16x8*)(lds + PG8_SB(b, h) + boff + n * 2048 + k * 1024); } while (0)
#define PG8_MMA(ai, bj, At, Bt) do { __builtin_amdgcn_s_setprio(1); _Pragma("unroll") for (int m = 0; m < 4; ++m) _Pragma("unroll") for (int n = 0; n < 2; ++n) _Pragma("unroll") for (int k = 0; k < 2; ++k) \
        acc[ai][bj][m][n] = __builtin_amdgcn_mfma_f32_16x16x32_bf16(Bt[n][k], At[m][k], acc[ai][bj][m][n], 0, 0, 0); __builtin_amdgcn_s_setprio(0); } while (0)
#define PG8_WAIT_V(n) asm volatile("s_waitcnt vmcnt(" #n ")" ::: "memory")
#define PG8_WAIT_L(n) asm volatile("s_waitcnt lgkmcnt(" #n ")" ::: "memory")
#define PG8_BAR __builtin_amdgcn_s_barrier()
#define PG8_SCHED __builtin_amdgcn_sched_barrier(0)
    Unit cur, nxt; int ui = 0;
    if (!S.next(0, cur)) return;
    f32x4 acc[2][2][4][2];
#pragma unroll
    for (int a = 0; a < 2; ++a)
#pragma unroll
        for (int b = 0; b < 2; ++b)
#pragma unroll
            for (int m = 0; m < 4; ++m)
#pragma unroll
                for (int n = 0; n < 2; ++n) acc[a][b][m][n] = (f32x4){0.f, 0.f, 0.f, 0.f};
    bf16x8 At[4][2], B0[2][2], B1[2][2];
    const char* cA = (const char*)g.A + (size_t)cur.pm * tstep; const char* cB = (const char*)g.Bt + (size_t)cur.pn * tstep;
    S.a_ready(cur);
    if constexpr (SP2) {
        PG8_STAGE(PG8_SB(0, 0), cB, voffB); PG8_STAGE(PG8_SB(0, 1), cB + hstep, voffB); PG8_STAGE(PG8_SA(0, 0), cA, voffA); PG8_STAGE(PG8_SA(0, 1), cA + hstep, voffA);
        if (wr == 1) PG8_BAR;
        PG8_WAIT_V(2); PG8_BAR;
        PG8_STAGE(PG8_SB(1, 0), cB + kstep, voffB); PG8_STAGE(PG8_SA(1, 0), cA + kstep, voffA); PG8_STAGE(PG8_SB(1, 1), cB + hstep + kstep, voffB);
        PG8_WAIT_V(6); PG8_BAR;
    } else {
        PG8_STAGE(PG8_SB(0, 0), cB, voffB); PG8_STAGE(PG8_SA(0, 0), cA, voffA); PG8_STAGE(PG8_SB(0, 1), cB + hstep, voffB); PG8_STAGE(PG8_SA(0, 1), cA + hstep, voffA);
        if (wr == 1) PG8_BAR;
        PG8_WAIT_V(4); PG8_BAR;
        PG8_STAGE(PG8_SB(1, 0), cB + kstep, voffB); PG8_STAGE(PG8_SA(1, 0), cA + kstep, voffA); PG8_STAGE(PG8_SB(1, 1), cB + hstep + kstep, voffB);
        PG8_WAIT_V(6); PG8_BAR;
    }
    for (;;) {
        const bool has_next = S.next(ui + 1, nxt);
        const char* nA = has_next ? (const char*)g.A + (size_t)nxt.pm * tstep : cA; const char* nB = has_next ? (const char*)g.Bt + (size_t)nxt.pn * tstep : cB;
        for (int t = 0; t < nt; t += 2) {
            const bool last = (t == nt - 2);
            const char* a1 = cA + (size_t)(t + 1) * kstep;
            const char* a2 = last ? nA : cA + (size_t)(t + 2) * kstep; const char* b2 = last ? nB : cB + (size_t)(t + 2) * kstep;
            const char* a3 = a2 + kstep; const char* b3 = b2 + kstep;
            if (last && has_next) S.a_ready(nxt);
            if constexpr (SP2) {
            PG8_LDB(B0, 0, 0); PG8_LDB(B1, 0, 1); PG8_SCHED; PG8_LDA(At, 0, 0); PG8_STAGE(PG8_SA(1, 1), a1 + hstep, voffA);
            PG8_WAIT_V(8); PG8_WAIT_L(0); PG8_BAR; PG8_MMA(0, 0, At, B0); PG8_MMA(0, 1, At, B1); PG8_BAR; PG8_SCHED;
            PG8_LDA(At, 0, 1); PG8_STAGE(PG8_SB(0, 0), b2, voffB); PG8_STAGE(PG8_SB(0, 1), b2 + hstep, voffB); PG8_STAGE(PG8_SA(0, 0), a2, voffA);
            PG8_WAIT_V(8); PG8_WAIT_L(0); PG8_BAR; PG8_MMA(1, 0, At, B0); PG8_MMA(1, 1, At, B1); PG8_BAR; PG8_SCHED;
            PG8_LDB(B0, 1, 0); PG8_LDB(B1, 1, 1); PG8_SCHED; PG8_LDA(At, 1, 0); PG8_STAGE(PG8_SA(0, 1), a2 + hstep, voffA);
            PG8_WAIT_V(8); PG8_WAIT_L(0); PG8_BAR; PG8_MMA(0, 0, At, B0); PG8_MMA(0, 1, At, B1); PG8_BAR; PG8_SCHED;
            PG8_LDA(At, 1, 1); PG8_STAGE(PG8_SB(1, 0), b3, voffB); PG8_STAGE(PG8_SB(1, 1), b3 + hstep, voffB); PG8_STAGE(PG8_SA(1, 0), a3, voffA);
            PG8_WAIT_V(8); PG8_WAIT_L(0); PG8_BAR; PG8_MMA(1, 0, At, B0); PG8_MMA(1, 1, At, B1); PG8_BAR; PG8_SCHED;
            } else {
            PG8_LDB(B0, 0, 0); PG8_SCHED; PG8_LDA(At, 0, 0); PG8_STAGE(PG8_SA(1, 1), a1 + hstep, voffA);
            PG8_WAIT_L(8); PG8_BAR; PG8_WAIT_L(0); PG8_MMA(0, 0, At, B0); PG8_BAR; PG8_SCHED;
            PG8_LDB(B1, 0, 1); PG8_STAGE(PG8_SB(0, 0), b2, voffB);
            PG8_BAR; PG8_WAIT_L(0); PG8_MMA(0, 1, At, B1); PG8_BAR;
            PG8_LDA(At, 0, 1); PG8_STAGE(PG8_SA(0, 0), a2, voffA);
            PG8_BAR; PG8_WAIT_L(0); PG8_MMA(1, 0, At, B0); PG8_BAR; PG8_SCHED;
            PG8_STAGE(PG8_SB(0, 1), b2 + hstep, voffB);
            PG8_WAIT_V(6); PG8_BAR; PG8_MMA(1, 1, At, B1); PG8_BAR;
            PG8_LDB(B0, 1, 0); PG8_SCHED; PG8_LDA(At, 1, 0); PG8_STAGE(PG8_SA(0, 1), a2 + hstep, voffA);
            PG8_WAIT_L(8); PG8_BAR; PG8_WAIT_L(0); PG8_MMA(0, 0, At, B0); PG8_BAR; PG8_SCHED;
            PG8_LDB(B1, 1, 1); PG8_STAGE(PG8_SB(1, 0), b3, voffB);
            PG8_BAR; PG8_WAIT_L(0); PG8_MMA(0, 1, At, B1); PG8_BAR;
            PG8_LDA(At, 1, 1); PG8_STAGE(PG8_SA(1, 0), a3, voffA);
            PG8_BAR; PG8_WAIT_L(0); PG8_MMA(1, 0, At, B0); PG8_BAR; PG8_SCHED;
            PG8_STAGE(PG8_SB(1, 1), b3 + hstep, voffB);
            PG8_WAIT_V(6); PG8_BAR; PG8_MMA(1, 1, At, B1); PG8_BAR;
            }
        }
        if constexpr (ALIGN_EPI) { if (wr == 0) PG8_BAR; }
        if constexpr (!Epi::AFTER_DRAIN) { E(acc, cur, wr, wc, fr, fq); S.done(cur); }
        if (!has_next) break;
#pragma unroll
        for (int a = 0; a < 2; ++a)
#pragma unroll
            for (int b = 0; b < 2; ++b)
#pragma unroll
                for (int m = 0; m < 4; ++m)
#pragma unroll
                    for (int n = 0; n < 2; ++n) acc[a][b][m][n] = (f32x4){0.f, 0.f, 0.f, 0.f};
        cur = nxt; cA = nA; cB = nB; ++ui;
        if constexpr (ALIGN_EPI) { if (wr == 1) PG8_BAR; }
    }
    PG8_WAIT_V(0);
    if constexpr (!ALIGN_EPI) { if (wr == 0) PG8_BAR; }
    PG8_BAR;
    if constexpr (Epi::AFTER_DRAIN) { E.fused(acc, cur, wr, wc, fr, fq, lds, wid, lane); S.done(cur); }
#undef PG8_SA
#undef PG8_SB
#undef PG8_STAGE
#undef PG8_LDA
#undef PG8_LDB
#undef PG8_MMA
#undef PG8_WAIT_V
#undef PG8_WAIT_L
#undef PG8_BAR
#undef PG8_SCHED
}
}

struct Args { const float* in[21]; float* out; unsigned char* ws; int ph_lo, ph_hi; };
enum { I_X = 0, I_N1 = 1, I_WIN = 2, I_LB = 3, I_HGN = 4, I_CW = 5, I_CB = 6, I_DTB = 7, I_ALOG = 8, I_DSK = 9, I_SSDN = 10, I_WSB = 11, I_WHG = 12, I_WSSD = 13, I_WOUT = 14,
       I_N2 = 15, I_WQ = 16, I_SK = 17, I_U = 18, I_V = 19, I_FN = 20 };
typedef const __attribute__((address_space(4))) Args* KArgs;
struct Frame {
    LAS unsigned char* lds;
    int tid, lane, wave, vcu, G, bx;
    KArgs ap;
};
#define WSP(T, off) ((T*)(F.ap->ws + (off)))

__device__ __forceinline__ void transpose_item(const float* W, int ldw, bf16* WT, int ldt, int nblk, LAS float* scr, int item, int lane) {
    const int kb = item / nblk, nb = item % nblk, k0 = 64 * kb, n0 = 32 * nb;
#pragma unroll 8
    for (int i = 0; i < 32; ++i) { const int kk = 2 * i + (lane >> 5); scr[kk * 33 + (lane & 31)] = W[(size_t)(k0 + kk) * ldw + n0 + (lane & 31)]; }
    LDS_WAIT(); asm volatile("" ::: "memory");
    const int c = lane & 7;
#pragma unroll
    for (int j = 0; j < 4; ++j) { const int n = (lane >> 3) + 8 * j; const LAS float* s = scr + (8 * c) * 33 + n;
        v4u o; o.x = pk2(s[0 * 33], s[1 * 33]); o.y = pk2(s[2 * 33], s[3 * 33]); o.z = pk2(s[4 * 33], s[5 * 33]); o.w = pk2(s[6 * 33], s[7 * 33]);
        *(GAS v4u*)(WT + (size_t)(n0 + n) * ldt + k0 + 8 * c) = o; }
    LDS_WAIT(); asm volatile("" ::: "memory");
}
__device__ __forceinline__ void weff_item(Frame& F, const float* wq, const float* sk, bf16* WeffT, int item) {
    LAS float* skT = (LAS float*)F.lds;
    LAS float* wqT = (LAS float*)(F.lds + 128 * 132 * 4);
    const int g = item >> 4, d0 = (item & 15) * 64;
    for (int e = F.tid; e < 128 * 32; e += 512) { const int key = e >> 5, i4 = (e & 31) * 4; const f32x4 v = *(const GAS f32x4*)(sk + ((size_t)g * 128 + key) * 128 + i4);
        skT[(i4 + 0) * 132 + key] = v.x; skT[(i4 + 1) * 132 + key] = v.y; skT[(i4 + 2) * 132 + key] = v.z; skT[(i4 + 3) * 132 + key] = v.w; }
    for (int e = F.tid; e < 64 * 32; e += 512) { const int dl = e >> 5, i4 = (e & 31) * 4; const f32x4 v = *(const GAS f32x4*)(wq + (size_t)(d0 + dl) * 2048 + g * 128 + i4);
        wqT[(i4 + 0) * 68 + dl] = v.x; wqT[(i4 + 1) * 68 + dl] = v.y; wqT[(i4 + 2) * 68 + dl] = v.z; wqT[(i4 + 3) * 68 + dl] = v.w; }
    __syncthreads();
    const int ty = F.tid >> 4, tx = F.tid & 15;
    float acc[4][4];
#pragma unroll
    for (int a = 0; a < 4; ++a)
#pragma unroll
        for (int b = 0; b < 4; ++b) acc[a][b] = 0.f;
#pragma unroll 4
    for (int i = 0; i < 128; ++i) { const f32x4 a = *(const LAS f32x4*)(skT + i * 132 + 4 * ty), b = *(const LAS f32x4*)(wqT + i * 68 + 4 * tx);
#pragma unroll
        for (int p = 0; p < 4; ++p)
#pragma unroll
            for (int q = 0; q < 4; ++q) acc[p][q] += a[p] * b[q]; }
#pragma unroll
    for (int p = 0; p < 4; ++p) { v2u o; o.x = pk2(acc[p][0], acc[p][1]); o.y = pk2(acc[p][2], acc[p][3]);
        *(GAS v2u*)(WeffT + (size_t)(g * 128 + 4 * ty + p) * 1024 + d0 + 4 * tx) = o; }
    __syncthreads();
}
__device__ __forceinline__ void load_wdt(Frame& F, const float* w_in_l, LAS float* wdt) {
    for (int e = F.tid; e < 2048; e += 512) { const int d = e >> 1, hf = (e & 1) * 4; *(LAS f32x4*)(wdt + d * 8 + hf) = *(const GAS f32x4*)(w_in_l + (size_t)d * W_IN_COLS + W_DT_COL + hf); }
}
template <bool DO_DT> __device__ __forceinline__ void norm_row_from_regs(const f32x4 (&v)[4], const float* nw, bf16* xnrow, const LAS float* wdt, float* dtrow, int lane) {
    float s = 0.f;
#pragma unroll
    for (int j = 0; j < 4; ++j) s += (v[j].x * v[j].x + v[j].y * v[j].y) + (v[j].z * v[j].z + v[j].w * v[j].w);
    const float rstd = 1.0f / sqrtf(wave_sum(s) * (1.f / DM) + EPS);
    f32x4 h[4];
#pragma unroll
    for (int j = 0; j < 4; ++j) { const f32x4 w = *(const GAS f32x4*)(nw + 4 * lane + 256 * j); h[j] = v[j] * rstd * w; }
    GAS unsigned long long* o8 = (GAS unsigned long long*)xnrow + lane;
#pragma unroll
    for (int j = 0; j < 4; ++j) o8[64 * j] = (unsigned long long)pk2(h[j].x, h[j].y) | ((unsigned long long)pk2(h[j].z, h[j].w) << 32);
    if constexpr (DO_DT) {
        float d[8];
#pragma unroll
        for (int q = 0; q < 8; ++q) d[q] = 0.f;
#pragma unroll
        for (int j = 0; j < 4; ++j)
#pragma unroll
            for (int e = 0; e < 4; ++e) { const float hv = __builtin_bit_cast(float, f2bf(h[j][e]) << 16);
                const LAS float* wp = wdt + (4 * lane + 256 * j + e) * 8; const f32x4 w0 = *(const LAS f32x4*)wp, w1 = *(const LAS f32x4*)(wp + 4);
                d[0] += hv * w0.x; d[1] += hv * w0.y; d[2] += hv * w0.z; d[3] += hv * w0.w; d[4] += hv * w1.x; d[5] += hv * w1.y; d[6] += hv * w1.z; d[7] += hv * w1.w; }
#pragma unroll
        for (int q = 0; q < 8; ++q) d[q] = wave_sum(d[q]);
        if (lane == 0) { *(GAS f32x4*)dtrow = (f32x4){d[0], d[1], d[2], d[3]}; *(GAS f32x4*)(dtrow + 4) = (f32x4){d[4], d[5], d[6], d[7]}; }
    }
}
__device__ __forceinline__ void p0_prologue(Frame& F) {
    const int gw = F.vcu * NWAVES + F.wave, NGW = F.G * NWAVES;
    {
        LAS float* scr = (LAS float*)(F.lds + F.wave * 16384);
        constexpr int NB_A = 4864 / 32, NB_G = 3072 / 32;
        constexpr int I_A = 16 * NB_A, I_G = 16 * NB_G, I_BR = 8 * 32, I_O = 16 * 32;
        constexpr int PER_LAYER = I_A + I_G + 3 * I_BR + I_O;
        for (int it = gw; it < 2 * PER_LAYER; it += NGW) {
            const int l = it / PER_LAYER; int r = it - l * PER_LAYER;
            const float* win = F.ap->in[I_WIN] + (size_t)l * DM * W_IN_COLS; bf16* WinT = WSP(bf16, WS_WIN + (size_t)l * 16 * MiB);
            if (r < I_A) { transpose_item(win, W_IN_COLS, WinT, DM, NB_A, scr, r, F.lane); continue; } r -= I_A;
            if (r < I_G) { transpose_item(win + W_GATE_COL, W_IN_COLS, WinT + (size_t)C_GATE * DM, DM, NB_G, scr, r, F.lane); continue; } r -= I_G;
            bf16* WbrT = WSP(bf16, WS_WBR + (size_t)l * 3 * MiB);
            if (r < I_BR) { transpose_item(F.ap->in[I_WSB] + (size_t)l * 512 * DM, DM, WbrT, 512, 32, scr, r, F.lane); continue; } r -= I_BR;
            if (r < I_BR) { transpose_item(F.ap->in[I_WHG] + (size_t)l * 512 * DM, DM, WbrT + (size_t)1024 * 512, 512, 32, scr, r, F.lane); continue; } r -= I_BR;
            if (r < I_BR) { transpose_item(F.ap->in[I_WSSD] + (size_t)l * 512 * DM, DM, WbrT + (size_t)2048 * 512, 512, 32, scr, r, F.lane); continue; } r -= I_BR;
            transpose_item(F.ap->in[I_WOUT] + (size_t)l * DM * DM, DM, WSP(bf16, WS_WOUT + (size_t)l * 2 * MiB), DM, 32, scr, r, F.lane);
        }
    }
    __syncthreads();
    for (int it = F.vcu; it < 512; it += F.G) { const int l = it >> 8;
        weff_item(F, F.ap->in[I_WQ] + (size_t)l * DM * 2048, F.ap->in[I_SK] + (size_t)l * 16 * 128 * 128, WSP(bf16, WS_WEFF + (size_t)l * 4 * MiB), it & 255); }
    __syncthreads();
    LAS float* wdt = (LAS float*)F.lds; load_wdt(F, F.ap->in[I_WIN], wdt);
    __syncthreads();
    for (int m = gw; m < TT; m += NGW) {
        const GAS f32x4* xr = (const GAS f32x4*)(F.ap->in[I_X] + (size_t)m * DM) + F.lane; GAS f32x4* xo = (GAS f32x4*)(F.ap->out + (size_t)m * DM) + F.lane;
        f32x4 v[4];
#pragma unroll
        for (int j = 0; j < 4; ++j) { v[j] = xr[64 * j]; xo[64 * j] = v[j]; }
        norm_row_from_regs<true>(v, F.ap->in[I_N1], WSP(bf16, WS_XN) + (size_t)m * DM, wdt, WSP(float, WS_DT) + (size_t)m * 8, F.lane);
    }
    __syncthreads();
}
__device__ __forceinline__ void p_norm2(Frame& F, int l) {
    const int gw = F.vcu * NWAVES + F.wave, NGW = F.G * NWAVES;
    for (int m = gw; m < TT; m += NGW) {
        const GAS f32x4* xr = (const GAS f32x4*)(F.ap->out + (size_t)m * DM) + F.lane;
        f32x4 v[4];
#pragma unroll
        for (int j = 0; j < 4; ++j) v[j] = xr[64 * j];
        norm_row_from_regs<false>(v, F.ap->in[I_N2] + (size_t)l * DM, WSP(bf16, WS_XN) + (size_t)m * DM, (const LAS float*)nullptr, (float*)nullptr, F.lane);
    }
    const size_t gt = (size_t)F.vcu * 512 + F.tid, NT = (size_t)F.G * 512, N8 = (size_t)16384 * 1024 / 8;
    const float* U = F.ap->in[I_U] + (size_t)l * 16384 * 1024; const float* V = F.ap->in[I_V] + (size_t)l * 16384 * 1024;
    for (size_t i = gt; i < 2 * N8; i += NT) { const bool isv = i >= N8; const size_t j = isv ? i - N8 : i; const float* src = (isv ? V : U) + j * 8;
        const f32x4 a = __builtin_nontemporal_load((const GAS f32x4*)src), b = __builtin_nontemporal_load((const GAS f32x4*)src + 1);
        v4u o; o.x = pk2(a.x, a.y); o.y = pk2(a.z, a.w); o.z = pk2(b.x, b.y); o.w = pk2(b.z, b.w);
        *(GAS v4u*)(WSP(bf16, isv ? WS_V16 : WS_U16) + j * 8) = o; }
}

__device__ __forceinline__ int crow(int r, int hi) { return (r & 3) + 8 * (r >> 2) + 4 * hi; }
__device__ __forceinline__ void sb_block(const f32x16& p, int kb  , int qi, float& R, float (&a)[16], int lane) {
    float beta[16], suf[16], tot[4], ptot[4];
#pragma unroll
    for (int g = 0; g < 4; ++g) {
        float omb[4];
#pragma unroll
        for (int i = 0; i < 4; ++i) { const int r = 4 * g + i; const float z = p[r] * 0.125f;
            const float e = __builtin_amdgcn_exp2f(-fabsf(z) * 1.4426950408889634f), rc = frcp(1.f + e), sm = e * rc;
            const bool pos = z >= 0.f, valid = (kb + i + 8 * g) < qi;
            beta[r] = valid ? (pos ? rc : sm) : 0.f; omb[i] = valid ? (pos ? sm : rc) : 1.f; }
        suf[4 * g + 3] = 1.f; suf[4 * g + 2] = omb[3]; suf[4 * g + 1] = omb[3] * omb[2]; suf[4 * g] = suf[4 * g + 1] * omb[1]; tot[g] = suf[4 * g] * omb[0];
    }
#pragma unroll
    for (int g = 0; g < 4; ++g) ptot[g] = __shfl_xor(tot[g], 32);
    const bool lo = lane < 32;
    float sp[4]; sp[3] = 1.f; sp[2] = tot[3] * ptot[3]; sp[1] = sp[2] * (tot[2] * ptot[2]); sp[0] = sp[1] * (tot[1] * ptot[1]);
    const float total = sp[0] * (tot[0] * ptot[0]);
#pragma unroll
    for (int g = 0; g < 4; ++g) { const float af = R * sp[g] * (lo ? ptot[g] : 1.f);
#pragma unroll
        for (int i = 0; i < 4; ++i) a[4 * g + i] = beta[4 * g + i] * af * suf[4 * g + i]; }
    R *= total;
}
__device__ __forceinline__ void sb_attn_wave(const bf16* PROJ, bf16* Y0, int b, int h, int qblk, LAS bf16* vt  , int lane) {
    const int r32 = lane & 31, hi = lane >> 5;
    const size_t rowbase = (size_t)b * SEQ;
    const int qw = qblk * 32, qi = qw + r32;
    bf16x8 qf[4];
    { const bf16* qp = PROJ + (rowbase + qi) * NP + C_SBQ + h * 64 + hi * 8;
#pragma unroll
      for (int d0 = 0; d0 < 4; ++d0) qf[d0] = *(const GAS bf16x8*)(qp + d0 * 16); }
    f32x16 o0 = {}, o1 = {};
    float R = 1.0f;
    for (int kt = (qw + 30) >> 6; kt >= 0; --kt) {
        const bf16* kp = PROJ + (rowbase + (size_t)kt * 64 + r32) * NP + C_SBK + h * 64 + hi * 8;
        bf16x8 kf0[4], kf1[4];
#pragma unroll
        for (int d0 = 0; d0 < 4; ++d0) { kf0[d0] = *(const GAS bf16x8*)(kp + d0 * 16); kf1[d0] = *(const GAS bf16x8*)(kp + (size_t)32 * NP + d0 * 16); }
        { const bf16* vp = PROJ + (rowbase + (size_t)kt * 64 + (lane >> 3)) * NP + C_SBV + h * 64 + (lane & 7) * 8;
          bf16x8 vv[8];
#pragma unroll
          for (int i = 0; i < 8; ++i) vv[i] = *(const GAS bf16x8*)(vp + (size_t)(8 * i) * NP);
#pragma unroll
          for (int i = 0; i < 8; ++i)
#pragma unroll
              for (int e = 0; e < 8; ++e) vt[((lane & 7) * 8 + e) * 72 + (lane >> 3) + 8 * i] = (bf16)vv[i][e]; }
        f32x16 p0 = {}, p1 = {};
#pragma unroll
        for (int d0 = 0; d0 < 4; ++d0) { p0 = MFMA32(kf0[d0], qf[d0], p0); p1 = MFMA32(kf1[d0], qf[d0], p1); }
        float a1[16], a0[16];
        sb_block(p1, kt * 64 + 32 + 4 * hi, qi, R, a1, lane);
        sb_block(p0, kt * 64 + 4 * hi, qi, R, a0, lane);
        bf16x8 pa[4]; pa[0] = pack8(a0); pa[1] = pack8(a0 + 8); pa[2] = pack8(a1); pa[3] = pack8(a1 + 8);
        LDS_WAIT();
#pragma unroll
        for (int s = 0; s < 4; ++s) {
            const LAS bf16* v0p = vt + r32 * 72 + 16 * s + 4 * hi; const LAS bf16* v1p = vt + (32 + r32) * 72 + 16 * s + 4 * hi;
            const v2u x0 = *(const LAS v2u*)v0p, x1 = *(const LAS v2u*)(v0p + 8), y0 = *(const LAS v2u*)v1p, y1 = *(const LAS v2u*)(v1p + 8);
            const bf16x8 vb0 = __builtin_bit_cast(bf16x8, (v4u){x0.x, x0.y, x1.x, x1.y}), vb1 = __builtin_bit_cast(bf16x8, (v4u){y0.x, y0.y, y1.x, y1.y});
            o0 = MFMA32(pa[s], vb0, o0); o1 = MFMA32(pa[s], vb1, o1);
        }
        LDS_WAIT();
        if (__all(R < 1e-37f)) break;
    }
    bf16* yp = Y0 + (rowbase + qw) * 512 + h * 64 + r32;
#pragma unroll
    for (int r = 0; r < 16; ++r) { const int q = crow(r, hi); yp[(size_t)q * 512] = (bf16)f2bf(o0[r]); yp[(size_t)q * 512 + 32] = (bf16)f2bf(o1[r]); }
}
__device__ __forceinline__ void p_sb_attn(Frame& F) {
    LAS bf16* vt = (LAS bf16*)(F.lds + F.wave * 9216);
    const int gw = F.vcu * NWAVES + F.wave, NGW = F.G * NWAVES;
    for (int u = gw; u < 4096; u += NGW) sb_attn_wave(WSP(bf16, WS_PROJ), WSP(bf16, WS_Y), u >> 11, (u >> 8) & 7, u & 255, vt, F.lane);
}

__device__ __forceinline__ float hg_lb(const float* lbl, int l, int kk) { return l == 0 ? 0.f : sigmoidf_(lbl[512 + kk] - lbl[kk]); }
__device__ __forceinline__ void ld8f(const LAS float* p, float* v) { const f32x4 a = *(const LAS f32x4*)p, b = *(const LAS f32x4*)(p + 4); v[0] = a.x; v[1] = a.y; v[2] = a.z; v[3] = a.w; v[4] = b.x; v[5] = b.y; v[6] = b.z; v[7] = b.w; }
constexpr int HG_P = 132;
__device__ __forceinline__ void hg_local_unit(Frame& F, int l, int b, int h, int c) {
    LAS float* Bc = (LAS float*)F.lds;
    LAS float* Ky = (LAS float*)(F.lds + 33792);
    LAS bf16* Vt = (LAS bf16*)(F.lds + 67584);
    LAS float* Sg = (LAS float*)(F.lds + 86016);
    const bf16* PROJ = WSP(bf16, WS_PROJ);
    const size_t row0 = (size_t)b * SEQ + (size_t)c * 64;
    const int tid = F.tid, lane = F.lane, w = F.wave, fr = lane & 15, quad = lane >> 4;
    for (int e = tid; e < 64 * 16; e += 512) { const int t = e >> 4, k8 = (e & 15) * 8;
        float fv[8]; unpack8(*(const GAS v4u*)(PROJ + (row0 + t) * NP + C_HGF + h * 128 + k8), fv);
#pragma unroll
        for (int j = 0; j < 8; ++j) { const float lb = hg_lb(F.ap->in[I_LB], l, h * 128 + k8 + j);
            const float ee = fexp(-fabsf(fv[j])), rc = frcp(1.f + ee), sm = ee * rc; const bool pos = fv[j] >= 0.f;
            const float sg = pos ? rc : sm, sgn = pos ? sm : rc;
            const float f = lb + (1.f - lb) * sg;
            Bc[t * HG_P + k8 + j] = __logf(fmaxf(f, 1e-30f)); Ky[t * HG_P + k8 + j] = (1.f - lb) * sgn; }
        const v4u iv = *(const GAS v4u*)(PROJ + (row0 + t) * NP + C_HGI + h * 128 + k8);
        Vt[(k8 + 0) * 72 + t] = (bf16)(iv.x & 0xffff); Vt[(k8 + 1) * 72 + t] = (bf16)(iv.x >> 16); Vt[(k8 + 2) * 72 + t] = (bf16)(iv.y & 0xffff); Vt[(k8 + 3) * 72 + t] = (bf16)(iv.y >> 16);
        Vt[(k8 + 4) * 72 + t] = (bf16)(iv.z & 0xffff); Vt[(k8 + 5) * 72 + t] = (bf16)(iv.z >> 16); Vt[(k8 + 6) * 72 + t] = (bf16)(iv.w & 0xffff); Vt[(k8 + 7) * 72 + t] = (bf16)(iv.w >> 16); }
    __syncthreads();
    { const int seg = tid >> 7, k = tid & 127; float run = 0.f;
#pragma unroll
      for (int i = 0; i < 16; ++i) { run += Bc[(seg * 16 + i) * HG_P + k]; Bc[(seg * 16 + i) * HG_P + k] = run; }
      Sg[seg * 128 + k] = run;
      __syncthreads();
      float off = 0.f;
#pragma unroll
      for (int s = 0; s < 3; ++s) if (s < seg) off += Sg[s * 128 + k];
      if (seg)
#pragma unroll
          for (int i = 0; i < 16; ++i) Bc[(seg * 16 + i) * HG_P + k] += off; }
    __syncthreads();
    if (tid < 128) WSP(float, WS_DCH)[(((size_t)(b * 4 + h)) * 128 + c) * 128 + tid] = fexp(Bc[63 * HG_P + tid]);
    {
        const int I = w >> 1, vh = w & 1;
        const int tl = 16 * I + fr;
        bf16x8 bq[4];
#pragma unroll
        for (int ks = 0; ks < 4; ++ks) { const int k0 = 32 * ks + 8 * quad;
            float qv[8], bt[8], rf[8], o[8], oq[8];
            unpack8(*(const GAS v4u*)(PROJ + (row0 + tl) * NP + C_HGQ + h * 128 + k0), qv);
            ld8f(Bc + tl * HG_P + k0, bt);
            if (I > 0) ld8f(Bc + (16 * I - 1) * HG_P + k0, rf); else {
#pragma unroll
                for (int j = 0; j < 8; ++j) rf[j] = 0.f; }
#pragma unroll
            for (int j = 0; j < 8; ++j) { const float qs = siluf_(qv[j]) * 0.08838834764831845f; o[j] = qs * fexp(bt[j] - rf[j]); oq[j] = qs * fexp(bt[j]); }
            bq[ks] = pack8(o);
            if (vh == 0) *(GAS bf16x8*)(WSP(bf16, WS_QT) + (row0 + tl) * 512 + h * 128 + k0) = pack8(oq);
        }
        f32x4 sT[4];
#pragma unroll
        for (int J = 0; J < 4; ++J) { sT[J] = (f32x4){0.f, 0.f, 0.f, 0.f};
            if (J <= I) { const int sl = 16 * J + fr;
#pragma unroll
                for (int ks = 0; ks < 4; ++ks) { const int k0 = 32 * ks + 8 * quad; float kv[8], bs[8], rf[8], o[8];
                    ld8f(Ky + sl * HG_P + k0, kv); ld8f(Bc + sl * HG_P + k0, bs);
                    if (I > 0) ld8f(Bc + (16 * I - 1) * HG_P + k0, rf); else {
#pragma unroll
                        for (int j = 0; j < 8; ++j) rf[j] = 0.f; }
#pragma unroll
                    for (int j = 0; j < 8; ++j) o[j] = kv[j] * fexp(fminf(rf[j] - bs[j], 80.f));
                    sT[J] = MFMA16(pack8(o), bq[ks], sT[J]); }
                if (J == I) {
#pragma unroll
                    for (int r = 0; r < 4; ++r) if (4 * quad + r > fr) sT[J][r] = 0.f; }
            } }
        bf16x8 bs0, bs1;
        { float t0[8] = {sT[0][0], sT[0][1], sT[0][2], sT[0][3], sT[1][0], sT[1][1], sT[1][2], sT[1][3]}; bs0 = pack8(t0);
          float t1[8] = {sT[2][0], sT[2][1], sT[2][2], sT[2][3], sT[3][0], sT[3][1], sT[3][2], sT[3][3]}; bs1 = pack8(t1); }
#pragma unroll
        for (int vi = 0; vi < 4; ++vi) { const int vb = vh * 4 + vi; const LAS bf16* vp = Vt + (16 * vb + fr) * 72 + 4 * quad;
            f32x4 acc = {0.f, 0.f, 0.f, 0.f};
            { const v2u x0 = *(const LAS v2u*)vp, x1 = *(const LAS v2u*)(vp + 16); acc = MFMA16(__builtin_bit_cast(bf16x8, (v4u){x0.x, x0.y, x1.x, x1.y}), bs0, acc); }
            if (I >= 2) { const v2u x0 = *(const LAS v2u*)(vp + 32), x1 = *(const LAS v2u*)(vp + 48); acc = MFMA16(__builtin_bit_cast(bf16x8, (v4u){x0.x, x0.y, x1.x, x1.y}), bs1, acc); }
            v2u o; o.x = pk2(acc[0], acc[1]); o.y = pk2(acc[2], acc[3]);
            *(GAS v2u*)(WSP(bf16, WS_OI) + (row0 + tl) * 512 + h * 128 + 16 * vb + 4 * quad) = o; }
    }
    {
        const int k = 16 * w + fr; const float bl = Bc[63 * HG_P + k];
        bf16x8 bk[2];
#pragma unroll
        for (int ks = 0; ks < 2; ++ks) { float o[8];
#pragma unroll
            for (int j = 0; j < 8; ++j) { const int s = 32 * ks + 8 * quad + j; o[j] = Ky[s * HG_P + k] * fexp(bl - Bc[s * HG_P + k]); }
            bk[ks] = pack8(o); }
        bf16* S = WSP(bf16, WS_HGS) + (((size_t)(b * 4 + h)) * 128 + c) * 16384;
#pragma unroll
        for (int vb = 0; vb < 8; ++vb) { f32x4 acc = {0.f, 0.f, 0.f, 0.f};
#pragma unroll
            for (int ks = 0; ks < 2; ++ks) acc = MFMA16(*(const LAS bf16x8*)(Vt + (16 * vb + fr) * 72 + 32 * ks + 8 * quad), bk[ks], acc);
#pragma unroll
            for (int r = 0; r < 4; ++r) S[(size_t)(16 * vb + 4 * quad + r) * 128 + k] = (bf16)f2bf(acc[r]); }
    }
    __syncthreads();
}
__device__ __forceinline__ void hg_out_unit(Frame& F, int l, int b, int h, int c) {
    LAS float* SS = (LAS float*)F.lds;
    const bf16* PROJ = WSP(bf16, WS_PROJ);
    const size_t row0 = (size_t)b * SEQ + (size_t)c * 64;
    const int lane = F.lane, w = F.wave, fr = lane & 15, quad = lane >> 4;
    const bf16* S = WSP(bf16, WS_HGS) + (((size_t)(b * 4 + h)) * 128 + c) * 16384;
    bf16x8 af[4];
#pragma unroll
    for (int ks = 0; ks < 4; ++ks) af[ks] = *(const GAS bf16x8*)(S + (size_t)(16 * w + fr) * 128 + 32 * ks + 8 * quad);
    f32x4 o[4];
#pragma unroll
    for (int tb = 0; tb < 4; ++tb) { o[tb] = (f32x4){0.f, 0.f, 0.f, 0.f};
        const bf16* qp = WSP(bf16, WS_QT) + (row0 + 16 * tb + fr) * 512 + h * 128 + 8 * quad;
#pragma unroll
        for (int ks = 0; ks < 4; ++ks) o[tb] = MFMA16(af[ks], *(const GAS bf16x8*)(qp + 32 * ks), o[tb]);
        const v2u oi = *(const GAS v2u*)(WSP(bf16, WS_OI) + (row0 + 16 * tb + fr) * 512 + h * 128 + 16 * w + 4 * quad);
        o[tb][0] += bflo(oi.x); o[tb][1] += bfhi(oi.x); o[tb][2] += bflo(oi.y); o[tb][3] += bfhi(oi.y);
        float ss = (o[tb][0] * o[tb][0] + o[tb][1] * o[tb][1]) + (o[tb][2] * o[tb][2] + o[tb][3] * o[tb][3]);
        ss += __shfl_xor(ss, 16); ss += __shfl_xor(ss, 32);
        if (quad == 0) SS[w * 64 + 16 * tb + fr] = ss; }
    __syncthreads();
    const f32x4 nw = *(const GAS f32x4*)(F.ap->in[I_HGN] + (size_t)l * 128 + 16 * w + 4 * quad);
#pragma unroll
    for (int tb = 0; tb < 4; ++tb) { const int t = 16 * tb + fr; float tot = 0.f;
#pragma unroll
        for (int ww = 0; ww < 8; ++ww) tot += SS[ww * 64 + t];
        const float rstd = 1.0f / sqrtf(tot * (1.f / 128.f) + EPS);
        const v2u gv = *(const GAS v2u*)(PROJ + (row0 + t) * NP + C_HGG + h * 128 + 16 * w + 4 * quad);
        const float y0 = o[tb][0] * rstd * nw.x * siluf_(bflo(gv.x)), y1 = o[tb][1] * rstd * nw.y * siluf_(bfhi(gv.x)), y2 = o[tb][2] * rstd * nw.z * siluf_(bflo(gv.y)), y3 = o[tb][3] * rstd * nw.w * siluf_(bfhi(gv.y));
        v2u ov; ov.x = pk2(y0, y1); ov.y = pk2(y2, y3);
        *(GAS v2u*)(WSP(bf16, WS_Y) + (size_t)TT * 512 + (row0 + t) * 512 + h * 128 + 16 * w + 4 * quad) = ov; }
    __syncthreads();
}

constexpr int SL_CM = 0, SL_BM = 18432, SL_BT = 36864, SL_XT = 54272, SL_AC = 123904, SL_DT = 125952;
__device__ __forceinline__ void ssd_local_unit(Frame& F, int l, int b, int c, int g) {
    LAS bf16* Cm = (LAS bf16*)(F.lds + SL_CM); LAS bf16* Bm = (LAS bf16*)(F.lds + SL_BM); LAS bf16* Bt = (LAS bf16*)(F.lds + SL_BT); LAS bf16* Xt = (LAS bf16*)(F.lds + SL_XT);
    LAS float* AC = (LAS float*)(F.lds + SL_AC); LAS float* DT = (LAS float*)(F.lds + SL_DT);
    const bf16* PROJ = WSP(bf16, WS_PROJ);
    const size_t row0 = (size_t)b * SEQ + (size_t)c * 128;
    const int tid = F.tid, lane = F.lane, w = F.wave, fr = lane & 15, quad = lane >> 4;
    if (w < 4) { const int head = 4 * g + w; const float bias = F.ap->in[I_DTB][l * 8 + head], A = -fexp(F.ap->in[I_ALOG][l * 8 + head]);
        float dt[2], a[2];
#pragma unroll
        for (int i = 0; i < 2; ++i) { const float x = WSP(float, WS_DT)[(row0 + 2 * lane + i) * 8 + head] + bias; dt[i] = x > 20.f ? x : __logf(1.f + fexp(x)); a[i] = A * dt[i]; }
        float v = a[0] + a[1], inc = v;
#pragma unroll
        for (int o = 1; o < 64; o <<= 1) { const float t = __shfl_up(inc, o); if (lane >= o) inc += t; }
        const float ex = inc - v;
        AC[w * 128 + 2 * lane] = ex + a[0]; AC[w * 128 + 2 * lane + 1] = ex + v; DT[w * 128 + 2 * lane] = dt[0]; DT[w * 128 + 2 * lane + 1] = dt[1]; }
    { const float* cw = F.ap->in[I_CW] + (size_t)l * 4 * 768; const float* cb = F.ap->in[I_CB] + (size_t)l * 768;
      for (int e = tid; e < 128 * 48; e += 512) { const int lr = e / 48, cgp = e - lr * 48;
          const int ch = cgp < 32 ? 256 * g + 8 * cgp : (cgp < 40 ? 512 + 64 * g + 8 * (cgp - 32) : 640 + 64 * g + 8 * (cgp - 40));
          float acc[8];
          { const f32x4 b0 = *(const GAS f32x4*)(cb + ch), b1 = *(const GAS f32x4*)(cb + ch + 4); acc[0] = b0.x; acc[1] = b0.y; acc[2] = b0.z; acc[3] = b0.w; acc[4] = b1.x; acc[5] = b1.y; acc[6] = b1.z; acc[7] = b1.w; }
#pragma unroll
          for (int k = 0; k < 4; ++k) { const int lt = lr - 3 + k;
              if (c > 0 || lt >= 0) { float xv[8]; unpack8(*(const GAS v4u*)(PROJ + (size_t)((long)row0 + lt) * NP + C_XBC + ch), xv);
                  const f32x4 w0 = *(const GAS f32x4*)(cw + k * 768 + ch), w1 = *(const GAS f32x4*)(cw + k * 768 + ch + 4);
                  acc[0] += w0.x * xv[0]; acc[1] += w0.y * xv[1]; acc[2] += w0.z * xv[2]; acc[3] += w0.w * xv[3]; acc[4] += w1.x * xv[4]; acc[5] += w1.y * xv[5]; acc[6] += w1.z * xv[6]; acc[7] += w1.w * xv[7]; } }
#pragma unroll
          for (int j = 0; j < 8; ++j) acc[j] = siluf_(acc[j]);
          if (cgp < 32) {
#pragma unroll
              for (int j = 0; j < 8; ++j) Xt[(8 * cgp + j) * 136 + lr] = (bf16)f2bf(acc[j]);
          } else if (cgp < 40) { const int n0 = 8 * (cgp - 32); *(LAS bf16x8*)(Bm + lr * 72 + n0) = pack8(acc);
#pragma unroll
              for (int j = 0; j < 8; ++j) Bt[(n0 + j) * 136 + lr] = (bf16)f2bf(acc[j]);
          } else { const int n0 = 8 * (cgp - 40); *(LAS bf16x8*)(Cm + lr * 72 + n0) = pack8(acc); } } }
    __syncthreads();
    for (int e = tid; e < 128 * 32; e += 512) { const int lr = e >> 5, hh = (e >> 3) & 3, n8 = (e & 7) * 8; float cv[8]; unpack8(*(const LAS v4u*)(Cm + lr * 72 + n8), cv);
        const float ea = fexp(AC[hh * 128 + lr]);
#pragma unroll
        for (int j = 0; j < 8; ++j) cv[j] *= ea;
        *(GAS bf16x8*)(WSP(bf16, WS_CE) + (row0 + lr) * 512 + (4 * g + hh) * 64 + n8) = pack8(cv); }
    if (tid < 4) WSP(float, WS_ATOT)[((size_t)b * 64 + c) * 8 + 4 * g + tid] = AC[tid * 128 + 127];
    {
        const int ll = 16 * w + fr;
        bf16x8 cf[2];
#pragma unroll
        for (int ks = 0; ks < 2; ++ks) cf[ks] = *(const LAS bf16x8*)(Cm + ll * 72 + 32 * ks + 8 * quad);
        f32x4 gT[8];
#pragma unroll
        for (int sb = 0; sb < 8; ++sb) { gT[sb] = (f32x4){0.f, 0.f, 0.f, 0.f};
            if (sb <= w) {
#pragma unroll
                for (int ks = 0; ks < 2; ++ks) gT[sb] = MFMA16(*(const LAS bf16x8*)(Bm + (16 * sb + fr) * 72 + 32 * ks + 8 * quad), cf[ks], gT[sb]); } }
#pragma unroll 1
        for (int hh = 0; hh < 4; ++hh) { const int head = 4 * g + hh; const float al = AC[hh * 128 + ll], dsk = F.ap->in[I_DSK][l * 8 + head];
            f32x4 yT[4];
#pragma unroll
            for (int pb = 0; pb < 4; ++pb) yT[pb] = (f32x4){0.f, 0.f, 0.f, 0.f};
#pragma unroll
            for (int pj = 0; pj < 4; ++pj) if (2 * pj <= w) {
                float o[8];
#pragma unroll
                for (int j = 0; j < 8; ++j) { const int sb = 2 * pj + (j >> 2), s = 16 * sb + 4 * quad + (j & 3);
                    const float gv = (j < 4) ? gT[2 * pj][j & 3] : gT[2 * pj + 1][j & 3];
                    float v = gv * fexp(fminf(al - AC[hh * 128 + s], 0.f)) * DT[hh * 128 + s];
                    if (s == ll) v += dsk;
                    o[j] = (s <= ll) ? v : 0.f; }
                const bf16x8 bfr = pack8(o);
#pragma unroll
                for (int pb = 0; pb < 4; ++pb) { const LAS bf16* xp = Xt + (hh * 64 + 16 * pb + fr) * 136 + 32 * pj + 4 * quad;
                    const v2u x0 = *(const LAS v2u*)xp, x1 = *(const LAS v2u*)(xp + 16);
                    yT[pb] = MFMA16(__builtin_bit_cast(bf16x8, (v4u){x0.x, x0.y, x1.x, x1.y}), bfr, yT[pb]); } }
#pragma unroll
            for (int pb = 0; pb < 4; ++pb) { v2u ov; ov.x = pk2(yT[pb][0], yT[pb][1]); ov.y = pk2(yT[pb][2], yT[pb][3]);
                *(GAS v2u*)(WSP(bf16, WS_YD) + (row0 + ll) * 512 + head * 64 + 16 * pb + 4 * quad) = ov; } }
    }
    {
        const int hh = w >> 1, head = 4 * g + hh, pb0 = (w & 1) * 2; const float alast = AC[hh * 128 + 127];
        f32x4 st[2][4];
#pragma unroll
        for (int i = 0; i < 2; ++i)
#pragma unroll
            for (int nb = 0; nb < 4; ++nb) st[i][nb] = (f32x4){0.f, 0.f, 0.f, 0.f};
#pragma unroll
        for (int ks = 0; ks < 4; ++ks) { const int s0 = 32 * ks + 8 * quad; float wv[8];
#pragma unroll
            for (int j = 0; j < 8; ++j) wv[j] = fexp(alast - AC[hh * 128 + s0 + j]) * DT[hh * 128 + s0 + j];
            bf16x8 xa[2];
#pragma unroll
            for (int i = 0; i < 2; ++i) xa[i] = *(const LAS bf16x8*)(Xt + (hh * 64 + 16 * (pb0 + i) + fr) * 136 + s0);
#pragma unroll
            for (int nb = 0; nb < 4; ++nb) { float bv[8]; unpack8(*(const LAS v4u*)(Bt + (16 * nb + fr) * 136 + s0), bv);
#pragma unroll
                for (int j = 0; j < 8; ++j) bv[j] *= wv[j];
                const bf16x8 bfr = pack8(bv);
#pragma unroll
                for (int i = 0; i < 2; ++i) st[i][nb] = MFMA16(xa[i], bfr, st[i][nb]); } }
        bf16* S = WSP(bf16, WS_SSDS) + ((((size_t)b * 64 + c) * 8 + head) * 4096);
#pragma unroll
        for (int i = 0; i < 2; ++i)
#pragma unroll
            for (int nb = 0; nb < 4; ++nb)
#pragma unroll
                for (int r = 0; r < 4; ++r) S[(size_t)(16 * (pb0 + i) + 4 * quad + r) * 64 + 16 * nb + fr] = (bf16)f2bf(st[i][nb][r]);
    }
    __syncthreads();
}
__device__ __forceinline__ void ssd_out_unit(Frame& F, int l, int b, int c, int g) {
    const bf16* PROJ = WSP(bf16, WS_PROJ);
    const size_t row0 = (size_t)b * SEQ + (size_t)c * 128;
    const int lane = F.lane, w = F.wave, fr = lane & 15, quad = lane >> 4;
    const size_t row = row0 + 16 * w + fr;
    f32x4 yT[4][4]; float ss = 0.f;
#pragma unroll
    for (int hh = 0; hh < 4; ++hh) { const int head = 4 * g + hh;
        bf16x8 cf[2];
#pragma unroll
        for (int ks = 0; ks < 2; ++ks) cf[ks] = *(const GAS bf16x8*)(WSP(bf16, WS_CE) + row * 512 + head * 64 + 32 * ks + 8 * quad);
        const bf16* S = WSP(bf16, WS_SSDS) + ((((size_t)b * 64 + c) * 8 + head) * 4096);
#pragma unroll
        for (int pb = 0; pb < 4; ++pb) { f32x4 acc = {0.f, 0.f, 0.f, 0.f};
#pragma unroll
            for (int ks = 0; ks < 2; ++ks) acc = MFMA16(*(const GAS bf16x8*)(S + (size_t)(16 * pb + fr) * 64 + 32 * ks + 8 * quad), cf[ks], acc);
            const int col = head * 64 + 16 * pb + 4 * quad;
            const v2u yd = *(const GAS v2u*)(WSP(bf16, WS_YD) + row * 512 + col), zv = *(const GAS v2u*)(PROJ + row * NP + C_SSDZ + col);
            acc[0] = (acc[0] + bflo(yd.x)) * siluf_(bflo(zv.x)); acc[1] = (acc[1] + bfhi(yd.x)) * siluf_(bfhi(zv.x)); acc[2] = (acc[2] + bflo(yd.y)) * siluf_(bflo(zv.y)); acc[3] = (acc[3] + bfhi(yd.y)) * siluf_(bfhi(zv.y));
            ss += (acc[0] * acc[0] + acc[1] * acc[1]) + (acc[2] * acc[2] + acc[3] * acc[3]);
            yT[hh][pb] = acc; } }
    ss += __shfl_xor(ss, 16); ss += __shfl_xor(ss, 32);
    const float rstd = 1.0f / sqrtf(ss * (1.f / 256.f) + EPS);
#pragma unroll
    for (int hh = 0; hh < 4; ++hh)
#pragma unroll
        for (int pb = 0; pb < 4; ++pb) { const int col = (4 * g + hh) * 64 + 16 * pb + 4 * quad; const f32x4 nw = *(const GAS f32x4*)(F.ap->in[I_SSDN] + (size_t)l * 512 + col);
            v2u ov; ov.x = pk2(yT[hh][pb][0] * rstd * nw.x, yT[hh][pb][1] * rstd * nw.y); ov.y = pk2(yT[hh][pb][2] * rstd * nw.z, yT[hh][pb][3] * rstd * nw.w);
            *(GAS v2u*)(WSP(bf16, WS_Y) + (size_t)2 * TT * 512 + row * 512 + col) = ov; }
}
__device__ __forceinline__ void p_scan(Frame& F) {
    const int gt = F.vcu * 512 + F.tid;
    if (gt < 65536) {
        const int bh = gt >> 13, pr = gt & 8191, k = (2 * pr) & 127;
        unsigned* S = (unsigned*)(WSP(bf16, WS_HGS) + (size_t)bh * 128 * 16384) + pr; const float* D = WSP(float, WS_DCH) + (size_t)bh * 128 * 128 + k;
        float r0 = 0.f, r1 = 0.f;
        for (int c0 = 0; c0 < 128; c0 += 8) { unsigned x[8]; f32x2 d[8];
#pragma unroll
            for (int i = 0; i < 8; ++i) { x[i] = __builtin_nontemporal_load((const GAS unsigned*)(S + (size_t)(c0 + i) * 8192)); d[i] = *(const GAS f32x2*)(D + (size_t)(c0 + i) * 128); }
#pragma unroll
            for (int i = 0; i < 8; ++i) { *(GAS unsigned*)(S + (size_t)(c0 + i) * 8192) = pk2(r0, r1); r0 = r0 * d[i].x + bflo(x[i]); r1 = r1 * d[i].y + bfhi(x[i]); } }
    } else if (gt < 65536 + 32768) {
        const int e = gt - 65536, bh = e >> 11, pr = e & 2047, b = bh >> 3, h = bh & 7;
        unsigned* S = (unsigned*)(WSP(bf16, WS_SSDS) + ((size_t)b * 64 * 8 + h) * 4096) + pr; const float* A = WSP(float, WS_ATOT) + (size_t)b * 64 * 8 + h;
        float r0 = 0.f, r1 = 0.f;
        for (int c0 = 0; c0 < 64; c0 += 8) { unsigned x[8]; float d[8];
#pragma unroll
            for (int i = 0; i < 8; ++i) { x[i] = __builtin_nontemporal_load((const GAS unsigned*)(S + (size_t)(c0 + i) * 8 * 2048)); d[i] = fexp(A[(size_t)(c0 + i) * 8]); }
#pragma unroll
            for (int i = 0; i < 8; ++i) { *(GAS unsigned*)(S + (size_t)(c0 + i) * 8 * 2048) = pk2(r0, r1); r0 = r0 * d[i] + bflo(x[i]); r1 = r1 * d[i] + bfhi(x[i]); } }
    }
}

typedef __bf16 bf16x2_t __attribute__((ext_vector_type(2)));
__device__ __forceinline__ float dot2bf(unsigned a, unsigned b, float c) { return __builtin_amdgcn_fdot2_f32_bf16(__builtin_bit_cast(bf16x2_t, a), __builtin_bit_cast(bf16x2_t, b), c, false); }
__device__ __forceinline__ void ins16(float (&top)[16], float x) {
#pragma unroll
    for (int i = 0; i < 16; ++i) { const float hi = __builtin_fmaxf(top[i], x); x = __builtin_fminf(top[i], x); top[i] = hi; }
}
__device__ __forceinline__ void top16_half(float (&top)[16], const float* base) {
#pragma unroll
    for (int i = 0; i < 16; ++i) top[i] = -INFINITY;
#pragma unroll 1
    for (int k0 = 0; k0 < 128; k0 += 8) { float x[8];
#pragma unroll
        for (int i = 0; i < 8; ++i) x[i] = __builtin_nontemporal_load((const GAS float*)(base + (size_t)(k0 + i) * TT));
#pragma unroll
        for (int i = 0; i < 8; ++i) ins16(top, __builtin_bit_cast(float, (__builtin_bit_cast(unsigned, x[i]) & ~127u) | (unsigned)(k0 + i))); }
}
__device__ __forceinline__ float mkc(float a, float b, unsigned code) { return __builtin_bit_cast(float, (__builtin_bit_cast(unsigned, a + b) & ~255u) | code); }
constexpr int PL_WDT = 0, PL_SELB = 32768, PL_IDX = 49152, PL_GATE = 65536, PL_WJ = 98304;
__device__ __forceinline__ void p_peer(Frame& F, int l, bool last) {
    LAS float* wdt = (LAS float*)(F.lds + PL_WDT); LAS unsigned* selb = (LAS unsigned*)(F.lds + PL_SELB); LAS unsigned short* idxl = (LAS unsigned short*)(F.lds + PL_IDX);
    LAS float* gatel = (LAS float*)(F.lds + PL_GATE); LAS float* wjl = (LAS float*)(F.lds + PL_WJ) + F.wave * 128;
    const int lane = F.lane, w = F.wave;
    if (!last) load_wdt(F, F.ap->in[I_WIN] + (size_t)(l + 1) * DM * W_IN_COLS, wdt);
    const bf16* U16 = WSP(bf16, WS_U16); const bf16* V16 = WSP(bf16, WS_V16);
    for (int blk = F.vcu; blk < TT / 64; blk += F.G) {
        const int t0 = blk * 64;
        __syncthreads();
        {
            float t1[16], t2[16], fin[16];
            const float* sb = WSP(float, WS_ST) + (size_t)(w * 256) * TT + t0 + lane;
            top16_half(t1, sb); top16_half(t2, sb + (size_t)128 * TT);
            LAS unsigned* mys = selb + (w * 64 + lane) * 8;
#pragma unroll
            for (int q = 0; q < 4; ++q) { unsigned a = 0, b = 0;
#pragma unroll
                for (int i = 0; i < 4; ++i) { a |= (__builtin_bit_cast(unsigned, t1[4 * q + i]) & 127u) << (8 * i); b |= (__builtin_bit_cast(unsigned, t2[4 * q + i]) & 127u) << (8 * i); }
                mys[q] = a; mys[4 + q] = b; }
#pragma unroll
            for (int j = 0; j < 16; ++j) fin[j] = mkc(t1[0], t2[j], (unsigned)j);
#pragma unroll
            for (int i = 1; i < 16; ++i)
#pragma unroll
                for (int j = 0; j < 16; ++j) if ((i + 1) * (j + 1) <= 16) ins16(fin, mkc(t1[i], t2[j], (unsigned)(i * 16 + j)));
            float m = fin[0];
#pragma unroll
            for (int r = 1; r < 16; ++r) m = __builtin_fmaxf(m, fin[r]);
            float ex[16], sum = 0.f;
#pragma unroll
            for (int r = 0; r < 16; ++r) { ex[r] = fexp(fin[r] - m); sum += ex[r]; }
            const float inv = 1.0f / sum;
            LDS_WAIT();
            const LAS unsigned char* myb = (const LAS unsigned char*)mys;
#pragma unroll
            for (int r = 0; r < 16; ++r) { const unsigned code = __builtin_bit_cast(unsigned, fin[r]) & 255u; const unsigned i1 = myb[code >> 4], i2 = myb[16 + (code & 15u)];
                idxl[lane * 128 + w * 16 + r] = (unsigned short)(i1 * 128u + i2); gatel[lane * 128 + w * 16 + r] = ex[r] * inv; }
        }
        __syncthreads();
#if defined(MK_PEER_DIAG) && MK_PEER_DIAG == 1
        for (int e = F.tid; e < 64 * 1024; e += 512) { const int tk = e >> 10, j = e & 1023; F.ap->out[((size_t)t0 + tk) * DM + j] = j < 128 ? (float)idxl[tk * 128 + j] : (j < 256 ? gatel[tk * 128 + j - 128] : 0.f); }
        continue;
#endif
#pragma unroll 1
        for (int tt = 8 * w; tt < 8 * w + 8; ++tt) {
            const size_t tok = (size_t)t0 + tt;
            unsigned hp[8];
            { const v4u a = *(const GAS v4u*)(WSP(bf16, WS_XN) + tok * DM + 8 * lane), b = *(const GAS v4u*)(WSP(bf16, WS_XN) + tok * DM + 512 + 8 * lane);
              hp[0] = a.x; hp[1] = a.y; hp[2] = a.z; hp[3] = a.w; hp[4] = b.x; hp[5] = b.y; hp[6] = b.z; hp[7] = b.w; }
#pragma unroll 1
            for (int bt = 0; bt < 2; ++bt) {
                float part[64];
#pragma unroll
                for (int jj = 0; jj < 64; ++jj) { const unsigned e = idxl[tt * 128 + bt * 64 + jj]; const bf16* row = U16 + (size_t)e * DM + 8 * lane;
                    const v4u a = *(const GAS v4u*)row, b = *(const GAS v4u*)(row + 512);
                    float s = dot2bf(a.x, hp[0], 0.f); s = dot2bf(a.y, hp[1], s); s = dot2bf(a.z, hp[2], s); s = dot2bf(a.w, hp[3], s);
                    s = dot2bf(b.x, hp[4], s); s = dot2bf(b.y, hp[5], s); s = dot2bf(b.z, hp[6], s); s = dot2bf(b.w, hp[7], s); part[jj] = s; }
#pragma unroll
                for (int off = 32; off >= 1; off >>= 1) { const bool up = (lane & off) != 0;
#pragma unroll
                    for (int i = 0; i < off; ++i) { const float send = up ? part[i] : part[i + off], keep = up ? part[i + off] : part[i]; part[i] = keep + __shfl_xor(send, off); } }
#if defined(MK_PEER_DIAG) && MK_PEER_DIAG == 2
                const float act = 1.0f + 0.f * part[0];
#else
                const float act = part[0];
#endif
                const float ge = 0.5f * act * (1.0f + erff(act * 0.70710678118654752f));
                wjl[bt * 64 + lane] = gatel[tt * 128 + bt * 64 + lane] * ge;
            }
            LDS_WAIT();
            float out[16];
#pragma unroll
            for (int i = 0; i < 16; ++i) out[i] = 0.f;
#pragma unroll 8
            for (int j = 0; j < 128; ++j) { const unsigned e = idxl[tt * 128 + j];
#if defined(MK_PEER_DIAG) && MK_PEER_DIAG == 3
                const float wj = 0.0f;
#else
                const float wj = wjl[j];
#endif
                const bf16* row = V16 + (size_t)e * DM + 8 * lane;
                const v4u a = *(const GAS v4u*)row, b = *(const GAS v4u*)(row + 512);
                out[0] += wj * bflo(a.x); out[1] += wj * bfhi(a.x); out[2] += wj * bflo(a.y); out[3] += wj * bfhi(a.y); out[4] += wj * bflo(a.z); out[5] += wj * bfhi(a.z); out[6] += wj * bflo(a.w); out[7] += wj * bfhi(a.w);
                out[8] += wj * bflo(b.x); out[9] += wj * bfhi(b.x); out[10] += wj * bflo(b.y); out[11] += wj * bfhi(b.y); out[12] += wj * bflo(b.z); out[13] += wj * bfhi(b.z); out[14] += wj * bflo(b.w); out[15] += wj * bfhi(b.w); }
            float* xr = F.ap->out + tok * DM; float ss = 0.f;
#pragma unroll
            for (int hseg = 0; hseg < 2; ++hseg)
#pragma unroll
                for (int q = 0; q < 2; ++q) {
#if defined(MK_PEER_DIAG) && MK_PEER_DIAG == 3
                    const f32x4 xv = *(const GAS f32x4*)(xr + 512 * hseg + 8 * lane + 4 * q);
#else
                    const f32x4 xv = *(const GAS f32x4*)(xr + 512 * hseg + 8 * lane + 4 * q);
#endif
#pragma unroll
                    for (int e = 0; e < 4; ++e) { out[8 * hseg + 4 * q + e] += xv[e]; ss += out[8 * hseg + 4 * q + e] * out[8 * hseg + 4 * q + e]; } }
            const float rstd = 1.0f / sqrtf(wave_sum(ss) * (1.f / DM) + EPS);
            if (last) {
                const float* fw = F.ap->in[I_FN];
#pragma unroll
                for (int hseg = 0; hseg < 2; ++hseg)
#pragma unroll
                    for (int q = 0; q < 2; ++q) { const f32x4 wv = *(const GAS f32x4*)(fw + 512 * hseg + 8 * lane + 4 * q); f32x4 o;
#pragma unroll
                        for (int e = 0; e < 4; ++e) o[e] = out[8 * hseg + 4 * q + e] * rstd * wv[e];
                        *(GAS f32x4*)(xr + 512 * hseg + 8 * lane + 4 * q) = o; }
            } else {
                const float* nw = F.ap->in[I_N1] + (size_t)(l + 1) * DM; float d[8];
#pragma unroll
                for (int q = 0; q < 8; ++q) d[q] = 0.f;
#pragma unroll
                for (int hseg = 0; hseg < 2; ++hseg) { float hv[8];
#pragma unroll
                    for (int q = 0; q < 2; ++q) { const f32x4 wv = *(const GAS f32x4*)(nw + 512 * hseg + 8 * lane + 4 * q); f32x4 o;
#pragma unroll
                        for (int e = 0; e < 4; ++e) { o[e] = out[8 * hseg + 4 * q + e]; hv[4 * q + e] = o[e] * rstd * wv[e]; }
#if !(defined(MK_PEER_SKIPX))
                        *(GAS f32x4*)(xr + 512 * hseg + 8 * lane + 4 * q) = o;
#endif
                        }
                    const bf16x8 hb = pack8(hv);
#if !(defined(MK_PEER_SKIPXN))
                    *(GAS bf16x8*)(WSP(bf16, WS_XN) + tok * DM + 512 * hseg + 8 * lane) = hb;
#endif
#pragma unroll
                    for (int e = 0; e < 8; ++e) { const float hq = bf2f((unsigned short)hb[e]); const LAS float* wp = wdt + (512 * hseg + 8 * lane + e) * 8; const f32x4 w0 = *(const LAS f32x4*)wp, w1 = *(const LAS f32x4*)(wp + 4);
                        d[0] += hq * w0.x; d[1] += hq * w0.y; d[2] += hq * w0.z; d[3] += hq * w0.w; d[4] += hq * w1.x; d[5] += hq * w1.y; d[6] += hq * w1.z; d[7] += hq * w1.w; } }
#pragma unroll
                for (int q = 0; q < 8; ++q) d[q] = wave_sum(d[q]);
#if !(defined(MK_PEER_SKIPXN))
                if (lane == 0)
#else
                if (lane == 99)
#endif
                { float* dr = WSP(float, WS_DT) + tok * 8; *(GAS f32x4*)dr = (f32x4){d[0], d[1], d[2], d[3]}; *(GAS f32x4*)(dr + 4) = (f32x4){d[4], d[5], d[6], d[7]}; }
            }
        }
    }
    __syncthreads();
}

#ifndef MK_PHASE_MASK
#define MK_PHASE_MASK 0x3ff
#endif
#ifndef MK_MIX_SUB
#define MK_MIX_SUB 7
#endif
#define MIXS(k) ((MK_MIX_SUB >> (k)) & 1)
#define PHM(k) ((MK_PHASE_MASK >> (k)) & 1)
#ifndef MK_STOP_PHASE
#define MK_STOP_PHASE 19
#endif
constexpr int N_PHASES = MK_STOP_PHASE;
__global__ void __launch_bounds__(NWAVES * 64, 2) fwd_kernel(Args args) {
    extern __shared__ __attribute__((aligned(16))) unsigned char lds[];
    Frame F;
    cg::grid_group grid = cg::this_grid();
    for (int ph = args.ph_lo; ph < args.ph_hi; ++ph) {
        { KArgs ap = (KArgs)__builtin_amdgcn_kernarg_segment_ptr(); asm volatile("" : "+s"(ap)); F.ap = ap; }
        { int t = threadIdx.x; asm volatile("" : "+v"(t)); F.tid = t; F.lane = t & 63; F.wave = __builtin_amdgcn_readfirstlane(t >> 6); }
        { int G = gridDim.x, bx = blockIdx.x; asm volatile("" : "+s"(G), "+s"(bx)); F.G = G; F.vcu = (G % 8 == 0) ? (bx % 8) * (G / 8) + bx / 8 : bx; F.bx = bx; }
        { LAS unsigned char* lp = (LAS unsigned char*)lds; asm volatile("" : "+s"(lp)); F.lds = lp; }
        if (ph >= 100) {
            const size_t off = ph == 100 ? WS_ST : (ph == 101 ? WS_U16 : (ph == 102 ? WS_XN : WS_V16));
            const GAS f32x4* src = (const GAS f32x4*)(F.ap->ws + off); GAS f32x4* dst = (GAS f32x4*)F.ap->out;
            for (size_t i = (size_t)F.vcu * 512 + F.tid; i < (size_t)TT * DM / 4; i += (size_t)F.G * 512) dst[i] = src[i];
        } else
        if (ph == 0) { if (PHM(0)) p0_prologue(F); }
        else {
            const int l = (ph - 1) / 9, sp = (ph - 1) % 9;
            if (sp == 0) { if (PHM(1)) {
                pg8::Gemm g{WSP(bf16, WS_XN), WSP(bf16, WS_WIN + (size_t)l * 16 * MiB), TT, NP, DM}; pg8::StaticOrder S; S.init(TT, NP, F.G, F.bx);
                pg8::EpiBf16 E{WSP(bf16, WS_PROJ), NP};
                pg8::gemm_phase<pg8::EpiBf16, pg8::StaticOrder, true, true>(F.lds, g, S, E);
            } } else if (sp == 1) { if (PHM(2)) {
                if (MIXS(0)) for (int u = F.vcu; u < 1024; u += F.G) hg_local_unit(F, l, u >> 9, (u >> 7) & 3, u & 127);
                if (MIXS(1)) for (int u = F.vcu; u < 256; u += F.G) ssd_local_unit(F, l, u >> 7, (u >> 1) & 63, u & 1);
                if (MIXS(2)) p_sb_attn(F);
            } } else if (sp == 2) { if (PHM(3)) {
                p_scan(F);
            } } else if (sp == 3) { if (PHM(4)) {
                for (int u = F.vcu; u < 1024; u += F.G) hg_out_unit(F, l, u >> 9, (u >> 7) & 3, u & 127);
                for (int u = F.vcu; u < 256; u += F.G) ssd_out_unit(F, l, u >> 7, (u >> 1) & 63, u & 1);
            } } else if (sp == 4) { if (PHM(5)) {
                pg8::Gemm g{WSP(bf16, WS_Y), WSP(bf16, WS_WBR + (size_t)l * 3 * MiB), 3 * TT, 3 * DM, 512}; pg8::MergeOrder S{F.vcu, F.G};
                pg8::EpiMerge E{WSP(bf16, WS_PROJ) + C_GATE, NP, WSP(bf16, WS_XN), DM};
                pg8::gemm_phase<pg8::EpiMerge, pg8::MergeOrder, true, true>(F.lds, g, S, E);
            } } else if (sp == 5) { if (PHM(6)) {
                pg8::Gemm g{WSP(bf16, WS_XN), WSP(bf16, WS_WOUT + (size_t)l * 2 * MiB), TT, DM, DM}; pg8::StaticOrder S; S.init(TT, DM, F.G, F.bx);
                pg8::EpiResF32 E{F.ap->out, DM};
                pg8::gemm_phase<pg8::EpiResF32, pg8::StaticOrder, true, true>(F.lds, g, S, E);
            } } else if (sp == 6) { if (PHM(7)) {
                p_norm2(F, l);
            } } else if (sp == 7) { if (PHM(8)) {
                pg8::Gemm g{WSP(bf16, WS_WEFF + (size_t)l * 4 * MiB), WSP(bf16, WS_XN), 2048, TT, DM}; pg8::StaticOrder S; S.init(2048, TT, F.G, F.bx);
                pg8::EpiF32 E{WSP(float, WS_ST), TT};
                pg8::gemm_phase<pg8::EpiF32, pg8::StaticOrder, true, true>(F.lds, g, S, E);
            } } else {
                if (PHM(9)) p_peer(F, l, l == 1);
            }
        }
        if (ph + 1 < args.ph_hi) grid.sync();
    }
}

extern "C" void kernel_launch(void* const* d_in, const int* in_sizes, int n_in, void* d_out, int out_size, void* d_ws, size_t ws_size, hipStream_t stream) {
    static int grid = 0;
    if (grid == 0) {
        if (n_in != 21 || out_size != TT * DM || ws_size < WS_END) { fprintf(stderr, "kernel_launch: unexpected shapes (n_in %d out %d ws %zu)\n", n_in, out_size, ws_size); grid = -1; return; }
        int dev = 0, cus = 0, per_cu = 0;
        if (hipGetDevice(&dev) != hipSuccess || hipDeviceGetAttribute(&cus, hipDeviceAttributeMultiprocessorCount, dev) != hipSuccess) { grid = -1; return; }
        if (hipFuncSetAttribute((const void*)fwd_kernel, hipFuncAttributeMaxDynamicSharedMemorySize, LDS_BYTES) != hipSuccess) { fprintf(stderr, "kernel_launch: hipFuncSetAttribute failed\n"); grid = -1; return; }
        if (hipOccupancyMaxActiveBlocksPerMultiprocessor(&per_cu, (const void*)fwd_kernel, NWAVES * 64, LDS_BYTES) != hipSuccess || per_cu < 1) { fprintf(stderr, "kernel_launch: occupancy query says %d\n", per_cu); (void)hipGetLastError(); per_cu = 1; }
        grid = cus;
        if (grid > 256) grid = 256;
    }
    if (grid < 0) return;
    Args a{};
    for (int i = 0; i < 21; ++i) a.in[i] = (const float*)d_in[i];
    a.out = (float*)d_out; a.ws = (unsigned char*)d_ws;
#if MK_N_LAUNCHES == 1
    a.ph_lo = 0; a.ph_hi = N_PHASES;
    void* kargs[] = {&a};
    hipError_t e = hipLaunchCooperativeKernel((const void*)fwd_kernel, dim3(grid), dim3(NWAVES * 64), kargs, LDS_BYTES, stream);
    if (e != hipSuccess) fprintf(stderr, "kernel_launch: cooperative launch failed: %s (grid %d)\n", hipGetErrorString(e), grid);
#else
    for (int ph = 0; ph < N_PHASES; ++ph) { a.ph_lo = ph; a.ph_hi = ph + 1;
        hipLaunchKernelGGL(fwd_kernel, dim3(grid), dim3(NWAVES * 64), LDS_BYTES, stream, a); }
#ifdef MK_DIAG
    a.ph_lo = MK_DIAG; a.ph_hi = MK_DIAG + 1; hipLaunchKernelGGL(fwd_kernel, dim3(grid), dim3(NWAVES * 64), LDS_BYTES, stream, a);
#endif
#endif
}
```

```cpp
#include <hip/hip_runtime.h>
#include <hip/hip_cooperative_groups.h>
#include <cstdio>
#include <cstdint>
namespace cg = cooperative_groups;

#ifndef MK_N_LAUNCHES
#define MK_N_LAUNCHES 1
#ifndef MK_REPEAT_SP
#define MK_REPEAT_SP -1
#endif
#endif
#ifndef MK_PAR_MIX1
#define MK_PAR_MIX1 0
#endif
#ifndef MK_PAR_SEL
#define MK_PAR_SEL 0
#endif
#ifndef MK_V8_IN_U
#define MK_V8_IN_U 1
#endif
#ifndef MK_UCOL
#define MK_UCOL 1
#endif
#ifndef MK_U8_EARLY
#define MK_U8_EARLY 0
#endif
#ifndef MK_W1_LATE
#define MK_W1_LATE 0
#endif
#ifndef MK_WT_STORES
#define MK_WT_STORES 1
#endif
#ifndef MK_BARRIER
#define MK_BARRIER 1
#endif

constexpr int TT = 16384;
constexpr int SEQ = 8192;
constexpr int DM = 1024;
constexpr int NP = 7936;
constexpr int C_SBQ = 0, C_SBK = 512, C_SBV = 1024, C_HGF = 1536, C_HGQ = 2048, C_HGI = 2560, C_HGG = 3072, C_SSDZ = 3584, C_XBC = 4096, C_GATE = 4864;
constexpr int W_IN_COLS = 7944, W_DT_COL = 4864, W_GATE_COL = 4872;
constexpr float EPS = 1e-6f;

constexpr size_t MiB = 1u << 20;
constexpr size_t WS_CTL = 0, CTL_ZERO_BYTES = 1 * MiB;
constexpr size_t WS_WIN = 2 * MiB;
constexpr size_t WS_WBR = 34 * MiB;
constexpr size_t WS_WOUT = 40 * MiB;
constexpr size_t WS_WEFF = 44 * MiB;
constexpr size_t WS_XB = 64 * MiB;
#define XNP ((bf16*)F.ap->out)
constexpr size_t WS_PROJ = 96 * MiB;
constexpr size_t WS_ST = 96 * MiB;
constexpr size_t WS_U8 = 224 * MiB, WS_V8 = 240 * MiB;
constexpr size_t WS_IDX = 52 * MiB;
constexpr size_t WS_W = 56 * MiB;
constexpr size_t WS_Y = 344 * MiB;
constexpr size_t WS_QT = 392 * MiB;
constexpr size_t WS_OI = 408 * MiB;
constexpr size_t WS_HGS = 424 * MiB;
constexpr size_t WS_CE = 456 * MiB;
constexpr size_t WS_YD = 472 * MiB;
constexpr size_t WS_SSDS = 488 * MiB;
constexpr size_t WS_DT = 496 * MiB;
constexpr size_t WS_DCH = 497 * MiB;
constexpr size_t WS_ATOT = 498 * MiB;
constexpr size_t WS_SSQ = 499 * MiB;
constexpr size_t WS_XW = 160 * MiB;
constexpr size_t WS_RSTD = 498 * MiB + 512 * 1024;
constexpr size_t WS_SSQ1 = 497 * MiB + 512 * 1024;
constexpr size_t WS_UP = 344 * MiB;
constexpr size_t WS_W2 = 500 * MiB;
constexpr size_t WS_END = 508 * MiB;

constexpr int RING_BYTES = 131072;
constexpr int LDSCTL_OFF = 143360, MISC_OFF = LDSCTL_OFF + 320;
constexpr int LDS_BYTES = 147456;
constexpr int NWAVES = 8;

#define GAS __attribute__((address_space(1)))
#define LAS __attribute__((address_space(3)))
typedef unsigned short bf16;
typedef unsigned v4u __attribute__((ext_vector_type(4)));
typedef unsigned v2u __attribute__((ext_vector_type(2)));
typedef float f32x4 __attribute__((ext_vector_type(4)));
typedef float f32x2 __attribute__((ext_vector_type(2)));
typedef float f32x16 __attribute__((ext_vector_type(16)));
typedef short bf16x8 __attribute__((ext_vector_type(8)));
typedef short bf16x4 __attribute__((ext_vector_type(4)));
typedef GAS unsigned gu32;
typedef GAS unsigned long long gu64;
#define RLX_AGENT __ATOMIC_RELAXED, __HIP_MEMORY_SCOPE_AGENT
#define LDS_WAIT() asm volatile("s_waitcnt lgkmcnt(0)" ::: "memory")
#define VM_WAIT() asm volatile("s_waitcnt vmcnt(0)" ::: "memory")
__device__ __forceinline__ void st16wt(void* p, v4u v) { asm volatile("global_store_dwordx4 %0, %1, off sc1\n\ts_nop 1" :: "v"(p), "v"(v) : "memory"); }
__device__ __forceinline__ void st8wt(void* p, v2u v) { asm volatile("global_store_dwordx2 %0, %1, off sc1\n\ts_nop 1" :: "v"(p), "v"(v) : "memory"); }
__device__ __forceinline__ unsigned f2bf(float f) { unsigned u = __builtin_bit_cast(unsigned, f); return (u + 0x7fffu + ((u >> 16) & 1u)) >> 16; }
__device__ __forceinline__ unsigned pk2(float lo, float hi) { return f2bf(lo) | (f2bf(hi) << 16); }
__device__ __forceinline__ float bf2f(unsigned short v) { return __builtin_bit_cast(float, (unsigned)v << 16); }
__device__ __forceinline__ float bflo(unsigned w) { return __builtin_bit_cast(float, w << 16); }
__device__ __forceinline__ float bfhi(unsigned w) { return __builtin_bit_cast(float, w & 0xffff0000u); }
__device__ __forceinline__ float fexp(float x) { return __builtin_amdgcn_exp2f(x * 1.4426950408889634f); }
__device__ __forceinline__ float frcp(float x) { return __builtin_amdgcn_rcpf(x); }
__device__ __forceinline__ float frsq(float x) { return __builtin_amdgcn_rsqf(x); }
__device__ __forceinline__ float geluf_(float v) { const float t = frcp(fabsf(v) * 0.2316418882f + 1.0f);
    float q = t * 0.5307027145f - 0.7265760135f; q = q * t + 0.7107068705f; q = q * t - 0.142248368f; q = q * t + 0.127414796f; q = q * t;
    const float m = v * (q * __builtin_amdgcn_exp2f(v * v * -0.72134752044f)); return v < 0.f ? m : v - m; }
__device__ __forceinline__ float sigmoidf_(float x) { const float e = fexp(-fabsf(x)), r = frcp(1.f + e); return x >= 0.f ? r : e * r; }
__device__ __forceinline__ float siluf_(float x) { return x * sigmoidf_(x); }
__device__ __forceinline__ bf16x8 pack8(const float* v) { v4u w; w.x = pk2(v[0], v[1]); w.y = pk2(v[2], v[3]); w.z = pk2(v[4], v[5]); w.w = pk2(v[6], v[7]); return __builtin_bit_cast(bf16x8, w); }
__device__ __forceinline__ void unpack8(v4u w, float* v) { v[0] = bflo(w.x); v[1] = bfhi(w.x); v[2] = bflo(w.y); v[3] = bfhi(w.y); v[4] = bflo(w.z); v[5] = bfhi(w.z); v[6] = bflo(w.w); v[7] = bfhi(w.w); }
__device__ __forceinline__ float shx(float v, int m, int lane) { return __builtin_bit_cast(float, __builtin_amdgcn_ds_bpermute((lane ^ m) << 2, __builtin_bit_cast(int, v))); }
__device__ __forceinline__ float shi(float v, int src) { return __builtin_bit_cast(float, __builtin_amdgcn_ds_bpermute(src << 2, __builtin_bit_cast(int, v))); }
__device__ __forceinline__ float wave_sum(float v, int lane) {
#pragma unroll
    for (int o = 1; o < 64; o <<= 1) v += shx(v, o, lane);
    return v;
}
__device__ __forceinline__ float hsum32(float a, float b) { auto r = __builtin_amdgcn_permlane32_swap(__builtin_bit_cast(unsigned, a), __builtin_bit_cast(unsigned, b), false, false); const unsigned r0 = r[0], r1 = r[1]; return __builtin_bit_cast(float, r0) + __builtin_bit_cast(float, r1); }
__device__ __forceinline__ float hsum16(float a, float b) { auto r = __builtin_amdgcn_permlane16_swap(__builtin_bit_cast(unsigned, a), __builtin_bit_cast(unsigned, b), false, false); const unsigned r0 = r[0], r1 = r[1]; return __builtin_bit_cast(float, r0) + __builtin_bit_cast(float, r1); }
__device__ __forceinline__ float hsum8(float a, float b, bool up) { asm volatile("" : "+v"(a), "+v"(b)); const float send = up ? a : b, keep = up ? b : a; return keep + __builtin_bit_cast(float, __builtin_amdgcn_update_dpp(0, __builtin_bit_cast(int, send), 0x128, 0xf, 0xf, false)); }
__device__ __forceinline__ float hsum4(float a, float b, bool up) { asm volatile("" : "+v"(a), "+v"(b)); const float send = up ? a : b, keep = up ? b : a;
    int t = __builtin_amdgcn_update_dpp(0, __builtin_bit_cast(int, send), 0x141, 0xf, 0xf, false); t = __builtin_amdgcn_update_dpp(0, t, 0x1b, 0xf, 0xf, false); return keep + __builtin_bit_cast(float, t); }
__device__ __forceinline__ float hsum2(float a, float b, bool up) { asm volatile("" : "+v"(a), "+v"(b)); const float send = up ? a : b, keep = up ? b : a; return keep + __builtin_bit_cast(float, __builtin_amdgcn_update_dpp(0, __builtin_bit_cast(int, send), 0x4e, 0xf, 0xf, false)); }
__device__ __forceinline__ float hsum1(float a, float b, bool up) { asm volatile("" : "+v"(a), "+v"(b)); const float send = up ? a : b, keep = up ? b : a; return keep + __builtin_bit_cast(float, __builtin_amdgcn_update_dpp(0, __builtin_bit_cast(int, send), 0xb1, 0xf, 0xf, false)); }
__device__ __forceinline__ float sum8lanes(float a) {
    a += __builtin_bit_cast(float, __builtin_amdgcn_update_dpp(0, __builtin_bit_cast(int, a), 0x141, 0xf, 0xf, false));
    a += __builtin_bit_cast(float, __builtin_amdgcn_update_dpp(0, __builtin_bit_cast(int, a), 0x1b, 0xf, 0xf, false));
    a += __builtin_bit_cast(float, __builtin_amdgcn_update_dpp(0, __builtin_bit_cast(int, a), 0xb1, 0xf, 0xf, false));
    return a; }
#define MFMA16(a, b, c) __builtin_amdgcn_mfma_f32_16x16x32_bf16((a), (b), (c), 0, 0, 0)
#define MFMA32(a, b, c) __builtin_amdgcn_mfma_f32_32x32x16_bf16((a), (b), (c), 0, 0, 0)
namespace pg8 {
#define PG8_LAS __attribute__((address_space(3)))
typedef unsigned short bf16_t;
typedef short bf16x8 __attribute__((ext_vector_type(8)));
typedef float f32x4 __attribute__((ext_vector_type(4)));
typedef unsigned u32x4 __attribute__((ext_vector_type(4)));
constexpr int BM = 256, BK = 64, HALF = 128, HTB = HALF * BK * 2  , STAGE_BYTES = 8 * HTB, NXCD = 8, WGM = 8;

__host__ __device__ __forceinline__ int lds_byte(int r, int c) { const int st = (r >> 4) * 2 + (c >> 5), rr = r & 15, cc = c & 31, ob = rr * 64 + cc * 2; return st * 1024 + (ob ^ (((ob >> 9) & 1) << 5)); }
__host__ __device__ __forceinline__ void stage_rc(int b, int& R, int& C) { const int st = b / 1024, sb = b % 1024, swz = sb ^ (((sb >> 9) & 1) << 5); R = (st >> 1) * 16 + swz / 64; C = (st & 1) * 32 + (swz % 64) / 2; }
__host__ __device__ __forceinline__ int perm32(int rho) { const int n = rho >> 4, i = rho & 15; return 8 * (i >> 2) + 4 * n + (i & 3); }

struct Unit { int pm, pn; };
struct Gemm { const bf16_t* A; const bf16_t* Bt; int M, N, K; };

struct StaticOrder {
    int nM, nN, nwg, G, c;
    __host__ __device__ void init(int M, int N, int G_, int c_) { nM = M / BM; nN = N / BM; nwg = nM * nN; G = G_; c = c_; }
    __host__ __device__ bool next(int i, Unit& u) const {
        const long L = (long)i * G + c; if (L >= nwg) return false;
        int wgid = (int)L; { const int q = nwg / NXCD, r = nwg % NXCD, xcd = wgid % NXCD, off = wgid / NXCD; wgid = (xcd < r ? xcd * (q + 1) : r * (q + 1) + (xcd - r) * q) + off; }
        const int nig = WGM * nN, gid = wgid / nig, fm = gid * WGM, gsz = (nM - fm) < WGM ? (nM - fm) : WGM;
        u.pm = fm + ((wgid % nig) % gsz); u.pn = (wgid % nig) / gsz; return true;
    }
    __device__ __forceinline__ void a_ready(const Unit&) const {}
    __device__ __forceinline__ void done(const Unit&) const {}
};

__device__ __forceinline__ unsigned cvt_pk_bf16(float lo, float hi) { unsigned r; asm volatile("v_cvt_pk_bf16_f32 %0, %1, %2" : "=v"(r) : "v"(lo), "v"(hi)); return r; }
typedef float f32x2 __attribute__((ext_vector_type(2)));
typedef unsigned u32x2 __attribute__((ext_vector_type(2)));
__device__ __forceinline__ void st16_wt(void* p, u32x4 v) {
#if MK_WT_STORES
    asm volatile("global_store_dwordx4 %0, %1, off sc1\n\ts_nop 1" :: "v"(p), "v"(v) : "memory");
#else
    *(u32x4*)p = v;
#endif
}
struct EpiBf16 {
    static constexpr bool PERM = true, AFTER_DRAIN = false;
    bf16_t* O; int ldc;
    __device__ __forceinline__ void operator()(const f32x4 (&acc)[2][2][4][2], const Unit& u, int wr, int wc, int fr, int fq) const {
        const int row0 = u.pm * BM + wr * 64 + fr; const int col0 = u.pn * BM + wc * 32 + 8 * fq;
#pragma unroll
        for (int ai = 0; ai < 2; ++ai)
#pragma unroll
            for (int m = 0; m < 4; ++m) { bf16_t* rowp = O + (size_t)(row0 + ai * HALF + m * 16) * ldc + col0;
#pragma unroll
                for (int bj = 0; bj < 2; ++bj) { const f32x4 v0 = acc[ai][bj][m][0], v1 = acc[ai][bj][m][1];
                    u32x4 w; w.x = cvt_pk_bf16(v0[0], v0[1]); w.y = cvt_pk_bf16(v0[2], v0[3]); w.z = cvt_pk_bf16(v1[0], v1[1]); w.w = cvt_pk_bf16(v1[2], v1[3]);
                    st16_wt(rowp + bj * HALF, w); } }
    }
};
struct EpiProj {
    static constexpr bool PERM = true, AFTER_DRAIN = false;
    bf16_t* O; int ldc; float* dt; const PG8_LAS float* rsl; int xg; const float* ssq8; bool scale;
    __device__ __forceinline__ void operator()(const f32x4 (&acc)[2][2][4][2], const Unit& u, int wr, int wc, int fr, int fq) const {
        const int rl0 = wr * 64 + fr, row0 = u.pm * BM + rl0; const int col0 = u.pn * BM + wc * 32 + 8 * fq;
        float sc[2][4];
        if ((u.pm >> 3) == xg) {
#pragma unroll
            for (int ai = 0; ai < 2; ++ai)
#pragma unroll
                for (int m = 0; m < 4; ++m) sc[ai][m] = rsl[(u.pm & 7) * BM + rl0 + ai * HALF + m * 16];
        } else {
#pragma unroll
            for (int ai = 0; ai < 2; ++ai)
#pragma unroll
                for (int m = 0; m < 4; ++m) { sc[ai][m] = 1.f; if (scale) { const float* pp = ssq8 + (size_t)(row0 + ai * HALF + m * 16) * 8; const f32x4 a = *(const f32x4*)pp, b = *(const f32x4*)(pp + 4);
                    sc[ai][m] = __builtin_amdgcn_rsqf((((a[0] + a[1]) + (a[2] + a[3])) + ((b[0] + b[1]) + (b[2] + b[3]))) * (1.f / 1024.f) + 1e-6f); } }
        }
        if (u.pn == 31) {
            if (wc == 0 && fq == 0) {
#pragma unroll
                for (int ai = 0; ai < 2; ++ai)
#pragma unroll
                    for (int m = 0; m < 4; ++m) { float* dp = dt + (size_t)(row0 + ai * HALF + m * 16) * 8; *(f32x4*)dp = acc[ai][0][m][0] * sc[ai][m]; *(f32x4*)(dp + 4) = acc[ai][0][m][1] * sc[ai][m]; }
            }
            return;
        }
#pragma unroll
        for (int ai = 0; ai < 2; ++ai)
#pragma unroll
            for (int m = 0; m < 4; ++m) { bf16_t* rowp = O + (size_t)(row0 + ai * HALF + m * 16) * ldc + col0;
#pragma unroll
                for (int bj = 0; bj < 2; ++bj) { const f32x4 v0 = acc[ai][bj][m][0] * sc[ai][m], v1 = acc[ai][bj][m][1] * sc[ai][m];
                    u32x4 w; w.x = cvt_pk_bf16(v0[0], v0[1]); w.y = cvt_pk_bf16(v0[2], v0[3]); w.z = cvt_pk_bf16(v1[0], v1[1]); w.w = cvt_pk_bf16(v1[2], v1[3]);
                    st16_wt(rowp + bj * HALF, w); } }
    }
};
struct EpiF32 {
    static constexpr bool PERM = false, AFTER_DRAIN = false;
    float* C; int ldc;
    __device__ __forceinline__ void operator()(const f32x4 (&acc)[2][2][4][2], const Unit& u, int wr, int wc, int fr, int fq) const {
        const int row0 = u.pm * BM + wr * 64 + fr, col0 = u.pn * BM + wc * 32 + 4 * fq;
#pragma unroll
        for (int ai = 0; ai < 2; ++ai)
#pragma unroll
            for (int m = 0; m < 4; ++m) { float* rowp = C + (size_t)(row0 + ai * HALF + m * 16) * ldc + col0;
#pragma unroll
                for (int bj = 0; bj < 2; ++bj)
#pragma unroll
                    for (int n = 0; n < 2; ++n) st16_wt(rowp + bj * HALF + n * 16, __builtin_bit_cast(u32x4, acc[ai][bj][m][n])); }
    }
};
struct EpiF16 {
    static constexpr bool PERM = true, AFTER_DRAIN = false;
    _Float16* C; int ldc;
    __device__ __forceinline__ void operator()(const f32x4 (&acc)[2][2][4][2], const Unit& u, int wr, int wc, int fr, int fq) const {
        typedef _Float16 h2 __attribute__((ext_vector_type(2)));
        const int row0 = u.pm * BM + wr * 64 + fr; const int col0 = u.pn * BM + wc * 32 + 8 * fq;
#pragma unroll
        for (int ai = 0; ai < 2; ++ai)
#pragma unroll
            for (int m = 0; m < 4; ++m) { _Float16* rowp = C + (size_t)(row0 + ai * HALF + m * 16) * ldc + col0;
#pragma unroll
                for (int bj = 0; bj < 2; ++bj) { const f32x4 v0 = acc[ai][bj][m][0], v1 = acc[ai][bj][m][1];
                    const h2 a = {(_Float16)v0[0], (_Float16)v0[1]}, b = {(_Float16)v0[2], (_Float16)v0[3]}, c = {(_Float16)v1[0], (_Float16)v1[1]}, d = {(_Float16)v1[2], (_Float16)v1[3]};
                    u32x4 w; w.x = __builtin_bit_cast(unsigned, a); w.y = __builtin_bit_cast(unsigned, b); w.z = __builtin_bit_cast(unsigned, c); w.w = __builtin_bit_cast(unsigned, d);
                    st16_wt(rowp + bj * HALF, w); } }
    }
};
template <bool DRY> struct EpiResF32 {
    static constexpr bool PERM = false, AFTER_DRAIN = false;
    float* C; int ldc;
    __device__ __forceinline__ void operator()(const f32x4 (&acc)[2][2][4][2], const Unit& u, int wr, int wc, int fr, int fq) const {
        const int row0 = u.pm * BM + wr * 64 + fr, col0 = u.pn * BM + wc * 32 + 4 * fq;
#pragma unroll
        for (int ai = 0; ai < 2; ++ai)
#pragma unroll
            for (int m = 0; m < 4; ++m) { float* rowp = C + (size_t)(row0 + ai * HALF + m * 16) * ldc + col0;
                f32x4 old[2][2];
#pragma unroll
                for (int bj = 0; bj < 2; ++bj)
#pragma unroll
                    for (int n = 0; n < 2; ++n) old[bj][n] = *(const f32x4*)(rowp + bj * HALF + n * 16);
#pragma unroll
                for (int bj = 0; bj < 2; ++bj)
#pragma unroll
                    for (int n = 0; n < 2; ++n) { const f32x4 r = old[bj][n] + acc[ai][bj][m][n]; if constexpr (!DRY) *(f32x4*)(rowp + bj * HALF + n * 16) = r; else asm volatile("" :: "v"(r)); } }
    }
};
template <bool CIN_F32> struct EpiResNorm {
    static constexpr bool PERM = true, AFTER_DRAIN = false;
    const void* Cin; bf16_t* C; int ldc; const float* w; bf16_t* XW; float* ssq;
    __device__ __forceinline__ void operator()(const f32x4 (&acc)[2][2][4][2], const Unit& u, int wr, int wc, int fr, int fq) const {
        const int row0 = u.pm * BM + wr * 64 + fr, col0 = u.pn * BM + wc * 32 + 8 * fq;
        f32x4 wv[2][2];
#pragma unroll
        for (int bj = 0; bj < 2; ++bj)
#pragma unroll
            for (int n = 0; n < 2; ++n) wv[bj][n] = *(const f32x4*)(w + col0 + bj * HALF + 4 * n);
        f32x4 xf[3][2][2]; u32x4 xh[3][2];
#define ERN_LD(i, s) do { const size_t ro_ = (size_t)(row0 + ((i) >> 2) * HALF + ((i) & 3) * 16) * ldc + col0; \
            if constexpr (CIN_F32) { _Pragma("unroll") for (int bj = 0; bj < 2; ++bj) _Pragma("unroll") for (int n = 0; n < 2; ++n) xf[s][bj][n] = *(const f32x4*)((const float*)Cin + ro_ + bj * HALF + 4 * n); } \
            else { _Pragma("unroll") for (int bj = 0; bj < 2; ++bj) xh[s][bj] = *(const u32x4*)((const bf16_t*)Cin + ro_ + bj * HALF); } } while (0)
#define ERN_COMP(i, s) do { constexpr int ai = (i) >> 2, m = (i) & 3; const size_t row = (size_t)(row0 + ai * HALF + m * 16); float ss = 0.f; \
            _Pragma("unroll") for (int bj = 0; bj < 2; ++bj) { f32x4 xx[2]; \
                if constexpr (CIN_F32) { xx[0] = xf[s][bj][0]; xx[1] = xf[s][bj][1]; } \
                else { const u32x4 q_ = xh[s][bj]; xx[0] = (f32x4){__builtin_bit_cast(float, q_.x << 16), __builtin_bit_cast(float, q_.x & 0xffff0000u), __builtin_bit_cast(float, q_.y << 16), __builtin_bit_cast(float, q_.y & 0xffff0000u)}; \
                       xx[1] = (f32x4){__builtin_bit_cast(float, q_.z << 16), __builtin_bit_cast(float, q_.z & 0xffff0000u), __builtin_bit_cast(float, q_.w << 16), __builtin_bit_cast(float, q_.w & 0xffff0000u)}; } \
                _Pragma("unroll") for (int n = 0; n < 2; ++n) { xx[n] = xx[n] + acc[ai][bj][m][n]; \
                    ss += (xx[n][0] * xx[n][0] + xx[n][1] * xx[n][1]) + (xx[n][2] * xx[n][2] + xx[n][3] * xx[n][3]); } \
                u32x4 xo; xo.x = cvt_pk_bf16(xx[0][0], xx[0][1]); xo.y = cvt_pk_bf16(xx[0][2], xx[0][3]); xo.z = cvt_pk_bf16(xx[1][0], xx[1][1]); xo.w = cvt_pk_bf16(xx[1][2], xx[1][3]); \
                *(u32x4*)(C + row * ldc + col0 + bj * HALF) = xo; \
                const f32x4 y0 = xx[0] * wv[bj][0], y1 = xx[1] * wv[bj][1]; \
                u32x4 o; o.x = cvt_pk_bf16(y0[0], y0[1]); o.y = cvt_pk_bf16(y0[2], y0[3]); o.z = cvt_pk_bf16(y1[0], y1[1]); o.w = cvt_pk_bf16(y1[2], y1[3]); \
                *(u32x4*)(XW + row * ldc + col0 + bj * HALF) = o; } \
              \
            { auto r1 = __builtin_amdgcn_permlane16_swap(__builtin_bit_cast(unsigned, ss), __builtin_bit_cast(unsigned, ss), false, false); const unsigned a1 = r1[0], b1 = r1[1]; ss = __builtin_bit_cast(float, a1) + __builtin_bit_cast(float, b1); \
              auto r2 = __builtin_amdgcn_permlane32_swap(__builtin_bit_cast(unsigned, ss), __builtin_bit_cast(unsigned, ss), false, false); const unsigned a2 = r2[0], b2 = r2[1]; ss = __builtin_bit_cast(float, a2) + __builtin_bit_cast(float, b2); } \
            if (fq == 0) ssq[row * 16 + 4 * u.pn + wc] = ss; } while (0)
        ERN_LD(0, 0); ERN_LD(1, 1); ERN_LD(2, 2);
        ERN_COMP(0, 0); ERN_LD(3, 0); ERN_COMP(1, 1); ERN_LD(4, 1); ERN_COMP(2, 2); ERN_LD(5, 2); ERN_COMP(3, 0); ERN_LD(6, 0); ERN_COMP(4, 1); ERN_LD(7, 1); ERN_COMP(5, 2); ERN_COMP(6, 0); ERN_COMP(7, 1);
#undef ERN_LD
#undef ERN_COMP
    }
};
struct EpiMerge {
    static constexpr bool PERM = true, AFTER_DRAIN = false;
    const bf16_t* gate; int ldg;
    bf16_t* O; int ldc;
    __device__ __forceinline__ void operator()(const f32x4 (&acc)[2][2][4][2], const Unit& u, int wr, int wc, int fr, int fq) const {
        const int br = u.pm >> 6, pm = u.pm & 63, pn = u.pn & 3;
        const int row0 = pm * BM + wr * 64 + fr, col0 = pn * BM + wc * 32 + 8 * fq;
        const bf16_t* gbase = gate + (size_t)row0 * ldg + br * 1024 + col0; bf16_t* obase = O + (size_t)row0 * ldc + col0;
        u32x4 gq[2][4], oq[2][4];
#define EMG_LD(b, s) do { _Pragma("unroll") for (int mm = 0; mm < 2; ++mm) _Pragma("unroll") for (int bj = 0; bj < 2; ++bj) { const size_t r = (size_t)(((b) >> 1) * HALF + (2 * ((b) & 1) + mm) * 16); \
            gq[s][mm * 2 + bj] = *(const u32x4*)(gbase + r * ldg + bj * HALF); oq[s][mm * 2 + bj] = *(const u32x4*)(obase + r * ldc + bj * HALF); } } while (0)
#define EMG_COMP(b, s) do { _Pragma("unroll") for (int mm = 0; mm < 2; ++mm) _Pragma("unroll") for (int bj = 0; bj < 2; ++bj) { constexpr int ai = (b) >> 1; const int m = 2 * ((b) & 1) + mm; const size_t r = (size_t)(ai * HALF + m * 16); \
            const u32x4 gw = gq[s][mm * 2 + bj]; \
            float v[8] = {acc[ai][bj][m][0][0], acc[ai][bj][m][0][1], acc[ai][bj][m][0][2], acc[ai][bj][m][0][3], acc[ai][bj][m][1][0], acc[ai][bj][m][1][1], acc[ai][bj][m][1][2], acc[ai][bj][m][1][3]}; \
            float g[8]; { g[0] = __builtin_bit_cast(float, gw.x << 16); g[1] = __builtin_bit_cast(float, gw.x & 0xffff0000u); g[2] = __builtin_bit_cast(float, gw.y << 16); g[3] = __builtin_bit_cast(float, gw.y & 0xffff0000u); \
                          g[4] = __builtin_bit_cast(float, gw.z << 16); g[5] = __builtin_bit_cast(float, gw.z & 0xffff0000u); g[6] = __builtin_bit_cast(float, gw.w << 16); g[7] = __builtin_bit_cast(float, gw.w & 0xffff0000u); } \
            _Pragma("unroll") for (int j = 0; j < 8; ++j) {   v[j] *= __builtin_amdgcn_rcpf(1.f + __builtin_amdgcn_exp2f(g[j] * -1.4426950408889634f)); } \
            if (br != 0) { const u32x4 ow = oq[s][mm * 2 + bj]; \
                v[0] += __builtin_bit_cast(float, ow.x << 16); v[1] += __builtin_bit_cast(float, ow.x & 0xffff0000u); v[2] += __builtin_bit_cast(float, ow.y << 16); v[3] += __builtin_bit_cast(float, ow.y & 0xffff0000u); \
                v[4] += __builtin_bit_cast(float, ow.z << 16); v[5] += __builtin_bit_cast(float, ow.z & 0xffff0000u); v[6] += __builtin_bit_cast(float, ow.w << 16); v[7] += __builtin_bit_cast(float, ow.w & 0xffff0000u); } \
            u32x4 wq; wq.x = cvt_pk_bf16(v[0], v[1]); wq.y = cvt_pk_bf16(v[2], v[3]); wq.z = cvt_pk_bf16(v[4], v[5]); wq.w = cvt_pk_bf16(v[6], v[7]); \
            *(u32x4*)(obase + r * ldc + bj * HALF) = wq; } } while (0)
        EMG_LD(0, 0); EMG_LD(1, 1); EMG_COMP(0, 0); EMG_LD(2, 0); EMG_COMP(1, 1); EMG_LD(3, 1); EMG_COMP(2, 0); EMG_COMP(3, 1);
#undef EMG_LD
#undef EMG_COMP
    }
};
struct EpiMerge2 {
    static constexpr bool PERM = true, AFTER_DRAIN = false;
    const bf16_t* gate; int ldg;
    bf16_t* O; int ldc;
    __device__ __forceinline__ void operator()(f32x4 (&acc)[2][2][4][2], const Unit& u, int wr, int wc, int fr, int fq) const {
        const int br = u.pm >> 6, pm = u.pm & 63, pn = u.pn & 3;
        const int row0 = pm * BM + wr * 64 + fr, col0 = pn * BM + wc * 32 + 8 * fq;
        const bf16_t* gbase = gate + (size_t)row0 * ldg + br * 1024 + col0; bf16_t* obase = O + (size_t)row0 * ldc + col0;
        const int nxo = br < 2 ? 1024 : 0;
        u32x4 gq[2][4], hq[2][4];
#define EM2_LD(b, s) do { _Pragma("unroll") for (int mm = 0; mm < 2; ++mm) _Pragma("unroll") for (int bj = 0; bj < 2; ++bj) { const size_t r = (size_t)(((b) >> 1) * HALF + (2 * ((b) & 1) + mm) * 16); \
            gq[s][mm * 2 + bj] = *(const u32x4*)(gbase + r * ldg + bj * HALF); hq[s][mm * 2 + bj] = *(const u32x4*)(gbase + r * ldg + bj * HALF + nxo); } } while (0)
#define EM2_E(x) __builtin_amdgcn_exp2f(__builtin_amdgcn_fmed3f((x), -30.f, 30.f) * -1.4426950408889634f)
#define EM2_COMP(b, s) do { _Pragma("unroll") for (int mm = 0; mm < 2; ++mm) _Pragma("unroll") for (int bj = 0; bj < 2; ++bj) { constexpr int ai = (b) >> 1; const int m = 2 * ((b) & 1) + mm; const size_t r = (size_t)(ai * HALF + m * 16); \
            const u32x4 gw = gq[s][mm * 2 + bj], hw = hq[s][mm * 2 + bj]; \
            const float g[8] = {__builtin_bit_cast(float, gw.x << 16), __builtin_bit_cast(float, gw.x & 0xffff0000u), __builtin_bit_cast(float, gw.y << 16), __builtin_bit_cast(float, gw.y & 0xffff0000u), \
                                __builtin_bit_cast(float, gw.z << 16), __builtin_bit_cast(float, gw.z & 0xffff0000u), __builtin_bit_cast(float, gw.w << 16), __builtin_bit_cast(float, gw.w & 0xffff0000u)}; \
            const float hh[8] = {__builtin_bit_cast(float, hw.x << 16), __builtin_bit_cast(float, hw.x & 0xffff0000u), __builtin_bit_cast(float, hw.y << 16), __builtin_bit_cast(float, hw.y & 0xffff0000u), \
                                 __builtin_bit_cast(float, hw.z << 16), __builtin_bit_cast(float, hw.z & 0xffff0000u), __builtin_bit_cast(float, hw.w << 16), __builtin_bit_cast(float, hw.w & 0xffff0000u)}; \
            float f[8]; \
            if (br < 2) { _Pragma("unroll") for (int j = 0; j < 8; ++j) f[j] = (1.f + EM2_E(hh[j])) * __builtin_amdgcn_rcpf(1.f + EM2_E(g[j])); } \
            else        { _Pragma("unroll") for (int j = 0; j < 8; ++j) f[j] = __builtin_amdgcn_rcpf(1.f + EM2_E(g[j])); } \
            _Pragma("unroll") for (int j = 0; j < 8; ++j) acc[ai][bj][m][j >> 2][j & 3] *= f[j]; \
            if (br == 2) { u32x4 wq; wq.x = cvt_pk_bf16(acc[ai][bj][m][0][0], acc[ai][bj][m][0][1]); wq.y = cvt_pk_bf16(acc[ai][bj][m][0][2], acc[ai][bj][m][0][3]); \
                wq.z = cvt_pk_bf16(acc[ai][bj][m][1][0], acc[ai][bj][m][1][1]); wq.w = cvt_pk_bf16(acc[ai][bj][m][1][2], acc[ai][bj][m][1][3]); \
                *(u32x4*)(obase + r * ldc + bj * HALF) = wq; } } } while (0)
        EM2_LD(0, 0); EM2_LD(1, 1); EM2_COMP(0, 0); EM2_LD(2, 0); EM2_COMP(1, 1); EM2_LD(3, 1); EM2_COMP(2, 0); EM2_COMP(3, 1);
#undef EM2_LD
#undef EM2_E
#undef EM2_COMP
    }
};
template <class Epi> __device__ __forceinline__ bool epi_keep(const Epi&, const Unit&) { return false; }
__device__ __forceinline__ bool epi_keep(const EpiMerge2&, const Unit& u) { return (u.pm >> 6) < 2; }
struct MergeOrder {
    int v, G;
    __device__ __forceinline__ bool next(int i, Unit& u) const { const int bi = i / 3, br = i - bi * 3; const long L = (long)bi * G + v; if (L >= 256) return false;
        u.pm = br * 64 + (int)(L >> 2); u.pn = br * 4 + (int)(L & 3); return true; }
    __device__ __forceinline__ void a_ready(const Unit&) const {}
    __device__ __forceinline__ void done(const Unit&) const {}
};
template <class Epi, class Sched, bool ALIGN_EPI = false, bool SP2 = false>
__device__ __forceinline__ void gemm_phase(PG8_LAS unsigned char* lds, const Gemm g, const Sched& S, const Epi& E, int tid_) {
    const int tid = tid_, wid = __builtin_amdgcn_readfirstlane(tid >> 6), lane = tid & 63, wr = wid >> 2, wc = wid & 3, fr = lane & 15, fq = lane >> 4;
    const int K = g.K, nt = K / BK;
    unsigned voffA[2], voffB[2];
#pragma unroll
    for (int i = 0; i < 2; ++i) { int R, C; stage_rc(tid * 16 + i * 8192, R, C); const int Rb = Epi::PERM ? ((R & ~31) + perm32(R & 31)) : R;
        voffA[i] = (unsigned)(R * K + C) * 2u; voffB[i] = (unsigned)(Rb * K + C) * 2u; }
    const size_t kstep = (size_t)(BK * 2);
    const size_t hstep = (size_t)HALF * K * 2;
    const size_t tstep = 2 * hstep;
    const unsigned ldsw = (unsigned)wid * 1024u;
    const int aoff = lds_byte(wr * 64 + fr, fq * 8), boff = lds_byte(wc * 32 + fr, fq * 8);
#define PG8_SA(b, h) (((b) * 2 + (h)) * HTB)
#define PG8_SB(b, h) ((4 + (b) * 2 + (h)) * HTB)
#define PG8_STAGE(bufoff, gbase, voff) do { _Pragma("unroll") for (int _i = 0; _i < 2; ++_i) \
        __builtin_amdgcn_global_load_lds((const unsigned*)((const char*)(gbase) + (voff)[_i]), (PG8_LAS unsigned*)(lds + (bufoff) + ldsw + _i * 8192), 16, 0, 0); } while (0)
#define PG8_LDA(dst, b, h) do { _Pragma("unroll") for (int m = 0; m < 4; ++m) _Pragma("unroll") for (int k = 0; k < 2; ++k) dst[m][k] = *(const PG8_LAS bf16x8*)(lds + PG8_SA(b, h) + aoff + m * 2048 + k * 1024); } while (0)
#define PG8_LDB(dst, b, h) do { _Pragma("unroll") for (int n = 0; n < 2; ++n) _Pragma("unroll") for (int k = 0; k < 2; ++k) dst[n][k] = *(const PG8_LAS bf16x8*)(lds + PG8_SB(b, h) + boff + n * 2048 + k * 1024); } while (0)
#define PG8_MMA(ai, bj, At, Bt) do { __builtin_amdgcn_s_setprio(1); _Pragma("unroll") for (int m = 0; m < 4; ++m) _Pragma("unroll") for (int n = 0; n < 2; ++n) _Pragma("unroll") for (int k = 0; k < 2; ++k) \
        acc[ai][bj][m][n] = __builtin_amdgcn_mfma_f32_16x16x32_bf16(Bt[n][k], At[m][k], acc[ai][bj][m][n], 0, 0, 0); __builtin_amdgcn_s_setprio(0); } while (0)
#define PG8_WAIT_V(n) asm volatile("s_waitcnt vmcnt(" #n ")" ::: "memory")
#define PG8_WAIT_L(n) asm volatile("s_waitcnt lgkmcnt(" #n ")" ::: "memory")
#define PG8_BAR __builtin_amdgcn_s_barrier()
#define PG8_SCHED __builtin_amdgcn_sched_barrier(0)
    Unit cur, nxt; int ui = 0;
    if (!S.next(0, cur)) return;
    f32x4 acc[2][2][4][2];
#pragma unroll
    for (int a = 0; a < 2; ++a)
#pragma unroll
        for (int b = 0; b < 2; ++b)
#pragma unroll
            for (int m = 0; m < 4; ++m)
#pragma unroll
                for (int n = 0; n < 2; ++n) acc[a][b][m][n] = (f32x4){0.f, 0.f, 0.f, 0.f};
    bf16x8 At[4][2], B0[2][2], B1[2][2];
    const char* cA = (const char*)g.A + (size_t)cur.pm * tstep; const char* cB = (const char*)g.Bt + (size_t)cur.pn * tstep;
    S.a_ready(cur);
    if constexpr (SP2) {
        PG8_STAGE(PG8_SB(0, 0), cB, voffB); PG8_STAGE(PG8_SB(0, 1), cB + hstep, voffB); PG8_STAGE(PG8_SA(0, 0), cA, voffA); PG8_STAGE(PG8_SA(0, 1), cA + hstep, voffA);
        if (wr == 1) PG8_BAR;
        PG8_WAIT_V(2); PG8_BAR;
        PG8_STAGE(PG8_SB(1, 0), cB + kstep, voffB); PG8_STAGE(PG8_SA(1, 0), cA + kstep, voffA); PG8_STAGE(PG8_SB(1, 1), cB + hstep + kstep, voffB);
        PG8_WAIT_V(6); PG8_BAR;
    } else {
        PG8_STAGE(PG8_SB(0, 0), cB, voffB); PG8_STAGE(PG8_SA(0, 0), cA, voffA); PG8_STAGE(PG8_SB(0, 1), cB + hstep, voffB); PG8_STAGE(PG8_SA(0, 1), cA + hstep, voffA);
        if (wr == 1) PG8_BAR;
        PG8_WAIT_V(4); PG8_BAR;
        PG8_STAGE(PG8_SB(1, 0), cB + kstep, voffB); PG8_STAGE(PG8_SA(1, 0), cA + kstep, voffA); PG8_STAGE(PG8_SB(1, 1), cB + hstep + kstep, voffB);
        PG8_WAIT_V(6); PG8_BAR;
    }
    for (;;) {
        const bool has_next = S.next(ui + 1, nxt);
        const char* nA = has_next ? (const char*)g.A + (size_t)nxt.pm * tstep : cA; const char* nB = has_next ? (const char*)g.Bt + (size_t)nxt.pn * tstep : cB;
        for (int t = 0; t < nt; t += 2) {
            const bool last = (t == nt - 2);
            const char* a1 = cA + (size_t)(t + 1) * kstep;
            const char* a2 = last ? nA : cA + (size_t)(t + 2) * kstep; const char* b2 = last ? nB : cB + (size_t)(t + 2) * kstep;
            const char* a3 = a2 + kstep; const char* b3 = b2 + kstep;
            if (last && has_next) S.a_ready(nxt);
            if constexpr (SP2) {
            PG8_LDB(B0, 0, 0); PG8_LDB(B1, 0, 1); PG8_SCHED; PG8_LDA(At, 0, 0); PG8_STAGE(PG8_SA(1, 1), a1 + hstep, voffA);
            PG8_WAIT_V(8); PG8_WAIT_L(0); PG8_BAR; PG8_MMA(0, 0, At, B0); PG8_MMA(0, 1, At, B1); PG8_BAR; PG8_SCHED;
            PG8_LDA(At, 0, 1); PG8_STAGE(PG8_SB(0, 0), b2, voffB); PG8_STAGE(PG8_SB(0, 1), b2 + hstep, voffB); PG8_STAGE(PG8_SA(0, 0), a2, voffA);
            PG8_WAIT_V(8); PG8_WAIT_L(0); PG8_BAR; PG8_MMA(1, 0, At, B0); PG8_MMA(1, 1, At, B1); PG8_BAR; PG8_SCHED;
            PG8_LDB(B0, 1, 0); PG8_LDB(B1, 1, 1); PG8_SCHED; PG8_LDA(At, 1, 0); PG8_STAGE(PG8_SA(0, 1), a2 + hstep, voffA);
            PG8_WAIT_V(8); PG8_WAIT_L(0); PG8_BAR; PG8_MMA(0, 0, At, B0); PG8_MMA(0, 1, At, B1); PG8_BAR; PG8_SCHED;
            PG8_LDA(At, 1, 1); PG8_STAGE(PG8_SB(1, 0), b3, voffB); PG8_STAGE(PG8_SB(1, 1), b3 + hstep, voffB); PG8_STAGE(PG8_SA(1, 0), a3, voffA);
            PG8_WAIT_V(8); PG8_WAIT_L(0); PG8_BAR; PG8_MMA(1, 0, At, B0); PG8_MMA(1, 1, At, B1); PG8_BAR; PG8_SCHED;
            } else {
            PG8_LDB(B0, 0, 0); PG8_SCHED; PG8_LDA(At, 0, 0); PG8_STAGE(PG8_SA(1, 1), a1 + hstep, voffA);
            PG8_WAIT_L(8); PG8_BAR; PG8_WAIT_L(0); PG8_MMA(0, 0, At, B0); PG8_BAR; PG8_SCHED;
            PG8_LDB(B1, 0, 1); PG8_STAGE(PG8_SB(0, 0), b2, voffB);
            PG8_BAR; PG8_WAIT_L(0); PG8_MMA(0, 1, At, B1); PG8_BAR;
            PG8_LDA(At, 0, 1); PG8_STAGE(PG8_SA(0, 0), a2, voffA);
            PG8_BAR; PG8_WAIT_L(0); PG8_MMA(1, 0, At, B0); PG8_BAR; PG8_SCHED;
            PG8_STAGE(PG8_SB(0, 1), b2 + hstep, voffB);
            PG8_WAIT_V(6); PG8_BAR; PG8_MMA(1, 1, At, B1); PG8_BAR;
            PG8_LDB(B0, 1, 0); PG8_SCHED; PG8_LDA(At, 1, 0); PG8_STAGE(PG8_SA(0, 1), a2 + hstep, voffA);
            PG8_WAIT_L(8); PG8_BAR; PG8_WAIT_L(0); PG8_MMA(0, 0, At, B0); PG8_BAR; PG8_SCHED;
            PG8_LDB(B1, 1, 1); PG8_STAGE(PG8_SB(1, 0), b3, voffB);
            PG8_BAR; PG8_WAIT_L(0); PG8_MMA(0, 1, At, B1); PG8_BAR;
            PG8_LDA(At, 1, 1); PG8_STAGE(PG8_SA(1, 0), a3, voffA);
            PG8_BAR; PG8_WAIT_L(0); PG8_MMA(1, 0, At, B0); PG8_BAR; PG8_SCHED;
            PG8_STAGE(PG8_SB(1, 1), b3 + hstep, voffB);
            PG8_WAIT_V(6); PG8_BAR; PG8_MMA(1, 1, At, B1); PG8_BAR;
            }
        }
        if constexpr (ALIGN_EPI) { if (wr == 0) PG8_BAR; }
        if constexpr (!Epi::AFTER_DRAIN) { E(acc, cur, wr, wc, fr, fq); S.done(cur); }
        if (!has_next) break;
        if (!epi_keep(E, cur)) {
#pragma unroll
        for (int a = 0; a < 2; ++a)
#pragma unroll
            for (int b = 0; b < 2; ++b)
#pragma unroll
                for (int m = 0; m < 4; ++m)
#pragma unroll
                    for (int n = 0; n < 2; ++n) acc[a][b][m][n] = (f32x4){0.f, 0.f, 0.f, 0.f}; }
        cur = nxt; cA = nA; cB = nB; ++ui;
        if constexpr (ALIGN_EPI) { if (wr == 1) PG8_BAR; }
    }
    PG8_WAIT_V(0);
    if constexpr (!ALIGN_EPI) { if (wr == 0) PG8_BAR; }
    PG8_BAR;
    if constexpr (Epi::AFTER_DRAIN) { E.fused(acc, cur, wr, wc, fr, fq, lds, wid, lane); S.done(cur); }
#undef PG8_SA
#undef PG8_SB
#undef PG8_STAGE
#undef PG8_LDA
#undef PG8_LDB
#undef PG8_MMA
#undef PG8_WAIT_V
#undef PG8_WAIT_L
#undef PG8_BAR
#undef PG8_SCHED
}
}
constexpr int CW_BAR = 4096;
__device__ __forceinline__ unsigned long long rt() { return __builtin_amdgcn_s_memrealtime(); }
#define XB_TMO      128
#define XB_XCNT(j)  (256  + 64 * (j))
#define XB_XSUB(j)  (1280 + 64 * (j))
#define XB_XGEN(j)  (2304 + 64 * (j))
#define XB_TOP      3328
#define XB_TOPGEN   3392
#define XCD_BAR_WORDS 3456
#define XB_SPIN_CAP (1u << 18)

__device__ __forceinline__ unsigned xb_ld(unsigned* p)              { return __hip_atomic_load(p, __ATOMIC_RELAXED, __HIP_MEMORY_SCOPE_AGENT); }
__device__ __forceinline__ unsigned xb_add(unsigned* p, unsigned v) { return __hip_atomic_fetch_add(p, v, __ATOMIC_RELAXED, __HIP_MEMORY_SCOPE_AGENT); }
__device__ __forceinline__ unsigned xb_xcc_id() { return (unsigned)__builtin_amdgcn_s_getreg((3 << 11) | 20) & 0xFu; }
#define XB_SPIN(cond, bar) do { unsigned _sp = 0; while (cond) { __builtin_amdgcn_s_sleep(1); \
    if ((++_sp & 255u) == 0u) { if (xb_ld(&(bar)[XB_TMO])) break; if (_sp > XB_SPIN_CAP) { atomicAdd(&(bar)[XB_TMO], 1u); break; } } } } while (0)

struct XcdBarrier {
    unsigned* bar; unsigned x;
    volatile LAS unsigned* st;
};

__device__ __forceinline__ XcdBarrier xcd_barrier_post(unsigned* bar, volatile LAS unsigned* st, int tid) {
    XcdBarrier b; b.bar = bar; b.x = xb_xcc_id(); b.st = st;
    if (tid == 0) (void)xb_add(&bar[XB_XCNT(b.x)], 1u);
    return b;
}
__device__ __forceinline__ void xcd_barrier_complete(unsigned* bar, unsigned x, unsigned& nloc, unsigned& nx) {
    const unsigned G = gridDim.x * gridDim.y * gridDim.z;
    unsigned sum, cnt, mine, sp = 0u;
    for (;;) {
        sum = 0u; cnt = 0u; mine = 0u;
#pragma unroll
        for (unsigned j = 0; j < 16; ++j) { const unsigned c = xb_ld(&bar[XB_XCNT(j)]); sum += c; cnt += (c > 0u) ? 1u : 0u; mine = (j == x) ? c : mine; }
        if (sum == G) break;
        __builtin_amdgcn_s_sleep(1);
        if ((++sp & 255u) == 0u) { if (xb_ld(&bar[XB_TMO])) break; if (sp > XB_SPIN_CAP) { atomicAdd(&bar[XB_TMO], 1u); break; } }
    }
    nloc = mine > 0u ? mine : 1u; nx = cnt > 0u ? cnt : 1u;
}

__device__ __forceinline__ void xcd_barrier(const XcdBarrier& b, int tid) {
    asm volatile("s_waitcnt vmcnt(0)" ::: "memory");
    __syncthreads();
    if (tid == 0) {
        unsigned* bar = b.bar;
        __builtin_amdgcn_s_waitcnt(0);
        unsigned nloc = b.st[0], nx = b.st[1];
        if (nloc == 0u) { xcd_barrier_complete(bar, b.x, nloc, nx); b.st[0] = nloc; b.st[1] = nx; }
        const unsigned old = xb_add(&bar[XB_XSUB(b.x)], 1u);
        const unsigned gen = old / nloc;
        if (old + 1u == (gen + 1u) * nloc) {
            __builtin_amdgcn_fence(__ATOMIC_RELEASE, "agent");
            asm volatile("s_waitcnt vmcnt(0)" ::: "memory");
            const unsigned og = xb_add(&bar[XB_TOP], 1u);
            const unsigned tg = og / nx;
            if (og + 1u == (tg + 1u) * nx) xb_add(&bar[XB_TOPGEN], 1u);
            else XB_SPIN(xb_ld(&bar[XB_TOPGEN]) == tg, bar);
            __builtin_amdgcn_fence(__ATOMIC_ACQUIRE, "agent");
            xb_add(&bar[XB_XGEN(b.x)], 1u);
            asm volatile("s_waitcnt vmcnt(0)" ::: "memory");
        } else {
            XB_SPIN(xb_ld(&bar[XB_XGEN(b.x)]) == gen, bar);
            __builtin_amdgcn_fence(__ATOMIC_ACQUIRE, "agent");
            asm volatile("s_waitcnt vmcnt(0)" ::: "memory");
        }
    }
    __syncthreads();
}

struct Args { const float* in[21]; float* out; unsigned char* ws; int ph_lo, ph_hi; };
enum { I_X = 0, I_N1 = 1, I_WIN = 2, I_LB = 3, I_HGN = 4, I_CW = 5, I_CB = 6, I_DTB = 7, I_ALOG = 8, I_DSK = 9, I_SSDN = 10, I_WSB = 11, I_WHG = 12, I_WSSD = 13, I_WOUT = 14,
       I_N2 = 15, I_WQ = 16, I_SK = 17, I_U = 18, I_V = 19, I_FN = 20 };
typedef const __attribute__((address_space(4))) Args* KArgs;
struct Frame {
    LAS unsigned char* lds;
    int tid, lane, wave, vcu, G, bx;
    KArgs ap;
};
#define WSP(T, off) ((T*)(F.ap->ws + (off)))

__device__ __forceinline__ void transpose_item(const float* W, int ldw, bf16* WT, int ldt, int nblk, LAS float* scr, int item, int lane) {
    const int kb = item / nblk, nb = item % nblk, k0 = 64 * kb, n0 = 64 * nb;
    f32x4 v[16];
#pragma unroll
    for (int i = 0; i < 16; ++i) v[i] = __builtin_nontemporal_load((const GAS f32x4*)(W + (size_t)(k0 + 4 * i + (lane >> 4)) * ldw + n0 + 4 * (lane & 15)));
#pragma unroll
    for (int i = 0; i < 16; ++i) { LAS float* d = scr + (4 * i + (lane >> 4)) * 65 + 4 * (lane & 15); d[0] = v[i].x; d[1] = v[i].y; d[2] = v[i].z; d[3] = v[i].w; }
    LDS_WAIT(); asm volatile("" ::: "memory");
    const int c = lane & 7;
#pragma unroll
    for (int j = 0; j < 8; ++j) { const int n = (lane >> 3) + 8 * j; const LAS float* s = scr + (8 * c) * 65 + n;
        v4u o; o.x = pk2(s[0 * 65], s[1 * 65]); o.y = pk2(s[2 * 65], s[3 * 65]); o.z = pk2(s[4 * 65], s[5 * 65]); o.w = pk2(s[6 * 65], s[7 * 65]);
        *(GAS v4u*)(WT + (size_t)(n0 + n) * ldt + k0 + 8 * c) = o; }
    LDS_WAIT(); asm volatile("" ::: "memory");
}
__device__ __forceinline__ void weff_item(Frame& F, const float* wq, const float* sk, bf16* WeffT, int item) {
    LAS float* skT = (LAS float*)F.lds;
    LAS float* wqT = (LAS float*)(F.lds + 128 * 132 * 4);
    const int g = item >> 4, d0 = (item & 15) * 64;
    for (int e = F.tid; e < 128 * 32; e += 512) { const int key = e >> 5, i4 = (e & 31) * 4; const f32x4 v = *(const GAS f32x4*)(sk + ((size_t)g * 128 + key) * 128 + i4);
        skT[(i4 + 0) * 132 + key] = v.x; skT[(i4 + 1) * 132 + key] = v.y; skT[(i4 + 2) * 132 + key] = v.z; skT[(i4 + 3) * 132 + key] = v.w; }
    for (int e = F.tid; e < 64 * 32; e += 512) { const int dl = e >> 5, i4 = (e & 31) * 4; const f32x4 v = *(const GAS f32x4*)(wq + (size_t)(d0 + dl) * 2048 + g * 128 + i4);
        wqT[(i4 + 0) * 68 + dl] = v.x; wqT[(i4 + 1) * 68 + dl] = v.y; wqT[(i4 + 2) * 68 + dl] = v.z; wqT[(i4 + 3) * 68 + dl] = v.w; }
    __syncthreads();
    const int ty = F.tid >> 4, tx = F.tid & 15;
    float acc[4][4];
#pragma unroll
    for (int a = 0; a < 4; ++a)
#pragma unroll
        for (int b = 0; b < 4; ++b) acc[a][b] = 0.f;
#pragma unroll 4
    for (int i = 0; i < 128; ++i) { const f32x4 a = *(const LAS f32x4*)(skT + i * 132 + 4 * ty), b = *(const LAS f32x4*)(wqT + i * 68 + 4 * tx);
#pragma unroll
        for (int p = 0; p < 4; ++p)
#pragma unroll
            for (int q = 0; q < 4; ++q) acc[p][q] += a[p] * b[q]; }
#pragma unroll
    for (int p = 0; p < 4; ++p) { v2u o; o.x = pk2(acc[p][0], acc[p][1]); o.y = pk2(acc[p][2], acc[p][3]);
        *(GAS v2u*)(WeffT + (size_t)(g * 128 + 4 * ty + p) * 1024 + d0 + 4 * tx) = o; }
    __syncthreads();
}
__device__ __forceinline__ void load_wdt(Frame& F, const float* w_in_l, LAS float* wdt) {
    for (int e = F.tid; e < 2048; e += 512) { const int d = e >> 1, hf = (e & 1) * 4; *(LAS f32x4*)(wdt + d * 8 + hf) = *(const GAS f32x4*)(w_in_l + (size_t)d * W_IN_COLS + W_DT_COL + hf); }
}
template <bool DO_DT> __device__ __forceinline__ void norm_row_from_regs(const f32x4 (&v)[4], const float* nw, bf16* xnrow, const LAS float* wdt, float* dtrow, int lane) {
    float s = 0.f;
#pragma unroll
    for (int j = 0; j < 4; ++j) s += (v[j].x * v[j].x + v[j].y * v[j].y) + (v[j].z * v[j].z + v[j].w * v[j].w);
    const float rstd = frsq(wave_sum(s, lane) * (1.f / DM) + EPS);
    f32x4 h[4];
#pragma unroll
    for (int j = 0; j < 4; ++j) { const f32x4 w = *(const GAS f32x4*)(nw + 4 * lane + 256 * j); h[j] = v[j] * rstd * w; }
    GAS unsigned long long* o8 = (GAS unsigned long long*)xnrow + lane;
#pragma unroll
    for (int j = 0; j < 4; ++j) o8[64 * j] = (unsigned long long)pk2(h[j].x, h[j].y) | ((unsigned long long)pk2(h[j].z, h[j].w) << 32);
    if constexpr (DO_DT) {
        float d[8];
#pragma unroll
        for (int q = 0; q < 8; ++q) d[q] = 0.f;
#pragma unroll
        for (int j = 0; j < 4; ++j)
#pragma unroll
            for (int e = 0; e < 4; ++e) { const float hv = __builtin_bit_cast(float, f2bf(h[j][e]) << 16);
                const LAS float* wp = wdt + (4 * lane + 256 * j + e) * 8; const f32x4 w0 = *(const LAS f32x4*)wp, w1 = *(const LAS f32x4*)(wp + 4);
                d[0] += hv * w0.x; d[1] += hv * w0.y; d[2] += hv * w0.z; d[3] += hv * w0.w; d[4] += hv * w1.x; d[5] += hv * w1.y; d[6] += hv * w1.z; d[7] += hv * w1.w; }
#pragma unroll
        for (int q = 0; q < 8; ++q) d[q] = wave_sum(d[q], lane);
        if (lane == 0) { *(GAS f32x4*)dtrow = (f32x4){d[0], d[1], d[2], d[3]}; *(GAS f32x4*)(dtrow + 4) = (f32x4){d[4], d[5], d[6], d[7]}; }
    }
}
constexpr int WT_NB_A = 4864 / 64, WT_NB_G = 3072 / 64;
constexpr int WT_I_A = 16 * WT_NB_A, WT_I_G = 16 * WT_NB_G, WT_I_BR = 8 * 16, WT_I_O = 16 * 16;
constexpr int WT_PER_LAYER = WT_I_A + WT_I_G + 3 * WT_I_BR + WT_I_O;
__device__ __forceinline__ void wt_item(Frame& F, int l, int r, LAS float* scr) {
    const float* win = F.ap->in[I_WIN] + (size_t)l * DM * W_IN_COLS; bf16* WinT = WSP(bf16, WS_WIN + (size_t)l * 16 * MiB);
    if (r < WT_I_A) { transpose_item(win, W_IN_COLS, WinT, DM, WT_NB_A, scr, r, F.lane); return; } r -= WT_I_A;
    if (r < WT_I_G) { transpose_item(win + W_GATE_COL, W_IN_COLS, WinT + (size_t)C_GATE * DM, DM, WT_NB_G, scr, r, F.lane); return; } r -= WT_I_G;
    bf16* WbrT = WSP(bf16, WS_WBR + (size_t)l * 3 * MiB);
    if (r < WT_I_BR) { transpose_item(F.ap->in[I_WSB] + (size_t)l * 512 * DM, DM, WbrT, 512, 16, scr, r, F.lane); return; } r -= WT_I_BR;
    if (r < WT_I_BR) { transpose_item(F.ap->in[I_WHG] + (size_t)l * 512 * DM, DM, WbrT + (size_t)1024 * 512, 512, 16, scr, r, F.lane); return; } r -= WT_I_BR;
    if (r < WT_I_BR) { transpose_item(F.ap->in[I_WSSD] + (size_t)l * 512 * DM, DM, WbrT + (size_t)2048 * 512, 512, 16, scr, r, F.lane); return; } r -= WT_I_BR;
    transpose_item(F.ap->in[I_WOUT] + (size_t)l * DM * DM, DM, WSP(bf16, WS_WOUT + (size_t)l * 2 * MiB), DM, 16, scr, r, F.lane);
}
__device__ __forceinline__ void p0_prologue(Frame& F) {
    const int gw = F.vcu * NWAVES + F.wave, NGW = F.G * NWAVES;
    {
        LAS float* scr = (LAS float*)(F.lds + F.wave * 16640);
        for (int it = gw; it < (MK_W1_LATE ? 1 : 2) * WT_PER_LAYER; it += NGW) { const int l = it / WT_PER_LAYER; wt_item(F, l, it - l * WT_PER_LAYER, scr); }
    }
    if (gw < 16) { const int l = gw >> 3, q = gw & 7; const float* win = F.ap->in[I_WIN] + (size_t)l * DM * W_IN_COLS + W_DT_COL + q; bf16* dst = WSP(bf16, WS_WIN + (size_t)l * 16 * MiB) + (size_t)(NP + q) * DM;
        for (int d = F.lane; d < DM; d += 64) dst[d] = (bf16)f2bf(win[(size_t)d * W_IN_COLS]); }
    __syncthreads();
    for (int it = F.vcu; it < 512; it += F.G) { const int l = it >> 8;
        weff_item(F, F.ap->in[I_WQ] + (size_t)l * DM * 2048, F.ap->in[I_SK] + (size_t)l * 16 * 128 * 128, WSP(bf16, WS_WEFF + (size_t)l * 4 * MiB), it & 255); }
    __syncthreads();
    { f32x4 nx[4];
      { const GAS f32x4* xr = (const GAS f32x4*)(F.ap->in[I_X] + (size_t)gw * DM) + F.lane;
#pragma unroll
        for (int j = 0; j < 4; ++j) nx[j] = xr[64 * j]; }
      for (int m = gw; m < TT; m += NGW) {
        f32x4 v[4];
#pragma unroll
        for (int j = 0; j < 4; ++j) v[j] = nx[j];
        if (m + NGW < TT) { const GAS f32x4* xr = (const GAS f32x4*)(F.ap->in[I_X] + (size_t)(m + NGW) * DM) + F.lane;
#pragma unroll
            for (int j = 0; j < 4; ++j) nx[j] = xr[64 * j]; }
        norm_row_from_regs<false>(v, F.ap->in[I_N1], XNP + (size_t)m * DM, (const LAS float*)F.lds, (float*)nullptr, F.lane);
      } }
    __syncthreads();
}
template <bool ISV> __device__ __forceinline__ void tables_items(Frame& F, int l, size_t i0, size_t step, size_t dstoff = (ISV ? WS_V8 : WS_U8)) {
    constexpr size_t N16 = (size_t)16384 * 1024 / 16;
    const float* T = F.ap->in[ISV ? I_V : I_U] + (size_t)l * 16384 * 1024; constexpr float sc = ISV ? 32.0f : 256.0f;
    for (size_t ib = i0; ib < N16; ib += 4 * step) {
        f32x4 a[4][4];
#pragma unroll
        for (int r = 0; r < 4; ++r) { const size_t j = ib + r * step; if (j < N16) {
#pragma unroll
            for (int q = 0; q < 4; ++q) a[r][q] = __builtin_nontemporal_load((const GAS f32x4*)(T + j * 16) + q); } }
#pragma unroll
        for (int r = 0; r < 4; ++r) { const size_t j = ib + r * step; if (j < N16) {
            v4u o;
#pragma unroll
            for (int q = 0; q < 4; ++q) { int p = 0; p = __builtin_amdgcn_cvt_pk_fp8_f32(a[r][q].x * sc, a[r][q].y * sc, p, false); p = __builtin_amdgcn_cvt_pk_fp8_f32(a[r][q].z * sc, a[r][q].w * sc, p, true); o[q] = (unsigned)p; }
            const size_t dst = (ISV || MK_UCOL) ? ((j & 63) >> 3) * (size_t)(16384 * 128) + (j >> 6) * 128 + (j & 7) * 16 : j * 16;
            *(GAS v4u*)(F.ap->ws + dstoff + dst) = o; } }
    }
}

__device__ __forceinline__ int crow(int r, int hi) { return (r & 3) + 8 * (r >> 2) + 4 * hi; }
__device__ __forceinline__ void sb_block(const f32x16& p, int kb  , int qi, float& R, float (&a)[16], int lane) {
    float beta[16], suf[16], tot[4], ptot[4];
#pragma unroll
    for (int g = 0; g < 4; ++g) {
        float omb[4];
#pragma unroll
        for (int i = 0; i < 4; ++i) { const int r = 4 * g + i; const float z = p[r] * 0.125f;
            const float e = __builtin_amdgcn_exp2f(-fabsf(z) * 1.4426950408889634f), rc = frcp(1.f + e), sm = e * rc;
            const bool pos = z >= 0.f, valid = (kb + i + 8 * g) < qi;
            beta[r] = valid ? (pos ? rc : sm) : 0.f; omb[i] = valid ? (pos ? sm : rc) : 1.f; }
        suf[4 * g + 3] = 1.f; suf[4 * g + 2] = omb[3]; suf[4 * g + 1] = omb[3] * omb[2]; suf[4 * g] = suf[4 * g + 1] * omb[1]; tot[g] = suf[4 * g] * omb[0];
    }
#pragma unroll
    for (int g = 0; g < 4; ++g) ptot[g] = shx(tot[g], 32, lane);
    const bool lo = lane < 32;
    float sp[4]; sp[3] = 1.f; sp[2] = tot[3] * ptot[3]; sp[1] = sp[2] * (tot[2] * ptot[2]); sp[0] = sp[1] * (tot[1] * ptot[1]);
    const float total = sp[0] * (tot[0] * ptot[0]);
#pragma unroll
    for (int g = 0; g < 4; ++g) { const float af = R * sp[g] * (lo ? ptot[g] : 1.f);
#pragma unroll
        for (int i = 0; i < 4; ++i) a[4 * g + i] = beta[4 * g + i] * af * suf[4 * g + i]; }
    R *= total;
}
__device__ __forceinline__ void sb_attn_wave(const bf16* PROJ, bf16* Y0, int b, int h, int qblk, LAS bf16* vt  , int lane) {
    const int r32 = lane & 31, hi = lane >> 5;
    const size_t rowbase = (size_t)b * SEQ;
    const int qw = qblk * 32, qi = qw + r32;
    bf16x8 qf[4];
    { const bf16* qp = PROJ + (rowbase + qi) * NP + C_SBQ + h * 64 + hi * 8;
#pragma unroll
      for (int d0 = 0; d0 < 4; ++d0) qf[d0] = *(const GAS bf16x8*)(qp + d0 * 16); }
    f32x16 o0 = {}, o1 = {};
    float R = 1.0f;
    for (int kt = (qw + 30) >> 6; kt >= 0; --kt) {
        const bf16* kp = PROJ + (rowbase + (size_t)kt * 64 + r32) * NP + C_SBK + h * 64 + hi * 8;
        bf16x8 kf0[4], kf1[4];
#pragma unroll
        for (int d0 = 0; d0 < 4; ++d0) { kf0[d0] = *(const GAS bf16x8*)(kp + d0 * 16); kf1[d0] = *(const GAS bf16x8*)(kp + (size_t)32 * NP + d0 * 16); }
        { const bf16* vp = PROJ + (rowbase + (size_t)kt * 64 + (lane >> 3)) * NP + C_SBV + h * 64 + (lane & 7) * 8;
          bf16x8 vv[8];
#pragma unroll
          for (int i = 0; i < 8; ++i) vv[i] = *(const GAS bf16x8*)(vp + (size_t)(8 * i) * NP);
#pragma unroll
          for (int i = 0; i < 8; ++i)
#pragma unroll
              for (int e = 0; e < 8; ++e) vt[((lane & 7) * 8 + e) * 72 + (lane >> 3) + 8 * i] = (bf16)vv[i][e]; }
        f32x16 p0 = {}, p1 = {};
#pragma unroll
        for (int d0 = 0; d0 < 4; ++d0) { p0 = MFMA32(kf0[d0], qf[d0], p0); p1 = MFMA32(kf1[d0], qf[d0], p1); }
        float a1[16], a0[16];
        sb_block(p1, kt * 64 + 32 + 4 * hi, qi, R, a1, lane);
        sb_block(p0, kt * 64 + 4 * hi, qi, R, a0, lane);
        bf16x8 pa[4]; pa[0] = pack8(a0); pa[1] = pack8(a0 + 8); pa[2] = pack8(a1); pa[3] = pack8(a1 + 8);
        LDS_WAIT();
#pragma unroll
        for (int s = 0; s < 4; ++s) {
            const LAS bf16* v0p = vt + r32 * 72 + 16 * s + 4 * hi; const LAS bf16* v1p = vt + (32 + r32) * 72 + 16 * s + 4 * hi;
            const v2u x0 = *(const LAS v2u*)v0p, x1 = *(const LAS v2u*)(v0p + 8), y0 = *(const LAS v2u*)v1p, y1 = *(const LAS v2u*)(v1p + 8);
            const bf16x8 vb0 = __builtin_bit_cast(bf16x8, (v4u){x0.x, x0.y, x1.x, x1.y}), vb1 = __builtin_bit_cast(bf16x8, (v4u){y0.x, y0.y, y1.x, y1.y});
            o0 = MFMA32(pa[s], vb0, o0); o1 = MFMA32(pa[s], vb1, o1);
        }
        LDS_WAIT();
        if (__all(R < 1e-37f)) break;
    }
    bf16* yp = Y0 + (rowbase + qw) * 512 + h * 64 + r32;
#pragma unroll
    for (int r = 0; r < 16; ++r) { const int q = crow(r, hi); yp[(size_t)q * 512] = (bf16)f2bf(o0[r]); yp[(size_t)q * 512 + 32] = (bf16)f2bf(o1[r]); }
}
__device__ __forceinline__ void p_sb_attn(Frame& F) {
    LAS bf16* vt = (LAS bf16*)(F.lds + F.wave * 9216);
    const int gw = F.vcu * NWAVES + F.wave, NGW = F.G * NWAVES;
    for (int u = gw, it_ = 0; u < 4096; u += NGW, ++it_) sb_attn_wave(WSP(bf16, WS_PROJ), WSP(bf16, WS_Y), u >> 11, (u >> 8) & 7, (it_ & 1) ? 255 - (u & 255) : (u & 255), vt, F.lane);
}

__device__ __forceinline__ float hg_lb(const float* lbl, int l, int kk) { return l == 0 ? 0.f : sigmoidf_(lbl[512 + kk] - lbl[kk]); }
__device__ __forceinline__ void ld8f(const LAS float* p, float* v) { const f32x4 a = *(const LAS f32x4*)p, b = *(const LAS f32x4*)(p + 4); v[0] = a.x; v[1] = a.y; v[2] = a.z; v[3] = a.w; v[4] = b.x; v[5] = b.y; v[6] = b.z; v[7] = b.w; }
constexpr int HG_P = 132;
__device__ __forceinline__ void hg_local_unit(Frame& F, int l, int b, int h, int c) {
    LAS float* Bc = (LAS float*)F.lds;
    LAS float* Ky = (LAS float*)(F.lds + 33792);
    LAS bf16* Vt = (LAS bf16*)(F.lds + 67584);
    LAS float* Sg = (LAS float*)(F.lds + 86016);
    const bf16* PROJ = WSP(bf16, WS_PROJ);
    const size_t row0 = (size_t)b * SEQ + (size_t)c * 64;
    const int tid = F.tid, lane = F.lane, w = F.wave, fr = lane & 15, quad = lane >> 4;
    float lbv[8];
#pragma unroll
    for (int j = 0; j < 8; ++j) lbv[j] = hg_lb(F.ap->in[I_LB], l, h * 128 + (tid & 15) * 8 + j);
    for (int e = tid; e < 64 * 16; e += 512) { const int t = e >> 4, k8 = (e & 15) * 8;
        float fv[8]; unpack8(*(const GAS v4u*)(PROJ + (row0 + t) * NP + C_HGF + h * 128 + k8), fv);
#pragma unroll
        for (int j = 0; j < 8; ++j) { const float lb = lbv[j];
            const float ee = fexp(-fabsf(fv[j])), rc = frcp(1.f + ee), sm = ee * rc; const bool pos = fv[j] >= 0.f;
            const float sg = pos ? rc : sm, sgn = pos ? sm : rc;
            const float f = lb + (1.f - lb) * sg;
            Bc[t * HG_P + k8 + j] = __logf(fmaxf(f, 1e-30f)); Ky[t * HG_P + k8 + j] = (1.f - lb) * sgn; }
        const v4u iv = *(const GAS v4u*)(PROJ + (row0 + t) * NP + C_HGI + h * 128 + k8);
        Vt[(k8 + 0) * 72 + t] = (bf16)(iv.x & 0xffff); Vt[(k8 + 1) * 72 + t] = (bf16)(iv.x >> 16); Vt[(k8 + 2) * 72 + t] = (bf16)(iv.y & 0xffff); Vt[(k8 + 3) * 72 + t] = (bf16)(iv.y >> 16);
        Vt[(k8 + 4) * 72 + t] = (bf16)(iv.z & 0xffff); Vt[(k8 + 5) * 72 + t] = (bf16)(iv.z >> 16); Vt[(k8 + 6) * 72 + t] = (bf16)(iv.w & 0xffff); Vt[(k8 + 7) * 72 + t] = (bf16)(iv.w >> 16); }
    __syncthreads();
    { const int seg = tid >> 7, k = tid & 127; float run = 0.f;
#pragma unroll
      for (int i = 0; i < 16; ++i) { run += Bc[(seg * 16 + i) * HG_P + k]; Bc[(seg * 16 + i) * HG_P + k] = run; }
      Sg[seg * 128 + k] = run;
      __syncthreads();
      float off = 0.f;
#pragma unroll
      for (int s = 0; s < 3; ++s) if (s < seg) off += Sg[s * 128 + k];
      if (seg)
#pragma unroll
          for (int i = 0; i < 16; ++i) Bc[(seg * 16 + i) * HG_P + k] += off; }
    __syncthreads();
    if (tid < 128) WSP(float, WS_DCH)[(((size_t)(b * 4 + h)) * 128 + c) * 128 + tid] = fexp(Bc[63 * HG_P + tid]);
    {
        const int I = (w < 4) ? (w >> 1) : 3 - ((w - 4) >> 1), vh = w & 1;
        const int tl = 16 * I + fr;
        bf16x8 bq[4];
#pragma unroll
        for (int ks = 0; ks < 4; ++ks) { const int k0 = 32 * ks + 8 * quad;
            float qv[8], bt[8], rf[8], o[8], oq[8];
            unpack8(*(const GAS v4u*)(PROJ + (row0 + tl) * NP + C_HGQ + h * 128 + k0), qv);
            ld8f(Bc + tl * HG_P + k0, bt);
            if (I > 0) ld8f(Bc + (16 * I - 1) * HG_P + k0, rf); else {
#pragma unroll
                for (int j = 0; j < 8; ++j) rf[j] = 0.f; }
#pragma unroll
            for (int j = 0; j < 8; ++j) { const float qs = siluf_(qv[j]) * 0.08838834764831845f; o[j] = qs * fexp(bt[j] - rf[j]); oq[j] = qs * fexp(bt[j]); }
            bq[ks] = pack8(o);
            if (vh == 0) *(GAS bf16x8*)(WSP(bf16, WS_QT) + (row0 + tl) * 512 + h * 128 + k0) = pack8(oq);
        }
        f32x4 sT[4];
#pragma unroll
        for (int J = 0; J < 4; ++J) { sT[J] = (f32x4){0.f, 0.f, 0.f, 0.f};
            if (J <= I) { const int sl = 16 * J + fr;
#pragma unroll
                for (int ks = 0; ks < 4; ++ks) { const int k0 = 32 * ks + 8 * quad; float kv[8], bs[8], rf[8], o[8];
                    ld8f(Ky + sl * HG_P + k0, kv); ld8f(Bc + sl * HG_P + k0, bs);
                    if (I > 0) ld8f(Bc + (16 * I - 1) * HG_P + k0, rf); else {
#pragma unroll
                        for (int j = 0; j < 8; ++j) rf[j] = 0.f; }
#pragma unroll
                    for (int j = 0; j < 8; ++j) o[j] = kv[j] * fexp(fminf(rf[j] - bs[j], 80.f));
                    sT[J] = MFMA16(pack8(o), bq[ks], sT[J]); }
                if (J == I) {
#pragma unroll
                    for (int r = 0; r < 4; ++r) if (4 * quad + r > fr) sT[J][r] = 0.f; }
            } }
        bf16x8 bs0, bs1;
        { float t0[8] = {sT[0][0], sT[0][1], sT[0][2], sT[0][3], sT[1][0], sT[1][1], sT[1][2], sT[1][3]}; bs0 = pack8(t0);
          float t1[8] = {sT[2][0], sT[2][1], sT[2][2], sT[2][3], sT[3][0], sT[3][1], sT[3][2], sT[3][3]}; bs1 = pack8(t1); }
#pragma unroll
        for (int vi = 0; vi < 4; ++vi) { const int vb = vh * 4 + vi; const LAS bf16* vp = Vt + (16 * vb + fr) * 72 + 4 * quad;
            f32x4 acc = {0.f, 0.f, 0.f, 0.f};
            { const v2u x0 = *(const LAS v2u*)vp, x1 = *(const LAS v2u*)(vp + 16); acc = MFMA16(__builtin_bit_cast(bf16x8, (v4u){x0.x, x0.y, x1.x, x1.y}), bs0, acc); }
            if (I >= 2) { const v2u x0 = *(const LAS v2u*)(vp + 32), x1 = *(const LAS v2u*)(vp + 48); acc = MFMA16(__builtin_bit_cast(bf16x8, (v4u){x0.x, x0.y, x1.x, x1.y}), bs1, acc); }
            v2u o; o.x = pk2(acc[0], acc[1]); o.y = pk2(acc[2], acc[3]);
            *(GAS v2u*)(WSP(bf16, WS_OI) + (row0 + tl) * 512 + h * 128 + 16 * vb + 4 * quad) = o; }
    }
    {
        const int k = 16 * w + fr; const float bl = Bc[63 * HG_P + k];
        bf16x8 bk[2];
#pragma unroll
        for (int ks = 0; ks < 2; ++ks) { float o[8];
#pragma unroll
            for (int j = 0; j < 8; ++j) { const int s = 32 * ks + 8 * quad + j; o[j] = Ky[s * HG_P + k] * fexp(bl - Bc[s * HG_P + k]); }
            bk[ks] = pack8(o); }
        bf16* S = WSP(bf16, WS_HGS) + (((size_t)(b * 4 + h)) * 128 + c) * 16384;
#pragma unroll
        for (int vb = 0; vb < 8; ++vb) { f32x4 acc = {0.f, 0.f, 0.f, 0.f};
#pragma unroll
            for (int ks = 0; ks < 2; ++ks) acc = MFMA16(*(const LAS bf16x8*)(Vt + (16 * vb + fr) * 72 + 32 * ks + 8 * quad), bk[ks], acc);
#pragma unroll
            for (int r = 0; r < 4; ++r) S[(size_t)(16 * vb + 4 * quad + r) * 128 + k] = (bf16)f2bf(acc[r]); }
    }
    __syncthreads();
}
struct HgOutRegs { v4u qv[2]; bf16x8 af[4]; v2u oiv[4], gvv[4]; };
__device__ __forceinline__ void hg_out_load(Frame& F, int b, int h, int c, HgOutRegs& R) {
    const bf16* PROJ = WSP(bf16, WS_PROJ);
    const size_t row0 = (size_t)b * SEQ + (size_t)c * 64;
    const int lane = F.lane, w = F.wave, fr = lane & 15, quad = lane >> 4;
    const bf16* S = WSP(bf16, WS_HGS) + (((size_t)(b * 4 + h)) * 128 + c) * 16384;
#pragma unroll
    for (int it = 0; it < 2; ++it) { const int e = F.tid + 512 * it; R.qv[it] = *(const GAS v4u*)(WSP(bf16, WS_QT) + (row0 + (e >> 4)) * 512 + h * 128 + (e & 15) * 8); }
#pragma unroll
    for (int ks = 0; ks < 4; ++ks) R.af[ks] = *(const GAS bf16x8*)(S + (size_t)(16 * w + fr) * 128 + 32 * ks + 8 * quad);
#pragma unroll
    for (int tb = 0; tb < 4; ++tb) { R.oiv[tb] = *(const GAS v2u*)(WSP(bf16, WS_OI) + (row0 + 16 * tb + fr) * 512 + h * 128 + 16 * w + 4 * quad); R.gvv[tb] = *(const GAS v2u*)(PROJ + (row0 + 16 * tb + fr) * NP + C_HGG + h * 128 + 16 * w + 4 * quad); }
}
__device__ __forceinline__ void hg_out_compute(Frame& F, int l, int b, int h, int c, const HgOutRegs& R) {
    LAS float* SS = (LAS float*)F.lds;
    const size_t row0 = (size_t)b * SEQ + (size_t)c * 64;
    const int lane = F.lane, w = F.wave, fr = lane & 15, quad = lane >> 4;
    LAS bf16* Qs = (LAS bf16*)(F.lds + 2048);
    const f32x4 nw = *(const GAS f32x4*)(F.ap->in[I_HGN] + (size_t)l * 128 + 16 * w + 4 * quad);
#pragma unroll
    for (int it = 0; it < 2; ++it) { const int e = F.tid + 512 * it; *(LAS v4u*)(Qs + (e >> 4) * 136 + (e & 15) * 8) = R.qv[it]; }
    __syncthreads();
    f32x4 o[4];
#pragma unroll
    for (int tb = 0; tb < 4; ++tb) { o[tb] = (f32x4){0.f, 0.f, 0.f, 0.f};
#pragma unroll
        for (int ks = 0; ks < 4; ++ks) o[tb] = MFMA16(R.af[ks], *(const LAS bf16x8*)(Qs + (16 * tb + fr) * 136 + 32 * ks + 8 * quad), o[tb]);
        const v2u oi = R.oiv[tb];
        o[tb][0] += bflo(oi.x); o[tb][1] += bfhi(oi.x); o[tb][2] += bflo(oi.y); o[tb][3] += bfhi(oi.y);
        float ss = (o[tb][0] * o[tb][0] + o[tb][1] * o[tb][1]) + (o[tb][2] * o[tb][2] + o[tb][3] * o[tb][3]);
        ss += shx(ss, 16, lane); ss += shx(ss, 32, lane);
        if (quad == 0) SS[w * 64 + 16 * tb + fr] = ss; }
    __syncthreads();
#pragma unroll
    for (int tb = 0; tb < 4; ++tb) { const int t = 16 * tb + fr; float tot = 0.f;
#pragma unroll
        for (int ww = 0; ww < 8; ++ww) tot += SS[ww * 64 + t];
        const float rstd = frsq(tot * (1.f / 128.f) + EPS);
        const v2u gv = R.gvv[tb];
        const float y0 = o[tb][0] * rstd * nw.x * siluf_(bflo(gv.x)), y1 = o[tb][1] * rstd * nw.y * siluf_(bfhi(gv.x)), y2 = o[tb][2] * rstd * nw.z * siluf_(bflo(gv.y)), y3 = o[tb][3] * rstd * nw.w * siluf_(bfhi(gv.y));
        v2u ov; ov.x = pk2(y0, y1); ov.y = pk2(y2, y3);
        *(GAS v2u*)(WSP(bf16, WS_Y) + (size_t)TT * 512 + (row0 + t) * 512 + h * 128 + 16 * w + 4 * quad) = ov; }
    __syncthreads();
}
__device__ __forceinline__ void hg_out_units(Frame& F, int l, int first, int stride) {
    if (first >= 1024) return;
    HgOutRegs Ra, Rb;
#define HGO_B(u) ((u) >> 9)
#define HGO_H(u) (((u) >> 7) & 3)
#define HGO_C(u) ((u) & 127)
    hg_out_load(F, HGO_B(first), HGO_H(first), HGO_C(first), Ra);
    for (int u = first; u < 1024; u += 2 * stride) {
        const int u1 = u + stride, u2 = u + 2 * stride;
        { const int un = u1 < 1024 ? u1 : u; hg_out_load(F, HGO_B(un), HGO_H(un), HGO_C(un), Rb); }
        hg_out_compute(F, l, HGO_B(u), HGO_H(u), HGO_C(u), Ra);
        if (u1 >= 1024) break;
        { const int un = u2 < 1024 ? u2 : u1; hg_out_load(F, HGO_B(un), HGO_H(un), HGO_C(un), Ra); }
        hg_out_compute(F, l, HGO_B(u1), HGO_H(u1), HGO_C(u1), Rb);
    }
#undef HGO_B
#undef HGO_H
#undef HGO_C
}

constexpr int SL_CM = 0, SL_BM = 18432, SL_BT = 36864, SL_XT = 54272, SL_AC = 123904, SL_DT = 125952;
__device__ __forceinline__ void ssd_local_unit(Frame& F, int l, int b, int c, int g) {
    LAS bf16* Cm = (LAS bf16*)(F.lds + SL_CM); LAS bf16* Bm = (LAS bf16*)(F.lds + SL_BM); LAS bf16* Bt = (LAS bf16*)(F.lds + SL_BT); LAS bf16* Xt = (LAS bf16*)(F.lds + SL_XT);
    LAS float* AC = (LAS float*)(F.lds + SL_AC); LAS float* DT = (LAS float*)(F.lds + SL_DT);
    const bf16* PROJ = WSP(bf16, WS_PROJ);
    const size_t row0 = (size_t)b * SEQ + (size_t)c * 128;
    const int tid = F.tid, lane = F.lane, w = F.wave, fr = lane & 15, quad = lane >> 4;
    if (w < 4) { const int head = 4 * g + w; const float bias = F.ap->in[I_DTB][l * 8 + head], A = -fexp(F.ap->in[I_ALOG][l * 8 + head]);
        float dt[2], a[2];
#pragma unroll
        for (int i = 0; i < 2; ++i) { const float x = WSP(float, WS_DT)[(row0 + 2 * lane + i) * 8 + head] + bias; dt[i] = x > 20.f ? x : __logf(1.f + fexp(x)); a[i] = A * dt[i]; }
        float v = a[0] + a[1], inc = v;
#pragma unroll
        for (int o = 1; o < 64; o <<= 1) { const float t = shi(inc, lane >= o ? lane - o : lane); if (lane >= o) inc += t; }
        const float ex = inc - v;
        AC[w * 128 + 2 * lane] = ex + a[0]; AC[w * 128 + 2 * lane + 1] = ex + v; DT[w * 128 + 2 * lane] = dt[0]; DT[w * 128 + 2 * lane + 1] = dt[1]; }
    if (tid < 384) { const float* cw = F.ap->in[I_CW] + (size_t)l * 4 * 768; const float* cb = F.ap->in[I_CB] + (size_t)l * 768;
        const int cgp = tid % 48, rb = tid / 48;
        const int ch = cgp < 32 ? 256 * g + 8 * cgp : (cgp < 40 ? 512 + 64 * g + 8 * (cgp - 32) : 640 + 64 * g + 8 * (cgp - 40));
        f32x4 wk[4][2];
#pragma unroll
        for (int k = 0; k < 4; ++k) { wk[k][0] = *(const GAS f32x4*)(cw + k * 768 + ch); wk[k][1] = *(const GAS f32x4*)(cw + k * 768 + ch + 4); }
        const f32x4 b0 = *(const GAS f32x4*)(cb + ch), b1 = *(const GAS f32x4*)(cb + ch + 4);
#pragma unroll 1
        for (int hf = 0; hf < 2; ++hf) {
        v4u xr[11];
#pragma unroll
        for (int i = 0; i < 11; ++i) { const int lt = 16 * rb + 8 * hf - 3 + i; const bool ok = c > 0 || lt >= 0;
            xr[i] = *(const GAS v4u*)(PROJ + (size_t)((long)row0 + (ok ? lt : 0)) * NP + C_XBC + ch); if (!ok) xr[i] = (v4u){0u, 0u, 0u, 0u}; }
#pragma unroll
        for (int j = 0; j < 8; ++j) { const int lr = 16 * rb + 8 * hf + j;
            float acc[8] = {b0.x, b0.y, b0.z, b0.w, b1.x, b1.y, b1.z, b1.w};
#pragma unroll
            for (int k = 0; k < 4; ++k) { float xv[8]; unpack8(xr[j + k], xv);
                acc[0] += wk[k][0].x * xv[0]; acc[1] += wk[k][0].y * xv[1]; acc[2] += wk[k][0].z * xv[2]; acc[3] += wk[k][0].w * xv[3]; acc[4] += wk[k][1].x * xv[4]; acc[5] += wk[k][1].y * xv[5]; acc[6] += wk[k][1].z * xv[6]; acc[7] += wk[k][1].w * xv[7]; }
#pragma unroll
            for (int q = 0; q < 8; ++q) acc[q] = siluf_(acc[q]);
            if (cgp < 32) {
#pragma unroll
                for (int q = 0; q < 8; ++q) Xt[(8 * cgp + q) * 136 + lr] = (bf16)f2bf(acc[q]);
            } else if (cgp < 40) { const int n0 = 8 * (cgp - 32); *(LAS bf16x8*)(Bm + lr * 72 + n0) = pack8(acc);
#pragma unroll
                for (int q = 0; q < 8; ++q) Bt[(n0 + q) * 136 + lr] = (bf16)f2bf(acc[q]);
            } else { const int n0 = 8 * (cgp - 40); *(LAS bf16x8*)(Cm + lr * 72 + n0) = pack8(acc); } } } }
    __syncthreads();
    for (int e = tid; e < 128 * 32; e += 512) { const int lr = e >> 5, hh = (e >> 3) & 3, n8 = (e & 7) * 8; float cv[8]; unpack8(*(const LAS v4u*)(Cm + lr * 72 + n8), cv);
        const float ea = fexp(AC[hh * 128 + lr]);
#pragma unroll
        for (int j = 0; j < 8; ++j) cv[j] *= ea;
        *(GAS bf16x8*)(WSP(bf16, WS_CE) + (row0 + lr) * 512 + (4 * g + hh) * 64 + n8) = pack8(cv); }
    if (tid < 4) WSP(float, WS_ATOT)[((size_t)b * 64 + c) * 8 + 4 * g + tid] = AC[tid * 128 + 127];
    for (int ps_ = 0; ps_ < 2; ++ps_) { const int wq = ps_ ? 7 - w : w;
        const int ll = 16 * wq + fr;
        bf16x8 cf[2];
#pragma unroll
        for (int ks = 0; ks < 2; ++ks) cf[ks] = *(const LAS bf16x8*)(Cm + ll * 72 + 32 * ks + 8 * quad);
        f32x4 gT[8];
#pragma unroll
        for (int sb = 0; sb < 8; ++sb) { gT[sb] = (f32x4){0.f, 0.f, 0.f, 0.f};
            if (sb <= wq) {
#pragma unroll
                for (int ks = 0; ks < 2; ++ks) gT[sb] = MFMA16(*(const LAS bf16x8*)(Bm + (16 * sb + fr) * 72 + 32 * ks + 8 * quad), cf[ks], gT[sb]); } }
#pragma unroll 1
        for (int hh = 2 * ps_; hh < 2 * ps_ + 2; ++hh) { const int head = 4 * g + hh; const float al = AC[hh * 128 + ll], dsk = F.ap->in[I_DSK][l * 8 + head];
            f32x4 yT[4];
#pragma unroll
            for (int pb = 0; pb < 4; ++pb) yT[pb] = (f32x4){0.f, 0.f, 0.f, 0.f};
#pragma unroll
            for (int pj = 0; pj < 4; ++pj) if (2 * pj <= wq) {
                float o[8];
#pragma unroll
                for (int j = 0; j < 8; ++j) { const int sb = 2 * pj + (j >> 2), s = 16 * sb + 4 * quad + (j & 3);
                    const float gv = (j < 4) ? gT[2 * pj][j & 3] : gT[2 * pj + 1][j & 3];
                    float v = gv * fexp(fminf(al - AC[hh * 128 + s], 0.f)) * DT[hh * 128 + s];
                    if (s == ll) v += dsk;
                    o[j] = (s <= ll) ? v : 0.f; }
                const bf16x8 bfr = pack8(o);
#pragma unroll
                for (int pb = 0; pb < 4; ++pb) { const LAS bf16* xp = Xt + (hh * 64 + 16 * pb + fr) * 136 + 32 * pj + 4 * quad;
                    const v2u x0 = *(const LAS v2u*)xp, x1 = *(const LAS v2u*)(xp + 16);
                    yT[pb] = MFMA16(__builtin_bit_cast(bf16x8, (v4u){x0.x, x0.y, x1.x, x1.y}), bfr, yT[pb]); } }
#pragma unroll
            for (int pb = 0; pb < 4; ++pb) { v2u ov; ov.x = pk2(yT[pb][0], yT[pb][1]); ov.y = pk2(yT[pb][2], yT[pb][3]);
                *(GAS v2u*)(WSP(bf16, WS_YD) + (row0 + ll) * 512 + head * 64 + 16 * pb + 4 * quad) = ov; } }
    }
    {
        const int hh = w >> 1, head = 4 * g + hh, pb0 = (w & 1) * 2; const float alast = AC[hh * 128 + 127];
        f32x4 st[2][4];
#pragma unroll
        for (int i = 0; i < 2; ++i)
#pragma unroll
            for (int nb = 0; nb < 4; ++nb) st[i][nb] = (f32x4){0.f, 0.f, 0.f, 0.f};
#pragma unroll
        for (int ks = 0; ks < 4; ++ks) { const int s0 = 32 * ks + 8 * quad; float wv[8];
#pragma unroll
            for (int j = 0; j < 8; ++j) wv[j] = fexp(alast - AC[hh * 128 + s0 + j]) * DT[hh * 128 + s0 + j];
            bf16x8 xa[2];
#pragma unroll
            for (int i = 0; i < 2; ++i) xa[i] = *(const LAS bf16x8*)(Xt + (hh * 64 + 16 * (pb0 + i) + fr) * 136 + s0);
#pragma unroll
            for (int nb = 0; nb < 4; ++nb) { float bv[8]; unpack8(*(const LAS v4u*)(Bt + (16 * nb + fr) * 136 + s0), bv);
#pragma unroll
                for (int j = 0; j < 8; ++j) bv[j] *= wv[j];
                const bf16x8 bfr = pack8(bv);
#pragma unroll
                for (int i = 0; i < 2; ++i) st[i][nb] = MFMA16(xa[i], bfr, st[i][nb]); } }
        bf16* S = WSP(bf16, WS_SSDS) + ((((size_t)b * 64 + c) * 8 + head) * 4096);
#pragma unroll
        for (int i = 0; i < 2; ++i)
#pragma unroll
            for (int nb = 0; nb < 4; ++nb)
#pragma unroll
                for (int r = 0; r < 4; ++r) S[(size_t)(16 * (pb0 + i) + 4 * quad + r) * 64 + 16 * nb + fr] = (bf16)f2bf(st[i][nb][r]);
    }
    __syncthreads();
}
__device__ __forceinline__ void ssd_out_unit(Frame& F, int l, int b, int c, int g) {
    const bf16* PROJ = WSP(bf16, WS_PROJ);
    const size_t row0 = (size_t)b * SEQ + (size_t)c * 128;
    const int lane = F.lane, w = F.wave, fr = lane & 15, quad = lane >> 4;
    const size_t row = row0 + 16 * w + fr;
    f32x4 yT[4][4]; float ss = 0.f;
#pragma unroll
    for (int hh = 0; hh < 4; ++hh) { const int head = 4 * g + hh;
        bf16x8 cf[2];
#pragma unroll
        for (int ks = 0; ks < 2; ++ks) cf[ks] = *(const GAS bf16x8*)(WSP(bf16, WS_CE) + row * 512 + head * 64 + 32 * ks + 8 * quad);
        const bf16* S = WSP(bf16, WS_SSDS) + ((((size_t)b * 64 + c) * 8 + head) * 4096);
#pragma unroll
        for (int pb = 0; pb < 4; ++pb) { f32x4 acc = {0.f, 0.f, 0.f, 0.f};
#pragma unroll
            for (int ks = 0; ks < 2; ++ks) acc = MFMA16(*(const GAS bf16x8*)(S + (size_t)(16 * pb + fr) * 64 + 32 * ks + 8 * quad), cf[ks], acc);
            const int col = head * 64 + 16 * pb + 4 * quad;
            const v2u yd = *(const GAS v2u*)(WSP(bf16, WS_YD) + row * 512 + col), zv = *(const GAS v2u*)(PROJ + row * NP + C_SSDZ + col);
            acc[0] = (acc[0] + bflo(yd.x)) * siluf_(bflo(zv.x)); acc[1] = (acc[1] + bfhi(yd.x)) * siluf_(bfhi(zv.x)); acc[2] = (acc[2] + bflo(yd.y)) * siluf_(bflo(zv.y)); acc[3] = (acc[3] + bfhi(yd.y)) * siluf_(bfhi(zv.y));
            ss += (acc[0] * acc[0] + acc[1] * acc[1]) + (acc[2] * acc[2] + acc[3] * acc[3]);
            yT[hh][pb] = acc; } }
    ss += shx(ss, 16, lane); ss += shx(ss, 32, lane);
    const float rstd = frsq(ss * (1.f / 256.f) + EPS);
#pragma unroll
    for (int hh = 0; hh < 4; ++hh)
#pragma unroll
        for (int pb = 0; pb < 4; ++pb) { const int col = (4 * g + hh) * 64 + 16 * pb + 4 * quad; const f32x4 nw = *(const GAS f32x4*)(F.ap->in[I_SSDN] + (size_t)l * 512 + col);
            v2u ov; ov.x = pk2(yT[hh][pb][0] * rstd * nw.x, yT[hh][pb][1] * rstd * nw.y); ov.y = pk2(yT[hh][pb][2] * rstd * nw.z, yT[hh][pb][3] * rstd * nw.w);
            *(GAS v2u*)(WSP(bf16, WS_Y) + (size_t)2 * TT * 512 + row * 512 + col) = ov; }
}
template <bool DRY> __device__ __forceinline__ void p_scan(Frame& F) {
    if (F.wave < 4) {
        const int gt = F.vcu * 256 + F.tid;
        if (gt < 65536) {
        const int bh = gt >> 13, pr = gt & 8191, k = (2 * pr) & 127;
        unsigned* S = (unsigned*)(WSP(bf16, WS_HGS) + (size_t)bh * 128 * 16384) + pr; const float* D = WSP(float, WS_DCH) + (size_t)bh * 128 * 128 + k;
        float r0 = 0.f, r1 = 0.f;
        unsigned xa[16], xb[16]; f32x2 da[16], db[16];
#define SC_LD(X_, D_, c0) do { _Pragma("unroll") for (int i = 0; i < 16; ++i) { X_[i] = __builtin_nontemporal_load((const GAS unsigned*)(S + (size_t)((c0) + i) * 8192)); D_[i] = *(const GAS f32x2*)(D + (size_t)((c0) + i) * 128); } } while (0)
#define SC_PROC(X_, D_, c0) do { _Pragma("unroll") for (int i = 0; i < 16; ++i) { const unsigned pv = pk2(r0, r1); if constexpr (!DRY) *(GAS unsigned*)(S + (size_t)((c0) + i) * 8192) = pv; else asm volatile("" :: "v"(pv)); r0 = r0 * D_[i].x + bflo(X_[i]); r1 = r1 * D_[i].y + bfhi(X_[i]); } } while (0)
        SC_LD(xa, da, 0);
        for (int c0 = 0; c0 < 128; c0 += 32) { SC_LD(xb, db, c0 + 16); SC_PROC(xa, da, c0); if (c0 + 32 < 128) SC_LD(xa, da, c0 + 32); SC_PROC(xb, db, c0 + 16); }
#undef SC_LD
#undef SC_PROC
        }
    } else if (F.wave < 6) {
        const int e = F.vcu * 128 + (F.tid - 256);
        if (e < 32768) {
        const int bh = e >> 11, pr = e & 2047, b = bh >> 3, h = bh & 7;
        unsigned* S = (unsigned*)(WSP(bf16, WS_SSDS) + ((size_t)b * 64 * 8 + h) * 4096) + pr; const float* A = WSP(float, WS_ATOT) + (size_t)b * 64 * 8 + h;
        float r0 = 0.f, r1 = 0.f;
        unsigned xa[16], xb[16]; float da[16], db[16];
#define SC_LD(X_, D_, c0) do { _Pragma("unroll") for (int i = 0; i < 16; ++i) { X_[i] = __builtin_nontemporal_load((const GAS unsigned*)(S + (size_t)((c0) + i) * 8 * 2048)); D_[i] = A[(size_t)((c0) + i) * 8]; } } while (0)
#define SC_PROC(X_, D_, c0) do { _Pragma("unroll") for (int i = 0; i < 16; ++i) { const unsigned pv = pk2(r0, r1); if constexpr (!DRY) *(GAS unsigned*)(S + (size_t)((c0) + i) * 8 * 2048) = pv; else asm volatile("" :: "v"(pv)); const float dd = fexp(D_[i]); r0 = r0 * dd + bflo(X_[i]); r1 = r1 * dd + bfhi(X_[i]); } } while (0)
        SC_LD(xa, da, 0);
        for (int c0 = 0; c0 < 64; c0 += 32) { SC_LD(xb, db, c0 + 16); SC_PROC(xa, da, c0); if (c0 + 32 < 64) SC_LD(xa, da, c0 + 32); SC_PROC(xb, db, c0 + 16); }
#undef SC_LD
#undef SC_PROC
        }
    }
}
#ifndef MK_X0
#define MK_X0 xcc_id()
#endif
#ifndef MK_UNEW_OUT
#define MK_UNEW_OUT WS_W2
#endif

typedef __bf16 bf16x2_t __attribute__((ext_vector_type(2)));
__device__ __forceinline__ float dot2bf(unsigned a, unsigned b, float c) { return __builtin_amdgcn_fdot2_f32_bf16(__builtin_bit_cast(bf16x2_t, a), __builtin_bit_cast(bf16x2_t, b), c, false); }
__device__ __forceinline__ void ins16(float (&top)[16], float x) {
#pragma unroll
    for (int i = 0; i < 16; ++i) { const float hi = __builtin_fmaxf(top[i], x); x = __builtin_fminf(top[i], x); top[i] = hi; }
}
#define CEX(a, b) do { const float hi_ = __builtin_fmaxf(a, b), lo_ = __builtin_fminf(a, b); a = hi_; b = lo_; } while (0)
__device__ __forceinline__ void sort16_desc(float (&v)[16]) {
#define S2(a, b) CEX(v[a], v[b])
    S2(0,13); S2(1,12); S2(2,15); S2(3,14); S2(4,8); S2(5,6); S2(7,11); S2(9,10);
    S2(0,5); S2(1,7); S2(2,9); S2(3,4); S2(6,13); S2(8,14); S2(10,15); S2(11,12);
    S2(0,1); S2(2,3); S2(4,5); S2(6,8); S2(7,9); S2(10,11); S2(12,13); S2(14,15);
    S2(0,2); S2(1,3); S2(4,10); S2(5,11); S2(6,7); S2(8,9); S2(12,14); S2(13,15);
    S2(1,2); S2(3,12); S2(4,6); S2(5,7); S2(8,10); S2(9,11); S2(13,14);
    S2(1,4); S2(2,6); S2(5,8); S2(7,10); S2(9,13); S2(11,14);
    S2(2,4); S2(3,6); S2(9,12); S2(11,13);
    S2(3,5); S2(6,8); S2(7,9); S2(10,12);
    S2(3,4); S2(5,6); S2(7,8); S2(9,10); S2(11,12);
    S2(6,7); S2(8,9);
#undef S2
}
__device__ __forceinline__ void merge16_desc(float (&a)[16], const float (&b)[16]) {
#pragma unroll
    for (int i = 0; i < 16; ++i) a[i] = __builtin_fmaxf(a[i], b[15 - i]);
#pragma unroll
    for (int j = 8; j > 0; j >>= 1)
#pragma unroll
        for (int i = 0; i < 16; ++i) { const int l = i ^ j; if (l > i) CEX(a[i], a[l]); }
}
__device__ __forceinline__ void top16_half(float (&top)[16], const _Float16* base) {
#pragma unroll 1
    for (int g0 = 0; g0 < 8; ++g0) { float x[16];
#pragma unroll
        for (int i = 0; i < 16; ++i) x[i] = (float)__builtin_nontemporal_load((const GAS _Float16*)(base + (size_t)(16 * g0 + i) * TT));
#pragma unroll
        for (int i = 0; i < 16; ++i) x[i] = __builtin_bit_cast(float, (__builtin_bit_cast(unsigned, x[i]) & ~127u) | (unsigned)(16 * g0 + i));
        sort16_desc(x);
        if (g0 == 0) {
#pragma unroll
            for (int i = 0; i < 16; ++i) top[i] = x[i];
        } else merge16_desc(top, x);
    }
}
__device__ __forceinline__ float mkc(float a, float b, unsigned code) { return __builtin_bit_cast(float, (__builtin_bit_cast(unsigned, a + b) & ~255u) | code); }
constexpr int PL_SELB = 0, PL_IDX = 16384, PL_GATE = 32768;
constexpr int CW_PEER = 8192;
__device__ __forceinline__ unsigned xcc_id() { return (unsigned)__builtin_amdgcn_s_getreg((3 << 11) | 20) & 7u; }
__device__ __forceinline__ float row_rstd(const float* ssq, size_t tok) { const f32x4 a = *(const GAS f32x4*)(ssq + tok * 16), b = *(const GAS f32x4*)(ssq + tok * 16 + 4), c = *(const GAS f32x4*)(ssq + tok * 16 + 8), d = *(const GAS f32x4*)(ssq + tok * 16 + 12);
    const f32x4 s = (a + b) + (c + d); return frsq(((s.x + s.y) + (s.z + s.w)) * (1.f / DM) + EPS); }
__device__ __forceinline__ void p_select(Frame& F, int l) {
    LAS unsigned* selb = (LAS unsigned*)(F.lds + PL_SELB); LAS unsigned short* idxl = (LAS unsigned short*)(F.lds + PL_IDX); LAS float* gatel = (LAS float*)(F.lds + PL_GATE);
    const int lane = F.lane, w = F.wave;
    for (int st_ = 0; st_ < 2; ++st_) { const bool enc_ = (st_ == 0) == (MK_PAR_SEL ? (F.vcu & 1) != 0 : false); asm volatile("" ::: "memory");
    if (enc_) { if (!(MK_U8_EARLY && MK_UCOL) || l == 0) for (int q_ = 0; q_ < (MK_REPEAT_SP == 13 ? 2 : 1); ++q_) tables_items<false>(F, l, (size_t)F.vcu * 512 + F.tid, (size_t)F.G * 512);
                if (!MK_V8_IN_U) tables_items<true>(F, l, (size_t)F.vcu * 512 + F.tid, (size_t)F.G * 512); }
    else for (int q2_ = 0; q2_ < (MK_REPEAT_SP == 15 ? 2 : 1); ++q2_) for (int blk = F.vcu; blk < TT / 64; blk += F.G) {
        const int t0 = blk * 64;
        __syncthreads();
        {
            float t1[16], t2[16], fin[16];
            const _Float16* sb = WSP(_Float16, WS_ST) + (size_t)(w * 256) * TT + t0 + lane;
            top16_half(t1, sb); top16_half(t2, sb + (size_t)128 * TT);
            LAS unsigned* mys = selb + (w * 64 + lane) * 8;
#pragma unroll
            for (int q = 0; q < 4; ++q) { unsigned a = 0, b = 0;
#pragma unroll
                for (int i = 0; i < 4; ++i) { a |= (__builtin_bit_cast(unsigned, t1[4 * q + i]) & 127u) << (8 * i); b |= (__builtin_bit_cast(unsigned, t2[4 * q + i]) & 127u) << (8 * i); }
                mys[q] = a; mys[4 + q] = b; }
#pragma unroll
            for (int j = 0; j < 16; ++j) fin[j] = mkc(t1[0], t2[j], (unsigned)j);
#define CND(i, j) mkc(t1[i], t2[j], (unsigned)((i) * 16 + (j)))
            { float ca[16] = {CND(1,0), CND(1,1), CND(1,2), CND(1,3), CND(1,4), CND(1,5), CND(1,6), CND(1,7), CND(2,0), CND(2,1), CND(2,2), CND(2,3), CND(2,4), CND(4,0), CND(4,1), CND(4,2)};
              sort16_desc(ca); merge16_desc(fin, ca); }
            { float cb[16] = {CND(3,0), CND(3,1), CND(3,2), CND(3,3), CND(5,0), CND(5,1), CND(6,0), CND(6,1), CND(7,0), CND(7,1), CND(8,0), CND(9,0), CND(10,0), CND(11,0), CND(12,0), CND(13,0)};
              sort16_desc(cb); merge16_desc(fin, cb); }
            ins16(fin, CND(14,0)); ins16(fin, CND(15,0));
#undef CND
            float m = fin[0];
#pragma unroll
            for (int r = 1; r < 16; ++r) m = __builtin_fmaxf(m, fin[r]);
            float ex[16], sum = 0.f;
            const float rs_ = row_rstd(WSP(float, WS_SSQ), (size_t)t0 + lane);
#pragma unroll
            for (int r = 0; r < 16; ++r) { ex[r] = fexp((fin[r] - m) * rs_); sum += ex[r]; }
            if (w == 0) WSP(float, WS_RSTD)[t0 + lane] = rs_;
            const float inv = frcp(sum);
            LDS_WAIT();
            const LAS unsigned char* myb = (const LAS unsigned char*)mys;
#pragma unroll
            for (int r = 0; r < 16; ++r) { const unsigned code = __builtin_bit_cast(unsigned, fin[r]) & 255u; const unsigned i1 = myb[code >> 4], i2 = myb[16 + (code & 15u)];
                idxl[lane * 128 + w * 16 + r] = (unsigned short)(i1 * 128u + i2); gatel[lane * 128 + w * 16 + r] = ex[r] * inv; }
        }
        __syncthreads();
        for (int e = F.tid; e < 1024; e += 512) *(GAS v4u*)(WSP(unsigned char, WS_IDX) + (size_t)t0 * 256 + e * 16) = *(const LAS v4u*)((const LAS unsigned char*)idxl + e * 16);
        for (int e = F.tid; e < 2048; e += 512) *(GAS v4u*)(WSP(unsigned char, WS_W) + (size_t)t0 * 512 + e * 16) = *(const LAS v4u*)((const LAS unsigned char*)gatel + e * 16);
    }
    __syncthreads(); }
}
__device__ __forceinline__ void cvt16(v4u p, float* v) {
    const unsigned wds[4] = {p.x, p.y, p.z, p.w};
#pragma unroll
    for (int q = 0; q < 4; ++q) { const f32x2 lo = __builtin_amdgcn_cvt_pk_f32_fp8((int)wds[q], false), hi = __builtin_amdgcn_cvt_pk_f32_fp8((int)wds[q], true); v[4 * q] = lo.x; v[4 * q + 1] = lo.y; v[4 * q + 2] = hi.x; v[4 * q + 3] = hi.y; }
}
__device__ __forceinline__ unsigned peer_ticket(Frame& F, int cw, unsigned x) { unsigned t = 0; if (F.lane == 0) t = __hip_atomic_fetch_add((gu32*)(F.ap->ws + WS_CTL) + cw + x * 64, 1u, RLX_AGENT); return t; }
typedef __bf16 bf16x2v __attribute__((ext_vector_type(2)));
template <bool DRY> __device__ __forceinline__ void p_peer_u2(Frame& F, int l, int cset = 0) {
    constexpr int TPT = 8, NTASK = TT / TPT;
    LAS unsigned char* wl = F.lds + F.wave * 6144;
    LAS unsigned short* idxT = (LAS unsigned short*)wl;
    LAS unsigned char* hT = wl + 2048;
    const int lane = F.lane, g = lane >> 3, c = lane & 7;
    const unsigned char* U8 = (const unsigned char*)F.ap->ws + ((MK_U8_EARLY && l == 1) ? WS_WIN : WS_U8);
    const unsigned x0 = MK_X0; const int cw = CW_PEER + ((DRY ? 4 : cset) + l * 2 + 0) * 8 * 64;
    const int wdst = ((2 * lane) & 7) * 16 + (lane >> 2);
    if constexpr (!DRY && MK_V8_IN_U) { if (F.wave >= NWAVES - 2) tables_items<true>(F, l, ((size_t)F.vcu * 2 + (F.wave - (NWAVES - 2))) * 64 + lane, (size_t)F.G * 2 * 64); }
    for (unsigned so = 0; so < 8; ++so) { const unsigned x = (x0 + so) & 7u;
      unsigned cur = (unsigned)__builtin_amdgcn_readfirstlane((int)peer_ticket(F, cw, x));
      while (cur < (unsigned)NTASK) {
        const unsigned nxtv = peer_ticket(F, cw, x);
        const size_t tk0 = (size_t)cur * TPT;
        { unsigned pr[TPT];
#pragma unroll
          for (int k = 0; k < TPT; ++k) pr[k] = *(const GAS unsigned*)(WSP(unsigned, WS_IDX) + (tk0 + k) * 64 + lane);
          const bf16* hp = WSP(bf16, WS_XW) + (tk0 + g) * DM + 128 * (int)x + 16 * c;
          const v4u h0 = *(const GAS v4u*)hp, h1 = *(const GAS v4u*)(hp + 8);
#pragma unroll
          for (int k = 0; k < TPT; ++k) { idxT[k * 128 + wdst] = (unsigned short)(pr[k] & 0xffffu); idxT[k * 128 + wdst + 16] = (unsigned short)(pr[k] >> 16); }
          *(LAS v4u*)(hT + lane * 32) = h0; *(LAS v4u*)(hT + lane * 32 + 16) = h1; }
        LDS_WAIT();
        v4u rA[8], rB[8];
        float* pbase = WSP(float, WS_UP) + (tk0 * 8 + x) * 128 + 2 * lane;
        const unsigned char* ubase = U8 + (size_t)x * (16384 * 128) + 16 * c;
#define PU2_ISSUE(R, k, ih) do { const v4u iq = *(const LAS v4u*)(idxT + (k) * 128 + g * 16 + 8 * (ih)); const unsigned iw[4] = {iq.x, iq.y, iq.z, iq.w}; \
            _Pragma("unroll") for (int i = 0; i < 8; ++i) { const unsigned e = (i & 1) ? (iw[i >> 1] >> 16) : (iw[i >> 1] & 0xffffu); R[i] = *(const GAS v4u*)(ubase + (size_t)e * 128); } } while (0)
#define PU2_DOT(R, ih) do { _Pragma("unroll") for (int i = 0; i < 8; ++i) { const unsigned rq[4] = {R[i].x, R[i].y, R[i].z, R[i].w}; f32x2 a2 = {0.f, 0.f}; \
                _Pragma("unroll") for (int q = 0; q < 4; ++q) { a2 = __builtin_elementwise_fma(__builtin_amdgcn_cvt_pk_f32_fp8((int)rq[q], false), h2[2 * q], a2); a2 = __builtin_elementwise_fma(__builtin_amdgcn_cvt_pk_f32_fp8((int)rq[q], true), h2[2 * q + 1], a2); } \
                s[8 * (ih) + i] = a2[0] + a2[1]; } } while (0)
        PU2_ISSUE(rA, 0, 0);
#pragma unroll 1
        for (int k = 0; k < TPT; ++k) {
            PU2_ISSUE(rB, k, 1);
            f32x2 h2[8];
            { const v4u h0 = *(const LAS v4u*)(hT + (k * 8 + c) * 32), h1 = *(const LAS v4u*)(hT + (k * 8 + c) * 32 + 16); const unsigned hw[8] = {h0.x, h0.y, h0.z, h0.w, h1.x, h1.y, h1.z, h1.w};
#pragma unroll
              for (int q = 0; q < 8; ++q) h2[q] = (f32x2){bflo(hw[q]), bfhi(hw[q])}; }
            float s[16];
            PU2_DOT(rA, 0);
            if (k + 1 < TPT) PU2_ISSUE(rA, k + 1, 0);
            PU2_DOT(rB, 1);
#pragma unroll
            for (int i = 0; i < 8; ++i) s[i] = hsum4(s[i], s[i + 8], (lane & 4) != 0);
#pragma unroll
            for (int i = 0; i < 4; ++i) s[i] = hsum2(s[i], s[i + 4], (lane & 2) != 0);
#pragma unroll
            for (int i = 0; i < 2; ++i) s[i] = hsum1(s[i], s[i + 2], (lane & 1) != 0);
            const unsigned long long po = (unsigned long long)__builtin_bit_cast(unsigned, s[0]) | ((unsigned long long)__builtin_bit_cast(unsigned, s[1]) << 32);
            if constexpr (!DRY) *(GAS unsigned long long*)(pbase + (size_t)k * 1024) = po; else asm volatile("" :: "v"(po));
        }
#undef PU2_ISSUE
#undef PU2_DOT
        LDS_WAIT();
        cur = (unsigned)__builtin_amdgcn_readfirstlane((int)nxtv);
      } }
}
template <bool DRY> __device__ __forceinline__ void p_reduce_u(Frame& F) {
    const int gw = F.vcu * NWAVES + F.wave, NGW = F.G * NWAVES, lane = F.lane;
    const int p0 = 2 * lane, j0 = 8 * (p0 & 15) + (p0 >> 4), j1 = j0 + 8;
    for (int tb = gw * 4; tb < TT; tb += NGW * 4) {
        f32x2 v[4][8]; float g0[4], g1[4], rs[4];
#pragma unroll
        for (int q = 0; q < 4; ++q) { const size_t t = (size_t)tb + q;
#pragma unroll
            for (int x = 0; x < 8; ++x) v[q][x] = *(const GAS f32x2*)(WSP(float, WS_UP) + (t * 8 + x) * 128 + p0);
            g0[q] = WSP(float, WS_W)[t * 128 + j0]; g1[q] = WSP(float, WS_W)[t * 128 + j1]; rs[q] = WSP(float, WS_RSTD)[t]; }
#pragma unroll
        for (int q = 0; q < 4; ++q) { const size_t t = (size_t)tb + q;
            const f32x2 sm = ((v[q][0] + v[q][1]) + (v[q][2] + v[q][3])) + ((v[q][4] + v[q][5]) + (v[q][6] + v[q][7]));
            const float sc = rs[q] * (1.0f / 256.0f); const float w0 = g0[q] * geluf_(sm[0] * sc), w1 = g1[q] * geluf_(sm[1] * sc);
            const unsigned long long wo = (unsigned long long)__builtin_bit_cast(unsigned, w0) | ((unsigned long long)__builtin_bit_cast(unsigned, w1) << 32);
            if constexpr (!DRY) *(GAS unsigned long long*)(WSP(float, WS_W2) + t * 128 + p0) = wo; else asm volatile("" :: "v"(wo)); }
    }
}
template <bool DRY> __device__ __forceinline__ void p_peer_v(Frame& F, int l) {
    constexpr int TPT = 8, NTASK = TT / TPT;
    LAS unsigned char* wl = F.lds + F.wave * 6144;
    LAS unsigned short* idxT = (LAS unsigned short*)wl;
    LAS float* wT = (LAS float*)(wl + 2048);
    const int lane = F.lane, g = lane >> 3, c = lane & 7;
    const unsigned char* V8 = WSP(unsigned char, WS_V8);
    const unsigned x0 = MK_X0; const int cw = CW_PEER + ((DRY ? 4 : 0) + l * 2 + 1) * 8 * 64;
    const int colo = 16 * c + ((lane >> 5) & 1) * 8 + ((lane >> 4) & 1) * 4 + ((lane >> 3) & 1) * 2;
    const int wdst = ((2 * lane) & 7) * 16 + (lane >> 2);
    if constexpr (!DRY && MK_U8_EARLY && MK_UCOL) { if (l == 0 && F.wave >= NWAVES - 2) tables_items<false>(F, 1, ((size_t)F.vcu * 2 + (F.wave - (NWAVES - 2))) * 64 + lane, (size_t)F.G * 2 * 64, WS_WIN); }
    if constexpr (!DRY && MK_W1_LATE) { if (l == 0 && F.wave >= NWAVES - 2) { LAS float* scr = (LAS float*)(F.lds + 65536 + (F.wave - (NWAVES - 2)) * 16640);
        for (int it = F.vcu * 2 + (F.wave - (NWAVES - 2)); it < WT_PER_LAYER; it += F.G * 2) wt_item(F, 1, it, scr); } }
    for (unsigned so = 0; so < 8; ++so) { const unsigned x = (x0 + so) & 7u;
      unsigned cur = (unsigned)__builtin_amdgcn_readfirstlane((int)peer_ticket(F, cw, x));
      while (cur < (unsigned)NTASK) {
        const unsigned nxtv = peer_ticket(F, cw, x);
        const size_t tk0 = (size_t)cur * TPT;
        { unsigned pr[TPT]; unsigned long long wv[TPT];
#pragma unroll
          for (int k = 0; k < TPT; ++k) { pr[k] = *(const GAS unsigned*)(WSP(unsigned, WS_IDX) + (tk0 + k) * 64 + lane); wv[k] = *(const GAS unsigned long long*)(WSP(float, WS_W2) + (tk0 + k) * 128 + 2 * lane); }
#pragma unroll
          for (int k = 0; k < TPT; ++k) { idxT[k * 128 + wdst] = (unsigned short)(pr[k] & 0xffffu); idxT[k * 128 + wdst + 16] = (unsigned short)(pr[k] >> 16);
              if (MK_UCOL) *(LAS unsigned long long*)(wT + k * 128 + 2 * lane) = wv[k];
              else { wT[k * 128 + wdst] = __builtin_bit_cast(float, (unsigned)wv[k]); wT[k * 128 + wdst + 16] = __builtin_bit_cast(float, (unsigned)(wv[k] >> 32)); } } }
        LDS_WAIT();
        v4u rA[8], rB[8]; unsigned xv; f32x2 acc2[8];
        bf16* xbase = WSP(bf16, WS_XB) + tk0 * DM + 128 * (int)x + colo;
        float w1a = 0.f, w1b = 0.f; if (l == 0) { const float* wp_ = F.ap->in[I_N1] + DM + 128 * (int)x + colo; w1a = wp_[0]; w1b = wp_[1]; }
        const unsigned char* vbase = V8 + (size_t)x * (16384 * 128) + 16 * c;
#define PV_ISSUE(R, k, ih) do { const v4u iq = *(const LAS v4u*)(idxT + (k) * 128 + g * 16 + 8 * (ih)); const unsigned iw[4] = {iq.x, iq.y, iq.z, iq.w}; \
            _Pragma("unroll") for (int i = 0; i < 8; ++i) { const unsigned e = (i & 1) ? (iw[i >> 1] >> 16) : (iw[i >> 1] & 0xffffu); R[i] = *(const GAS v4u*)(vbase + (size_t)e * 128); } } while (0)
#define PV_ACC(R, k, ih) do { const f32x4 wq0 = *(const LAS f32x4*)(wT + (k) * 128 + g * 16 + 8 * (ih)), wq1 = *(const LAS f32x4*)(wT + (k) * 128 + g * 16 + 8 * (ih) + 4); \
            const float wa[8] = {wq0.x, wq0.y, wq0.z, wq0.w, wq1.x, wq1.y, wq1.z, wq1.w}; \
            _Pragma("unroll") for (int i = 0; i < 8; ++i) { const f32x2 w2 = {wa[i], wa[i]}; const unsigned rq[4] = {R[i].x, R[i].y, R[i].z, R[i].w}; \
                _Pragma("unroll") for (int q = 0; q < 4; ++q) { acc2[2 * q] = __builtin_elementwise_fma(__builtin_amdgcn_cvt_pk_f32_fp8((int)rq[q], false), w2, acc2[2 * q]); \
                                                               acc2[2 * q + 1] = __builtin_elementwise_fma(__builtin_amdgcn_cvt_pk_f32_fp8((int)rq[q], true), w2, acc2[2 * q + 1]); } } } while (0)
        PV_ISSUE(rA, 0, 0);
#pragma unroll 1
        for (int k = 0; k < TPT; ++k) {
            PV_ISSUE(rB, k, 1); xv = *(const GAS unsigned*)(xbase + (size_t)k * DM);
#pragma unroll
            for (int q = 0; q < 8; ++q) acc2[q] = (f32x2){0.f, 0.f};
            PV_ACC(rA, k, 0);
            if (k + 1 < TPT) PV_ISSUE(rA, k + 1, 0);
            PV_ACC(rB, k, 1);
            float acc[16];
#pragma unroll
            for (int q = 0; q < 8; ++q) { acc[2 * q] = acc2[q][0]; acc[2 * q + 1] = acc2[q][1]; }
#pragma unroll
            for (int i = 0; i < 8; ++i) acc[i] = hsum32(acc[i], acc[i + 8]);
#pragma unroll
            for (int i = 0; i < 4; ++i) acc[i] = hsum16(acc[i], acc[i + 4]);
#pragma unroll
            for (int i = 0; i < 2; ++i) acc[i] = hsum8(acc[i], acc[i + 2], (lane & 8) != 0);
            const float o0 = bflo(xv) + acc[0] * (1.0f / 32.0f), o1 = bfhi(xv) + acc[1] * (1.0f / 32.0f);
            const unsigned xo = pk2(o0, o1);
            if constexpr (!DRY) *(GAS unsigned*)(xbase + (size_t)k * DM) = xo; else asm volatile("" :: "v"(xo));
            if (l == 0) { const unsigned yw = pk2(o0 * w1a, o1 * w1b); const float ss = wave_sum(o0 * o0 + o1 * o1, lane);
                if constexpr (!DRY) { *(GAS unsigned*)(XNP + (tk0 + k) * DM + 128 * (int)x + colo) = yw; if (lane == 0) WSP(float, WS_SSQ1)[(tk0 + k) * 8 + x] = ss; } else asm volatile("" :: "v"(yw), "v"(ss)); }
        }
#undef PV_ISSUE
#undef PV_ACC
        LDS_WAIT();
        cur = (unsigned)__builtin_amdgcn_readfirstlane((int)nxtv);
      } }
}
template <bool DRY> __device__ __forceinline__ void p_rownorm(Frame& F, int l, bool last) {
    const int gw = F.vcu * NWAVES + F.wave, NGW = F.G * NWAVES;
    const bf16* X = WSP(bf16, WS_XB);
    v2u nx[4];
    { const GAS v2u* x0 = (const GAS v2u*)(X + (size_t)gw * DM) + F.lane;
#pragma unroll
      for (int j = 0; j < 4; ++j) nx[j] = x0[64 * j]; }
    for (int m = gw; m < TT; m += NGW) {
        GAS f32x4* xr = (GAS f32x4*)(F.ap->out + (size_t)m * DM) + F.lane;
        f32x4 v[4];
#pragma unroll
        for (int j = 0; j < 4; ++j) v[j] = (f32x4){bflo(nx[j].x), bfhi(nx[j].x), bflo(nx[j].y), bfhi(nx[j].y)};
        if (m + NGW < TT) { const GAS v2u* xn_ = (const GAS v2u*)(X + (size_t)(m + NGW) * DM) + F.lane;
#pragma unroll
            for (int j = 0; j < 4; ++j) nx[j] = xn_[64 * j]; }
        float s = 0.f;
#pragma unroll
        for (int j = 0; j < 4; ++j) s += (v[j].x * v[j].x + v[j].y * v[j].y) + (v[j].z * v[j].z + v[j].w * v[j].w);
        const float rstd = frsq(wave_sum(s, F.lane) * (1.f / DM) + EPS);
#pragma unroll
        for (int j = 0; j < 4; ++j) { const f32x4 wv = *(const GAS f32x4*)(F.ap->in[I_FN] + 4 * F.lane + 256 * j); const f32x4 ov = v[j] * rstd * wv; if constexpr (!DRY) xr[64 * j] = ov; else asm volatile("" :: "v"(ov)); }
    }
    __syncthreads();
}

#ifndef MK_PHASE_MASK
#define MK_PHASE_MASK 0x3ff
#endif
#ifndef MK_DBLBAR
#define MK_DBLBAR 0
#endif
#ifndef MK_SP2
#define MK_SP2 true
#endif
#ifndef MK_REPEAT_SP
#define MK_REPEAT_SP -1
#endif
#ifndef MK_MIX_SUB
#define MK_MIX_SUB 7
#endif
#define MIXS(k) ((MK_MIX_SUB >> (k)) & 1)
#define REP(k) (MK_REPEAT_SP == (k))
#define PHM(k) ((MK_PHASE_MASK >> (k)) & 1)
#ifndef MK_STOP_PHASE
#define MK_STOP_PHASE (22 + 2 * MK_UCOL)
#endif
constexpr int N_PHASES = MK_STOP_PHASE;
#define MK_LAUNDER() do { { KArgs ap = (KArgs)__builtin_amdgcn_kernarg_segment_ptr(); asm volatile("" : "+s"(ap)); F.ap = ap; } { int w0 = wave0; asm volatile("" : "+s"(w0)); int ln; asm volatile("v_mbcnt_lo_u32_b32 %0, -1, 0\n\tv_mbcnt_hi_u32_b32 %0, -1, %0" : "=v"(ln)); F.wave = w0; F.lane = ln; F.tid = w0 * 64 + ln; } { int G = gridDim.x, bx = blockIdx.x; asm volatile("" : "+s"(G), "+s"(bx)); F.G = G; F.vcu = (G % 8 == 0) ? (bx % 8) * (G / 8) + bx / 8 : bx; F.bx = bx; } { LAS unsigned char* lp = (LAS unsigned char*)lds; asm volatile("" : "+s"(lp)); F.lds = lp; } } while (0)
__global__ void __launch_bounds__(NWAVES * 64, 2) fwd_kernel(Args args) {
    extern __shared__ __attribute__((aligned(16))) unsigned char lds[];
    Frame F;
#if MK_BARRIER == 1
    { LAS unsigned* z = (LAS unsigned*)((LAS unsigned char*)lds + LDSCTL_OFF); for (int u = threadIdx.x; u < (LDS_BYTES - LDSCTL_OFF) / 4; u += NWAVES * 64) z[u] = 0u; }
    __syncthreads();
    const int wave0 = __builtin_amdgcn_readfirstlane((int)threadIdx.x >> 6);
    (void)xcd_barrier_post((unsigned*)(args.ws + WS_CTL) + CW_BAR, (volatile LAS unsigned*)((LAS unsigned char*)lds + MISC_OFF) + 8, (int)threadIdx.x);
#endif
    int rep_ph = -1;
    for (int ph = args.ph_lo; ph < args.ph_hi; ++ph) {
        MK_LAUNDER();
        {
        if (ph == 0) { if (PHM(0)) for (int r_ = 0; r_ < (REP(12) ? 2 : 1); ++r_) p0_prologue(F); }
        else {
            constexpr int NS0 = 10 + MK_UCOL;
            const int l = (ph - 1) >= NS0 ? 1 : 0; int sp = (ph - 1) - NS0 * l; if (sp >= 6) ++sp;
            if (MK_UCOL) { if (sp == 10) sp = 12; else if (sp > 10) --sp; }
            if (sp == 0) { if (PHM(1)) {
                LAS float* rsl = (LAS float*)(F.lds + RING_BYTES); const int xg = F.bx & 7;
                for (int r = F.tid; r < 2048; r += 512) { float v = 1.f;
                    if (l > 0) { const float* pp = WSP(float, WS_SSQ1) + ((size_t)xg * 2048 + r) * 8; const f32x4 a = *(const GAS f32x4*)pp, b = *(const GAS f32x4*)(pp + 4); v = frsq((((a.x + a.y) + (a.z + a.w)) + ((b.x + b.y) + (b.z + b.w))) * (1.f / DM) + EPS); }
                    rsl[r] = v; }
                __syncthreads();
                pg8::Gemm g{XNP, WSP(bf16, WS_WIN + (size_t)l * 16 * MiB), TT, NP + 256, DM}; pg8::StaticOrder S; S.init(TT, NP + 256, F.G, F.bx);
                pg8::EpiProj E{WSP(bf16, WS_PROJ), NP, WSP(float, WS_DT), rsl, (F.G % 8 == 0) ? xg : -1, WSP(float, WS_SSQ1), l > 0};
                pg8::gemm_phase<pg8::EpiProj, pg8::StaticOrder, true, MK_SP2>(F.lds, g, S, E, F.tid);
            } } else if (sp == 1) { if (PHM(2)) {
                for (int r_ = 0; r_ < (REP(1) ? 2 : 1); ++r_)
                { const bool odd_ = MK_PAR_MIX1 && (F.vcu & 1) != 0;
                  if (odd_) { for (int q_ = 0; q_ < (MK_REPEAT_SP == 22 ? 2 : 1); ++q_) p_sb_attn(F); __syncthreads(); }
                  MK_LAUNDER();
                  for (int q_ = 0; q_ < (MK_REPEAT_SP == 20 ? 2 : 1); ++q_) for (int u = F.vcu; u < 1024; u += F.G) hg_local_unit(F, l, u >> 9, (u >> 7) & 3, u & 127);
                  for (int q_ = 0; q_ < (MK_REPEAT_SP == 21 ? 2 : 1); ++q_) for (int u = F.vcu; u < 256; u += F.G) ssd_local_unit(F, l, u >> 7, (u >> 1) & 63, u & 1);
                  MK_LAUNDER();
                  if (!odd_) { __syncthreads(); for (int q_ = 0; q_ < (MK_REPEAT_SP == 22 ? 2 : 1); ++q_) p_sb_attn(F); } }
            } } else if (sp == 2) { if (PHM(3)) {
                if (REP(2)) p_scan<true>(F);
                p_scan<false>(F);
            } } else if (sp == 3) { if (PHM(4)) {
                for (int r_ = 0; r_ < (REP(3) ? 2 : 1); ++r_) {
                hg_out_units(F, l, F.vcu, F.G);
                for (int u = F.vcu; u < 256; u += F.G) ssd_out_unit(F, l, u >> 7, (u >> 1) & 63, u & 1); }
            } } else if (sp == 4) { if (PHM(5)) {
                pg8::Gemm g{WSP(bf16, WS_Y), WSP(bf16, WS_WBR + (size_t)l * 3 * MiB), 3 * TT, 3 * DM, 512}; pg8::MergeOrder S{F.vcu, F.G};
                pg8::EpiMerge2 E{WSP(bf16, WS_PROJ) + C_GATE, NP, XNP, DM};
                pg8::gemm_phase<pg8::EpiMerge2, pg8::MergeOrder, true, MK_SP2>(F.lds, g, S, E, F.tid);
            } } else if (sp == 5) { if (PHM(6)) {
                pg8::Gemm g{XNP, WSP(bf16, WS_WOUT + (size_t)l * 2 * MiB), TT, DM, DM}; pg8::StaticOrder S; S.init(TT, DM, F.G, F.bx);
                if (l == 0) { pg8::EpiResNorm<true> E{F.ap->in[I_X], WSP(bf16, WS_XB), DM, F.ap->in[I_N2] + (size_t)l * DM, WSP(bf16, WS_XW), WSP(float, WS_SSQ)};
                    pg8::gemm_phase<pg8::EpiResNorm<true>, pg8::StaticOrder, true, MK_SP2>(F.lds, g, S, E, F.tid); }
                else { pg8::EpiResNorm<false> E{WSP(bf16, WS_XB), WSP(bf16, WS_XB), DM, F.ap->in[I_N2] + (size_t)l * DM, WSP(bf16, WS_XW), WSP(float, WS_SSQ)};
                    pg8::gemm_phase<pg8::EpiResNorm<false>, pg8::StaticOrder, true, MK_SP2>(F.lds, g, S, E, F.tid); }
            } } else if (sp == 7) { if (PHM(8)) {
                pg8::Gemm g{WSP(bf16, WS_WEFF + (size_t)l * 4 * MiB), WSP(bf16, WS_XW), 2048, TT, DM}; pg8::StaticOrder S; S.init(2048, TT, F.G, F.bx);
                pg8::EpiF16 E{WSP(_Float16, WS_ST), TT};
                pg8::gemm_phase<pg8::EpiF16, pg8::StaticOrder, true, MK_SP2>(F.lds, g, S, E, F.tid);
            } } else if (sp == 8) { if (PHM(9)) for (int r_ = 0; r_ < (REP(8) ? 2 : 1); ++r_) p_select(F, l);
            } else if (sp == 12) { if (PHM(9)) { if (REP(14)) p_reduce_u<true>(F); p_reduce_u<false>(F); }
            } else if (sp == 9 && MK_UCOL) { if (PHM(9) && MIXS(0)) { if (REP(9)) p_peer_u2<true>(F, l); if (REP(16)) p_peer_u2<false>(F, l, 4); p_peer_u2<false>(F, l); }
            } else if (sp == 10) { if (PHM(9) && MIXS(1)) { if (REP(10)) p_peer_v<true>(F, l); p_peer_v<false>(F, l); }
            } else { if (PHM(9)) { if (REP(11)) p_rownorm<true>(F, l, true); p_rownorm<false>(F, l, true); }
            }
        }
        }
        if ((MK_REPEAT_SP == 0 || MK_REPEAT_SP == 4 || MK_REPEAT_SP == 7) && ph > 0 && (((ph - 1) >= 10 + MK_UCOL ? ph - 11 - MK_UCOL : ph - 1) + ((((ph - 1) >= 10 + MK_UCOL ? ph - 11 - MK_UCOL : ph - 1)) >= 6 ? 1 : 0)) == MK_REPEAT_SP && rep_ph != ph) { rep_ph = ph; --ph; __syncthreads(); continue; }
#if MK_BARRIER == 1
        if (ph + 1 < args.ph_hi) { if (args.ph_hi - args.ph_lo == 2) cg::this_grid().sync();
            else { XcdBarrier bar; bar.bar = (unsigned*)(F.ap->ws + WS_CTL) + CW_BAR; bar.x = xb_xcc_id(); bar.st = (volatile LAS unsigned*)((LAS unsigned char*)lds + MISC_OFF) + 8; xcd_barrier(bar, F.tid); if (MK_DBLBAR) xcd_barrier(bar, F.tid); } }
#else
        if (ph + 1 < args.ph_hi) cg::this_grid().sync();
#endif
    }
}

extern "C" void kernel_launch(void* const* d_in, const int* in_sizes, int n_in, void* d_out, int out_size, void* d_ws, size_t ws_size, hipStream_t stream) {
    static int grid = 0;
    if (grid == 0) {
        if (n_in != 21 || out_size != TT * DM || ws_size < WS_END) { fprintf(stderr, "kernel_launch: unexpected shapes (n_in %d out %d ws %zu)\n", n_in, out_size, ws_size); grid = -1; return; }
        int dev = 0, cus = 0, per_cu = 0;
        if (hipGetDevice(&dev) != hipSuccess || hipDeviceGetAttribute(&cus, hipDeviceAttributeMultiprocessorCount, dev) != hipSuccess) { grid = -1; return; }
        if (hipFuncSetAttribute((const void*)fwd_kernel, hipFuncAttributeMaxDynamicSharedMemorySize, LDS_BYTES) != hipSuccess) { fprintf(stderr, "kernel_launch: hipFuncSetAttribute failed\n"); grid = -1; return; }
        if (hipOccupancyMaxActiveBlocksPerMultiprocessor(&per_cu, (const void*)fwd_kernel, NWAVES * 64, LDS_BYTES) != hipSuccess || per_cu < 1) { fprintf(stderr, "kernel_launch: occupancy query says %d\n", per_cu); (void)hipGetLastError(); per_cu = 1; }
        grid = cus;
        if (grid > 256) grid = 256;
    }
    if (grid < 0) return;
#if MK_BARRIER == 1
    if (hipMemsetAsync((char*)d_ws + WS_CTL, 0, CTL_ZERO_BYTES, stream) != hipSuccess) { fprintf(stderr, "kernel_launch: memset failed\n"); return; }
#endif
    Args a{};
    for (int i = 0; i < 21; ++i) a.in[i] = (const float*)d_in[i];
    a.out = (float*)d_out; a.ws = (unsigned char*)d_ws;
#if MK_N_LAUNCHES == 1
    a.ph_lo = 0; a.ph_hi = N_PHASES;
    void* kargs[] = {&a};
    hipError_t e = hipLaunchCooperativeKernel((const void*)fwd_kernel, dim3(grid), dim3(NWAVES * 64), kargs, LDS_BYTES, stream);
    if (e != hipSuccess) fprintf(stderr, "kernel_launch: cooperative launch failed: %s (grid %d)\n", hipGetErrorString(e), grid);
#else
    for (int ph = 0; ph < N_PHASES; ++ph) { a.ph_lo = ph; a.ph_hi = ph + 1;
        hipLaunchKernelGGL(fwd_kernel, dim3(grid), dim3(NWAVES * 64), LDS_BYTES, stream, a); }
#ifdef MK_DIAG
    a.ph_lo = MK_DIAG; a.ph_hi = MK_DIAG + 1; hipLaunchKernelGGL(fwd_kernel, dim3(grid), dim3(NWAVES * 64), LDS_BYTES, stream, a);
#endif
#endif
}
```

```cpp
#include <hip/hip_runtime.h>
#include <hip/hip_cooperative_groups.h>
#include <cstdio>
#include <cstdint>
namespace cg = cooperative_groups;

#ifndef MK_N_LAUNCHES
#define MK_N_LAUNCHES 1
#ifndef MK_REPEAT_SP
#define MK_REPEAT_SP -1
#endif
#endif
#ifndef MK_PAR_MIX1
#define MK_PAR_MIX1 0
#endif
#ifndef MK_PAR_SEL
#define MK_PAR_SEL 0
#endif
#ifndef MK_V8_IN_U
#define MK_V8_IN_U 1
#endif
#ifndef MK_UCOL
#define MK_UCOL 1
#endif
#ifndef MK_U8_EARLY
#define MK_U8_EARLY 0
#endif
#ifndef MK_W1_LATE
#define MK_W1_LATE 0
#endif
#ifndef MK_WT_STORES
#define MK_WT_STORES 1
#endif
#ifndef MK_BARRIER
#define MK_BARRIER 1
#endif

constexpr int TT = 16384;
constexpr int SEQ = 8192;
constexpr int DM = 1024;
constexpr int NP = 7936;
constexpr int C_SBQ = 0, C_SBK = 512, C_SBV = 1024, C_HGF = 1536, C_HGQ = 2048, C_HGI = 2560, C_HGG = 3072, C_SSDZ = 3584, C_XBC = 4096, C_GATE = 4864;
constexpr int W_IN_COLS = 7944, W_DT_COL = 4864, W_GATE_COL = 4872;
constexpr float EPS = 1e-6f;

constexpr size_t MiB = 1u << 20;
constexpr size_t WS_CTL = 0, CTL_ZERO_BYTES = 1 * MiB;
constexpr size_t WS_WIN = 2 * MiB;
constexpr size_t WS_WBR = 34 * MiB;
constexpr size_t WS_WOUT = 40 * MiB;
constexpr size_t WS_WEFF = 44 * MiB;
constexpr size_t WS_XB = 64 * MiB;
#define XNP ((bf16*)F.ap->out)
constexpr size_t WS_PROJ = 96 * MiB;
constexpr size_t WS_ST = 96 * MiB;
constexpr size_t WS_U8 = 224 * MiB, WS_V8 = 240 * MiB;
constexpr size_t WS_IDX = 52 * MiB;
constexpr size_t WS_W = 56 * MiB;
constexpr size_t WS_Y = 344 * MiB;
constexpr size_t WS_QT = 392 * MiB;
constexpr size_t WS_OI = 408 * MiB;
constexpr size_t WS_HGS = 424 * MiB;
constexpr size_t WS_CE = 456 * MiB;
constexpr size_t WS_YD = 472 * MiB;
constexpr size_t WS_SSDS = 488 * MiB;
constexpr size_t WS_DT = 496 * MiB;
constexpr size_t WS_DCH = 497 * MiB;
constexpr size_t WS_ATOT = 498 * MiB;
constexpr size_t WS_SSQ = 499 * MiB;
constexpr size_t WS_XW = 160 * MiB;
constexpr size_t WS_RSTD = 498 * MiB + 512 * 1024;
constexpr size_t WS_SSQ1 = 497 * MiB + 512 * 1024;
constexpr size_t WS_UP = 344 * MiB;
constexpr size_t WS_W2 = 500 * MiB;
constexpr size_t WS_END = 508 * MiB;

constexpr int RING_BYTES = 131072;
constexpr int LDSCTL_OFF = 143360, MISC_OFF = LDSCTL_OFF + 320;
constexpr int LDS_BYTES = 147456;
constexpr int NWAVES = 8;

#define GAS __attribute__((address_space(1)))
#define LAS __attribute__((address_space(3)))
typedef unsigned short bf16;
typedef unsigned v4u __attribute__((ext_vector_type(4)));
typedef unsigned v2u __attribute__((ext_vector_type(2)));
typedef float f32x4 __attribute__((ext_vector_type(4)));
typedef float f32x2 __attribute__((ext_vector_type(2)));
typedef float f32x16 __attribute__((ext_vector_type(16)));
typedef short bf16x8 __attribute__((ext_vector_type(8)));
typedef short bf16x4 __attribute__((ext_vector_type(4)));
typedef GAS unsigned gu32;
typedef GAS unsigned long long gu64;
#define RLX_AGENT __ATOMIC_RELAXED, __HIP_MEMORY_SCOPE_AGENT
#define LDS_WAIT() asm volatile("s_waitcnt lgkmcnt(0)" ::: "memory")
#define VM_WAIT() asm volatile("s_waitcnt vmcnt(0)" ::: "memory")
__device__ __forceinline__ void st16wt(void* p, v4u v) { asm volatile("global_store_dwordx4 %0, %1, off sc1\n\ts_nop 1" :: "v"(p), "v"(v) : "memory"); }
__device__ __forceinline__ void st8wt(void* p, v2u v) { asm volatile("global_store_dwordx2 %0, %1, off sc1\n\ts_nop 1" :: "v"(p), "v"(v) : "memory"); }
__device__ __forceinline__ unsigned f2bf(float f) { unsigned u = __builtin_bit_cast(unsigned, f); return (u + 0x7fffu + ((u >> 16) & 1u)) >> 16; }
__device__ __forceinline__ unsigned pk2(float lo, float hi) { return f2bf(lo) | (f2bf(hi) << 16); }
__device__ __forceinline__ float bf2f(unsigned short v) { return __builtin_bit_cast(float, (unsigned)v << 16); }
__device__ __forceinline__ float bflo(unsigned w) { return __builtin_bit_cast(float, w << 16); }
__device__ __forceinline__ float bfhi(unsigned w) { return __builtin_bit_cast(float, w & 0xffff0000u); }
__device__ __forceinline__ float fexp(float x) { return __builtin_amdgcn_exp2f(x * 1.4426950408889634f); }
__device__ __forceinline__ float frcp(float x) { return __builtin_amdgcn_rcpf(x); }
__device__ __forceinline__ float frsq(float x) { return __builtin_amdgcn_rsqf(x); }
__device__ __forceinline__ float geluf_(float v) { const float t = frcp(fabsf(v) * 0.2316418882f + 1.0f);
    float q = t * 0.5307027145f - 0.7265760135f; q = q * t + 0.7107068705f; q = q * t - 0.142248368f; q = q * t + 0.127414796f; q = q * t;
    const float m = v * (q * __builtin_amdgcn_exp2f(v * v * -0.72134752044f)); return v < 0.f ? m : v - m; }
__device__ __forceinline__ float sigmoidf_(float x) { const float e = fexp(-fabsf(x)), r = frcp(1.f + e); return x >= 0.f ? r : e * r; }
__device__ __forceinline__ float siluf_(float x) { return x * sigmoidf_(x); }
__device__ __forceinline__ bf16x8 pack8(const float* v) { v4u w; w.x = pk2(v[0], v[1]); w.y = pk2(v[2], v[3]); w.z = pk2(v[4], v[5]); w.w = pk2(v[6], v[7]); return __builtin_bit_cast(bf16x8, w); }
__device__ __forceinline__ void unpack8(v4u w, float* v) { v[0] = bflo(w.x); v[1] = bfhi(w.x); v[2] = bflo(w.y); v[3] = bfhi(w.y); v[4] = bflo(w.z); v[5] = bfhi(w.z); v[6] = bflo(w.w); v[7] = bfhi(w.w); }
__device__ __forceinline__ float shx(float v, int m, int lane) { return __builtin_bit_cast(float, __builtin_amdgcn_ds_bpermute((lane ^ m) << 2, __builtin_bit_cast(int, v))); }
__device__ __forceinline__ float shi(float v, int src) { return __builtin_bit_cast(float, __builtin_amdgcn_ds_bpermute(src << 2, __builtin_bit_cast(int, v))); }
__device__ __forceinline__ float wave_sum(float v, int lane) {
#pragma unroll
    for (int o = 1; o < 64; o <<= 1) v += shx(v, o, lane);
    return v;
}
__device__ __forceinline__ float hsum32(float a, float b) { auto r = __builtin_amdgcn_permlane32_swap(__builtin_bit_cast(unsigned, a), __builtin_bit_cast(unsigned, b), false, false); const unsigned r0 = r[0], r1 = r[1]; return __builtin_bit_cast(float, r0) + __builtin_bit_cast(float, r1); }
__device__ __forceinline__ float hsum16(float a, float b) { auto r = __builtin_amdgcn_permlane16_swap(__builtin_bit_cast(unsigned, a), __builtin_bit_cast(unsigned, b), false, false); const unsigned r0 = r[0], r1 = r[1]; return __builtin_bit_cast(float, r0) + __builtin_bit_cast(float, r1); }
__device__ __forceinline__ float hsum8(float a, float b, bool up) { asm volatile("" : "+v"(a), "+v"(b)); const float send = up ? a : b, keep = up ? b : a; return keep + __builtin_bit_cast(float, __builtin_amdgcn_update_dpp(0, __builtin_bit_cast(int, send), 0x128, 0xf, 0xf, false)); }
__device__ __forceinline__ float hsum4(float a, float b, bool up) { asm volatile("" : "+v"(a), "+v"(b)); const float send = up ? a : b, keep = up ? b : a;
    int t = __builtin_amdgcn_update_dpp(0, __builtin_bit_cast(int, send), 0x141, 0xf, 0xf, false); t = __builtin_amdgcn_update_dpp(0, t, 0x1b, 0xf, 0xf, false); return keep + __builtin_bit_cast(float, t); }
__device__ __forceinline__ float hsum2(float a, float b, bool up) { asm volatile("" : "+v"(a), "+v"(b)); const float send = up ? a : b, keep = up ? b : a; return keep + __builtin_bit_cast(float, __builtin_amdgcn_update_dpp(0, __builtin_bit_cast(int, send), 0x4e, 0xf, 0xf, false)); }
__device__ __forceinline__ float hsum1(float a, float b, bool up) { asm volatile("" : "+v"(a), "+v"(b)); const float send = up ? a : b, keep = up ? b : a; return keep + __builtin_bit_cast(float, __builtin_amdgcn_update_dpp(0, __builtin_bit_cast(int, send), 0xb1, 0xf, 0xf, false)); }
__device__ __forceinline__ float sum8lanes(float a) {
    a += __builtin_bit_cast(float, __builtin_amdgcn_update_dpp(0, __builtin_bit_cast(int, a), 0x141, 0xf, 0xf, false));
    a += __builtin_bit_cast(float, __builtin_amdgcn_update_dpp(0, __builtin_bit_cast(int, a), 0x1b, 0xf, 0xf, false));
    a += __builtin_bit_cast(float, __builtin_amdgcn_update_dpp(0, __builtin_bit_cast(int, a), 0xb1, 0xf, 0xf, false));
    return a; }
#define MFMA16(a, b, c) __builtin_amdgcn_mfma_f32_16x16x32_bf16((a), (b), (c), 0, 0, 0)
#define MFMA32(a, b, c) __builtin_amdgcn_mfma_f32_32x32x16_bf16((a), (b), (c), 0, 0, 0)
namespace pg8 {
#define PG8_LAS __attribute__((address_space(3)))
typedef unsigned short bf16_t;
typedef short bf16x8 __attribute__((ext_vector_type(8)));
typedef float f32x4 __attribute__((ext_vector_type(4)));
typedef unsigned u32x4 __attribute__((ext_vector_type(4)));
constexpr int BM = 256, BK = 64, HALF = 128, HTB = HALF * BK * 2  , STAGE_BYTES = 8 * HTB, NXCD = 8, WGM = 8;

__host__ __device__ __forceinline__ int lds_byte(int r, int c) { const int st = (r >> 4) * 2 + (c >> 5), rr = r & 15, cc = c & 31, ob = rr * 64 + cc * 2; return st * 1024 + (ob ^ (((ob >> 9) & 1) << 5)); }
__host__ __device__ __forceinline__ void stage_rc(int b, int& R, int& C) { const int st = b / 1024, sb = b % 1024, swz = sb ^ (((sb >> 9) & 1) << 5); R = (st >> 1) * 16 + swz / 64; C = (st & 1) * 32 + (swz % 64) / 2; }
__host__ __device__ __forceinline__ int perm32(int rho) { const int n = rho >> 4, i = rho & 15; return 8 * (i >> 2) + 4 * n + (i & 3); }

struct Unit { int pm, pn; };
struct Gemm { const bf16_t* A; const bf16_t* Bt; int M, N, K; };

struct StaticOrder {
    int nM, nN, nwg, G, c;
    __host__ __device__ void init(int M, int N, int G_, int c_) { nM = M / BM; nN = N / BM; nwg = nM * nN; G = G_; c = c_; }
    __host__ __device__ bool next(int i, Unit& u) const {
        const long L = (long)i * G + c; if (L >= nwg) return false;
        int wgid = (int)L; { const int q = nwg / NXCD, r = nwg % NXCD, xcd = wgid % NXCD, off = wgid / NXCD; wgid = (xcd < r ? xcd * (q + 1) : r * (q + 1) + (xcd - r) * q) + off; }
        const int nig = WGM * nN, gid = wgid / nig, fm = gid * WGM, gsz = (nM - fm) < WGM ? (nM - fm) : WGM;
        u.pm = fm + ((wgid % nig) % gsz); u.pn = (wgid % nig) / gsz; return true;
    }
    __device__ __forceinline__ void a_ready(const Unit&) const {}
    __device__ __forceinline__ void done(const Unit&) const {}
};

__device__ __forceinline__ unsigned cvt_pk_bf16(float lo, float hi) { unsigned r; asm volatile("v_cvt_pk_bf16_f32 %0, %1, %2" : "=v"(r) : "v"(lo), "v"(hi)); return r; }
typedef float f32x2 __attribute__((ext_vector_type(2)));
typedef unsigned u32x2 __attribute__((ext_vector_type(2)));
__device__ __forceinline__ void st16_wt(void* p, u32x4 v) {
#if MK_WT_STORES
    asm volatile("global_store_dwordx4 %0, %1, off sc1\n\ts_nop 1" :: "v"(p), "v"(v) : "memory");
#else
    *(u32x4*)p = v;
#endif
}
struct EpiBf16 {
    static constexpr bool PERM = true, AFTER_DRAIN = false;
    bf16_t* O; int ldc;
    __device__ __forceinline__ void operator()(const f32x4 (&acc)[2][2][4][2], const Unit& u, int wr, int wc, int fr, int fq) const {
        const int row0 = u.pm * BM + wr * 64 + fr; const int col0 = u.pn * BM + wc * 32 + 8 * fq;
#pragma unroll
        for (int ai = 0; ai < 2; ++ai)
#pragma unroll
            for (int m = 0; m < 4; ++m) { bf16_t* rowp = O + (size_t)(row0 + ai * HALF + m * 16) * ldc + col0;
#pragma unroll
                for (int bj = 0; bj < 2; ++bj) { const f32x4 v0 = acc[ai][bj][m][0], v1 = acc[ai][bj][m][1];
                    u32x4 w; w.x = cvt_pk_bf16(v0[0], v0[1]); w.y = cvt_pk_bf16(v0[2], v0[3]); w.z = cvt_pk_bf16(v1[0], v1[1]); w.w = cvt_pk_bf16(v1[2], v1[3]);
                    st16_wt(rowp + bj * HALF, w); } }
    }
};
struct EpiProj {
    static constexpr bool PERM = true, AFTER_DRAIN = false;
    bf16_t* O; int ldc; float* dt; const PG8_LAS float* rsl; int xg; const float* ssq8; bool scale;
    __device__ __forceinline__ void operator()(const f32x4 (&acc)[2][2][4][2], const Unit& u, int wr, int wc, int fr, int fq) const {
        const int rl0 = wr * 64 + fr, row0 = u.pm * BM + rl0; const int col0 = u.pn * BM + wc * 32 + 8 * fq;
        float sc[2][4];
        if ((u.pm >> 3) == xg) {
#pragma unroll
            for (int ai = 0; ai < 2; ++ai)
#pragma unroll
                for (int m = 0; m < 4; ++m) sc[ai][m] = rsl[(u.pm & 7) * BM + rl0 + ai * HALF + m * 16];
        } else {
#pragma unroll
            for (int ai = 0; ai < 2; ++ai)
#pragma unroll
                for (int m = 0; m < 4; ++m) { sc[ai][m] = 1.f; if (scale) { const float* pp = ssq8 + (size_t)(row0 + ai * HALF + m * 16) * 8; const f32x4 a = *(const f32x4*)pp, b = *(const f32x4*)(pp + 4);
                    sc[ai][m] = __builtin_amdgcn_rsqf((((a[0] + a[1]) + (a[2] + a[3])) + ((b[0] + b[1]) + (b[2] + b[3]))) * (1.f / 1024.f) + 1e-6f); } }
        }
        if (u.pn == 31) {
            if (wc == 0 && fq == 0) {
#pragma unroll
                for (int ai = 0; ai < 2; ++ai)
#pragma unroll
                    for (int m = 0; m < 4; ++m) { float* dp = dt + (size_t)(row0 + ai * HALF + m * 16) * 8; *(f32x4*)dp = acc[ai][0][m][0] * sc[ai][m]; *(f32x4*)(dp + 4) = acc[ai][0][m][1] * sc[ai][m]; }
            }
            return;
        }
#pragma unroll
        for (int ai = 0; ai < 2; ++ai)
#pragma unroll
            for (int m = 0; m < 4; ++m) { bf16_t* rowp = O + (size_t)(row0 + ai * HALF + m * 16) * ldc + col0;
#pragma unroll
                for (int bj = 0; bj < 2; ++bj) { const f32x4 v0 = acc[ai][bj][m][0] * sc[ai][m], v1 = acc[ai][bj][m][1] * sc[ai][m];
                    u32x4 w; w.x = cvt_pk_bf16(v0[0], v0[1]); w.y = cvt_pk_bf16(v0[2], v0[3]); w.z = cvt_pk_bf16(v1[0], v1[1]); w.w = cvt_pk_bf16(v1[2], v1[3]);
                    st16_wt(rowp + bj * HALF, w); } }
    }
};
struct EpiF32 {
    static constexpr bool PERM = false, AFTER_DRAIN = false;
    float* C; int ldc;
    __device__ __forceinline__ void operator()(const f32x4 (&acc)[2][2][4][2], const Unit& u, int wr, int wc, int fr, int fq) const {
        const int row0 = u.pm * BM + wr * 64 + fr, col0 = u.pn * BM + wc * 32 + 4 * fq;
#pragma unroll
        for (int ai = 0; ai < 2; ++ai)
#pragma unroll
            for (int m = 0; m < 4; ++m) { float* rowp = C + (size_t)(row0 + ai * HALF + m * 16) * ldc + col0;
#pragma unroll
                for (int bj = 0; bj < 2; ++bj)
#pragma unroll
                    for (int n = 0; n < 2; ++n) st16_wt(rowp + bj * HALF + n * 16, __builtin_bit_cast(u32x4, acc[ai][bj][m][n])); }
    }
};
struct EpiF16 {
    static constexpr bool PERM = true, AFTER_DRAIN = false;
    _Float16* C; int ldc;
    __device__ __forceinline__ void operator()(const f32x4 (&acc)[2][2][4][2], const Unit& u, int wr, int wc, int fr, int fq) const {
        typedef _Float16 h2 __attribute__((ext_vector_type(2)));
        const int row0 = u.pm * BM + wr * 64 + fr; const int col0 = u.pn * BM + wc * 32 + 8 * fq;
#pragma unroll
        for (int ai = 0; ai < 2; ++ai)
#pragma unroll
            for (int m = 0; m < 4; ++m) { _Float16* rowp = C + (size_t)(row0 + ai * HALF + m * 16) * ldc + col0;
#pragma unroll
                for (int bj = 0; bj < 2; ++bj) { const f32x4 v0 = acc[ai][bj][m][0], v1 = acc[ai][bj][m][1];
                    const h2 a = {(_Float16)v0[0], (_Float16)v0[1]}, b = {(_Float16)v0[2], (_Float16)v0[3]}, c = {(_Float16)v1[0], (_Float16)v1[1]}, d = {(_Float16)v1[2], (_Float16)v1[3]};
                    u32x4 w; w.x = __builtin_bit_cast(unsigned, a); w.y = __builtin_bit_cast(unsigned, b); w.z = __builtin_bit_cast(unsigned, c); w.w = __builtin_bit_cast(unsigned, d);
                    st16_wt(rowp + bj * HALF, w); } }
    }
};
template <bool DRY> struct EpiResF32 {
    static constexpr bool PERM = false, AFTER_DRAIN = false;
    float* C; int ldc;
    __device__ __forceinline__ void operator()(const f32x4 (&acc)[2][2][4][2], const Unit& u, int wr, int wc, int fr, int fq) const {
        const int row0 = u.pm * BM + wr * 64 + fr, col0 = u.pn * BM + wc * 32 + 4 * fq;
#pragma unroll
        for (int ai = 0; ai < 2; ++ai)
#pragma unroll
            for (int m = 0; m < 4; ++m) { float* rowp = C + (size_t)(row0 + ai * HALF + m * 16) * ldc + col0;
                f32x4 old[2][2];
#pragma unroll
                for (int bj = 0; bj < 2; ++bj)
#pragma unroll
                    for (int n = 0; n < 2; ++n) old[bj][n] = *(const f32x4*)(rowp + bj * HALF + n * 16);
#pragma unroll
                for (int bj = 0; bj < 2; ++bj)
#pragma unroll
                    for (int n = 0; n < 2; ++n) { const f32x4 r = old[bj][n] + acc[ai][bj][m][n]; if constexpr (!DRY) *(f32x4*)(rowp + bj * HALF + n * 16) = r; else asm volatile("" :: "v"(r)); } }
    }
};
template <bool CIN_F32> struct EpiResNorm {
    static constexpr bool PERM = true, AFTER_DRAIN = false;
    const void* Cin; bf16_t* C; int ldc; const float* w; bf16_t* XW; float* ssq;
    __device__ __forceinline__ void operator()(const f32x4 (&acc)[2][2][4][2], const Unit& u, int wr, int wc, int fr, int fq) const {
        const int row0 = u.pm * BM + wr * 64 + fr, col0 = u.pn * BM + wc * 32 + 8 * fq;
        f32x4 wv[2][2];
#pragma unroll
        for (int bj = 0; bj < 2; ++bj)
#pragma unroll
            for (int n = 0; n < 2; ++n) wv[bj][n] = *(const f32x4*)(w + col0 + bj * HALF + 4 * n);
        f32x4 xf[3][2][2]; u32x4 xh[3][2];
#define ERN_LD(i, s) do { const size_t ro_ = (size_t)(row0 + ((i) >> 2) * HALF + ((i) & 3) * 16) * ldc + col0; \
            if constexpr (CIN_F32) { _Pragma("unroll") for (int bj = 0; bj < 2; ++bj) _Pragma("unroll") for (int n = 0; n < 2; ++n) xf[s][bj][n] = *(const f32x4*)((const float*)Cin + ro_ + bj * HALF + 4 * n); } \
            else { _Pragma("unroll") for (int bj = 0; bj < 2; ++bj) xh[s][bj] = *(const u32x4*)((const bf16_t*)Cin + ro_ + bj * HALF); } } while (0)
#define ERN_COMP(i, s) do { constexpr int ai = (i) >> 2, m = (i) & 3; const size_t row = (size_t)(row0 + ai * HALF + m * 16); float ss = 0.f; \
            _Pragma("unroll") for (int bj = 0; bj < 2; ++bj) { f32x4 xx[2]; \
                if constexpr (CIN_F32) { xx[0] = xf[s][bj][0]; xx[1] = xf[s][bj][1]; } \
                else { const u32x4 q_ = xh[s][bj]; xx[0] = (f32x4){__builtin_bit_cast(float, q_.x << 16), __builtin_bit_cast(float, q_.x & 0xffff0000u), __builtin_bit_cast(float, q_.y << 16), __builtin_bit_cast(float, q_.y & 0xffff0000u)}; \
                       xx[1] = (f32x4){__builtin_bit_cast(float, q_.z << 16), __builtin_bit_cast(float, q_.z & 0xffff0000u), __builtin_bit_cast(float, q_.w << 16), __builtin_bit_cast(float, q_.w & 0xffff0000u)}; } \
                _Pragma("unroll") for (int n = 0; n < 2; ++n) { xx[n] = xx[n] + acc[ai][bj][m][n]; \
                    ss += (xx[n][0] * xx[n][0] + xx[n][1] * xx[n][1]) + (xx[n][2] * xx[n][2] + xx[n][3] * xx[n][3]); } \
                u32x4 xo; xo.x = cvt_pk_bf16(xx[0][0], xx[0][1]); xo.y = cvt_pk_bf16(xx[0][2], xx[0][3]); xo.z = cvt_pk_bf16(xx[1][0], xx[1][1]); xo.w = cvt_pk_bf16(xx[1][2], xx[1][3]); \
                *(u32x4*)(C + row * ldc + col0 + bj * HALF) = xo; \
                const f32x4 y0 = xx[0] * wv[bj][0], y1 = xx[1] * wv[bj][1]; \
                u32x4 o; o.x = cvt_pk_bf16(y0[0], y0[1]); o.y = cvt_pk_bf16(y0[2], y0[3]); o.z = cvt_pk_bf16(y1[0], y1[1]); o.w = cvt_pk_bf16(y1[2], y1[3]); \
                *(u32x4*)(XW + row * ldc + col0 + bj * HALF) = o; } \
              \
            { auto r1 = __builtin_amdgcn_permlane16_swap(__builtin_bit_cast(unsigned, ss), __builtin_bit_cast(unsigned, ss), false, false); const unsigned a1 = r1[0], b1 = r1[1]; ss = __builtin_bit_cast(float, a1) + __builtin_bit_cast(float, b1); \
              auto r2 = __builtin_amdgcn_permlane32_swap(__builtin_bit_cast(unsigned, ss), __builtin_bit_cast(unsigned, ss), false, false); const unsigned a2 = r2[0], b2 = r2[1]; ss = __builtin_bit_cast(float, a2) + __builtin_bit_cast(float, b2); } \
            if (fq == 0) ssq[row * 16 + 4 * u.pn + wc] = ss; } while (0)
        ERN_LD(0, 0); ERN_LD(1, 1); ERN_LD(2, 2);
        ERN_COMP(0, 0); ERN_LD(3, 0); ERN_COMP(1, 1); ERN_LD(4, 1); ERN_COMP(2, 2); ERN_LD(5, 2); ERN_COMP(3, 0); ERN_LD(6, 0); ERN_COMP(4, 1); ERN_LD(7, 1); ERN_COMP(5, 2); ERN_COMP(6, 0); ERN_COMP(7, 1);
#undef ERN_LD
#undef ERN_COMP
    }
};
struct EpiMerge {
    static constexpr bool PERM = true, AFTER_DRAIN = false;
    const bf16_t* gate; int ldg;
    bf16_t* O; int ldc;
    __device__ __forceinline__ void operator()(const f32x4 (&acc)[2][2][4][2], const Unit& u, int wr, int wc, int fr, int fq) const {
        const int br = u.pm >> 6, pm = u.pm & 63, pn = u.pn & 3;
        const int row0 = pm * BM + wr * 64 + fr, col0 = pn * BM + wc * 32 + 8 * fq;
        const bf16_t* gbase = gate + (size_t)row0 * ldg + br * 1024 + col0; bf16_t* obase = O + (size_t)row0 * ldc + col0;
        u32x4 gq[2][4], oq[2][4];
#define EMG_LD(b, s) do { _Pragma("unroll") for (int mm = 0; mm < 2; ++mm) _Pragma("unroll") for (int bj = 0; bj < 2; ++bj) { const size_t r = (size_t)(((b) >> 1) * HALF + (2 * ((b) & 1) + mm) * 16); \
            gq[s][mm * 2 + bj] = *(const u32x4*)(gbase + r * ldg + bj * HALF); oq[s][mm * 2 + bj] = *(const u32x4*)(obase + r * ldc + bj * HALF); } } while (0)
#define EMG_COMP(b, s) do { _Pragma("unroll") for (int mm = 0; mm < 2; ++mm) _Pragma("unroll") for (int bj = 0; bj < 2; ++bj) { constexpr int ai = (b) >> 1; const int m = 2 * ((b) & 1) + mm; const size_t r = (size_t)(ai * HALF + m * 16); \
            const u32x4 gw = gq[s][mm * 2 + bj]; \
            float v[8] = {acc[ai][bj][m][0][0], acc[ai][bj][m][0][1], acc[ai][bj][m][0][2], acc[ai][bj][m][0][3], acc[ai][bj][m][1][0], acc[ai][bj][m][1][1], acc[ai][bj][m][1][2], acc[ai][bj][m][1][3]}; \
            float g[8]; { g[0] = __builtin_bit_cast(float, gw.x << 16); g[1] = __builtin_bit_cast(float, gw.x & 0xffff0000u); g[2] = __builtin_bit_cast(float, gw.y << 16); g[3] = __builtin_bit_cast(float, gw.y & 0xffff0000u); \
                          g[4] = __builtin_bit_cast(float, gw.z << 16); g[5] = __builtin_bit_cast(float, gw.z & 0xffff0000u); g[6] = __builtin_bit_cast(float, gw.w << 16); g[7] = __builtin_bit_cast(float, gw.w & 0xffff0000u); } \
            _Pragma("unroll") for (int j = 0; j < 8; ++j) {   v[j] *= __builtin_amdgcn_rcpf(1.f + __builtin_amdgcn_exp2f(g[j] * -1.4426950408889634f)); } \
            if (br != 0) { const u32x4 ow = oq[s][mm * 2 + bj]; \
                v[0] += __builtin_bit_cast(float, ow.x << 16); v[1] += __builtin_bit_cast(float, ow.x & 0xffff0000u); v[2] += __builtin_bit_cast(float, ow.y << 16); v[3] += __builtin_bit_cast(float, ow.y & 0xffff0000u); \
                v[4] += __builtin_bit_cast(float, ow.z << 16); v[5] += __builtin_bit_cast(float, ow.z & 0xffff0000u); v[6] += __builtin_bit_cast(float, ow.w << 16); v[7] += __builtin_bit_cast(float, ow.w & 0xffff0000u); } \
            u32x4 wq; wq.x = cvt_pk_bf16(v[0], v[1]); wq.y = cvt_pk_bf16(v[2], v[3]); wq.z = cvt_pk_bf16(v[4], v[5]); wq.w = cvt_pk_bf16(v[6], v[7]); \
            *(u32x4*)(obase + r * ldc + bj * HALF) = wq; } } while (0)
        EMG_LD(0, 0); EMG_LD(1, 1); EMG_COMP(0, 0); EMG_LD(2, 0); EMG_COMP(1, 1); EMG_LD(3, 1); EMG_COMP(2, 0); EMG_COMP(3, 1);
#undef EMG_LD
#undef EMG_COMP
    }
};
struct EpiMerge2 {
    static constexpr bool PERM = true, AFTER_DRAIN = false;
    const bf16_t* gate; int ldg;
    bf16_t* O; int ldc;
    __device__ __forceinline__ void operator()(f32x4 (&acc)[2][2][4][2], const Unit& u, int wr, int wc, int fr, int fq) const {
        const int br = u.pm >> 6, pm = u.pm & 63, pn = u.pn & 3;
        const int row0 = pm * BM + wr * 64 + fr, col0 = pn * BM + wc * 32 + 8 * fq;
        const bf16_t* gbase = gate + (size_t)row0 * ldg + br * 1024 + col0; bf16_t* obase = O + (size_t)row0 * ldc + col0;
        const int nxo = br < 2 ? 1024 : 0;
        u32x4 gq[2][4], hq[2][4];
#define EM2_LD(b, s) do { _Pragma("unroll") for (int mm = 0; mm < 2; ++mm) _Pragma("unroll") for (int bj = 0; bj < 2; ++bj) { const size_t r = (size_t)(((b) >> 1) * HALF + (2 * ((b) & 1) + mm) * 16); \
            gq[s][mm * 2 + bj] = *(const u32x4*)(gbase + r * ldg + bj * HALF); hq[s][mm * 2 + bj] = *(const u32x4*)(gbase + r * ldg + bj * HALF + nxo); } } while (0)
#define EM2_E(x) __builtin_amdgcn_exp2f(__builtin_amdgcn_fmed3f((x), -30.f, 30.f) * -1.4426950408889634f)
#define EM2_COMP(b, s) do { _Pragma("unroll") for (int mm = 0; mm < 2; ++mm) _Pragma("unroll") for (int bj = 0; bj < 2; ++bj) { constexpr int ai = (b) >> 1; const int m = 2 * ((b) & 1) + mm; const size_t r = (size_t)(ai * HALF + m * 16); \
            const u32x4 gw = gq[s][mm * 2 + bj], hw = hq[s][mm * 2 + bj]; \
            const float g[8] = {__builtin_bit_cast(float, gw.x << 16), __builtin_bit_cast(float, gw.x & 0xffff0000u), __builtin_bit_cast(float, gw.y << 16), __builtin_bit_cast(float, gw.y & 0xffff0000u), \
                                __builtin_bit_cast(float, gw.z << 16), __builtin_bit_cast(float, gw.z & 0xffff0000u), __builtin_bit_cast(float, gw.w << 16), __builtin_bit_cast(float, gw.w & 0xffff0000u)}; \
            const float hh[8] = {__builtin_bit_cast(float, hw.x << 16), __builtin_bit_cast(float, hw.x & 0xffff0000u), __builtin_bit_cast(float, hw.y << 16), __builtin_bit_cast(float, hw.y & 0xffff0000u), \
                                 __builtin_bit_cast(float, hw.z << 16), __builtin_bit_cast(float, hw.z & 0xffff0000u), __builtin_bit_cast(float, hw.w << 16), __builtin_bit_cast(float, hw.w & 0xffff0000u)}; \
            float f[8]; \
            if (br < 2) { _Pragma("unroll") for (int j = 0; j < 8; ++j) f[j] = (1.f + EM2_E(hh[j])) * __builtin_amdgcn_rcpf(1.f + EM2_E(g[j])); } \
            else        { _Pragma("unroll") for (int j = 0; j < 8; ++j) f[j] = __builtin_amdgcn_rcpf(1.f + EM2_E(g[j])); } \
            _Pragma("unroll") for (int j = 0; j < 8; ++j) acc[ai][bj][m][j >> 2][j & 3] *= f[j]; \
            if (br == 2) { u32x4 wq; wq.x = cvt_pk_bf16(acc[ai][bj][m][0][0], acc[ai][bj][m][0][1]); wq.y = cvt_pk_bf16(acc[ai][bj][m][0][2], acc[ai][bj][m][0][3]); \
                wq.z = cvt_pk_bf16(acc[ai][bj][m][1][0], acc[ai][bj][m][1][1]); wq.w = cvt_pk_bf16(acc[ai][bj][m][1][2], acc[ai][bj][m][1][3]); \
                *(u32x4*)(obase + r * ldc + bj * HALF) = wq; } } } while (0)
        EM2_LD(0, 0); EM2_LD(1, 1); EM2_COMP(0, 0); EM2_LD(2, 0); EM2_COMP(1, 1); EM2_LD(3, 1); EM2_COMP(2, 0); EM2_COMP(3, 1);
#undef EM2_LD
#undef EM2_E
#undef EM2_COMP
    }
};
template <class Epi> __device__ __forceinline__ bool epi_keep(const Epi&, const Unit&) { return false; }
__device__ __forceinline__ bool epi_keep(const EpiMerge2&, const Unit& u) { return (u.pm >> 6) < 2; }
struct MergeOrder {
    int v, G;
    __device__ __forceinline__ bool next(int i, Unit& u) const { const int bi = i / 3, br = i - bi * 3; const long L = (long)bi * G + v; if (L >= 256) return false;
        u.pm = br * 64 + (int)(L >> 2); u.pn = br * 4 + (int)(L & 3); return true; }
    __device__ __forceinline__ void a_ready(const Unit&) const {}
    __device__ __forceinline__ void done(const Unit&) const {}
};
template <class Epi, class Sched, bool ALIGN_EPI = false, bool SP2 = false>
__device__ __forceinline__ void gemm_phase(PG8_LAS unsigned char* lds, const Gemm g, const Sched& S, const Epi& E, int tid_) {
    const int tid = tid_, wid = __builtin_amdgcn_readfirstlane(tid >> 6), lane = tid & 63, wr = wid >> 2, wc = wid & 3, fr = lane & 15, fq = lane >> 4;
    const int K = g.K, nt = K / BK;
    unsigned voffA[2], voffB[2];
#pragma unroll
    for (int i = 0; i < 2; ++i) { int R, C; stage_rc(tid * 16 + i * 8192, R, C); const int Rb = Epi::PERM ? ((R & ~31) + perm32(R & 31)) : R;
        voffA[i] = (unsigned)(R * K + C) * 2u; voffB[i] = (unsigned)(Rb * K + C) * 2u; }
    const size_t kstep = (size_t)(BK * 2);
    const size_t hstep = (size_t)HALF * K * 2;
    const size_t tstep = 2 * hstep;
    const unsigned ldsw = (unsigned)wid * 1024u;
    const int aoff = lds_byte(wr * 64 + fr, fq * 8), boff = lds_byte(wc * 32 + fr, fq * 8);
#define PG8_SA(b, h) (((b) * 2 + (h)) * HTB)
#define PG8_SB(b, h) ((4 + (b) * 2 + (h)) * HTB)
#define PG8_STAGE(bufoff, gbase, voff) do { _Pragma("unroll") for (int _i = 0; _i < 2; ++_i) \
        __builtin_amdgcn_global_load_lds((const unsigned*)((const char*)(gbase) + (voff)[_i]), (PG8_LAS unsigned*)(lds + (bufoff) + ldsw + _i * 8192), 16, 0, 0); } while (0)
#define PG8_LDA(dst, b, h) do { _Pragma("unroll") for (int m = 0; m < 4; ++m) _Pragma("unroll") for (int k = 0; k < 2; ++k) dst[m][k] = *(const PG8_LAS bf16x8*)(lds + PG8_SA(b, h) + aoff + m * 2048 + k * 1024); } while (0)
#define PG8_LDB(dst, b, h) do { _Pragma("unroll") for (int n = 0; n < 2; ++n) _Pragma("unroll") for (int k = 0; k < 2; ++k) dst[n][k] = *(const PG8_LAS bf16x8*)(lds + PG8_SB(b, h) + boff + n * 2048 + k * 1024); } while (0)
#define PG8_MMA(ai, bj, At, Bt) do { __builtin_amdgcn_s_setprio(1); _Pragma("unroll") for (int m = 0; m < 4; ++m) _Pragma("unroll") for (int n = 0; n < 2; ++n) _Pragma("unroll") for (int k = 0; k < 2; ++k) \
        acc[ai][bj][m][n] = __builtin_amdgcn_mfma_f32_16x16x32_bf16(Bt[n][k], At[m][k], acc[ai][bj][m][n], 0, 0, 0); __builtin_amdgcn_s_setprio(0); } while (0)
#define PG8_WAIT_V(n) asm volatile("s_waitcnt vmcnt(" #n ")" ::: "memory")
#define PG8_WAIT_L(n) asm volatile("s_waitcnt lgkmcnt(" #n ")" ::: "memory")
#define PG8_BAR __builtin_amdgcn_s_barrier()
#define PG8_SCHED __builtin_amdgcn_sched_barrier(0)
    Unit cur, nxt; int ui = 0;
    if (!S.next(0, cur)) return;
    f32x4 acc[2][2][4][2];
#pragma unroll
    for (int a = 0; a < 2; ++a)
#pragma unroll
        for (int b = 0; b < 2; ++b)
#pragma unroll
            for (int m = 0; m < 4; ++m)
#pragma unroll
                for (int n = 0; n < 2; ++n) acc[a][b][m][n] = (f32x4){0.f, 0.f, 0.f, 0.f};
    bf16x8 At[4][2], B0[2][2], B1[2][2];
    const char* cA = (const char*)g.A + (size_t)cur.pm * tstep; const char* cB = (const char*)g.Bt + (size_t)cur.pn * tstep;
    S.a_ready(cur);
    if constexpr (SP2) {
        PG8_STAGE(PG8_SB(0, 0), cB, voffB); PG8_STAGE(PG8_SB(0, 1), cB + hstep, voffB); PG8_STAGE(PG8_SA(0, 0), cA, voffA); PG8_STAGE(PG8_SA(0, 1), cA + hstep, voffA);
        if (wr == 1) PG8_BAR;
        PG8_WAIT_V(2); PG8_BAR;
        PG8_STAGE(PG8_SB(1, 0), cB + kstep, voffB); PG8_STAGE(PG8_SA(1, 0), cA + kstep, voffA); PG8_STAGE(PG8_SB(1, 1), cB + hstep + kstep, voffB);
        PG8_WAIT_V(6); PG8_BAR;
    } else {
        PG8_STAGE(PG8_SB(0, 0), cB, voffB); PG8_STAGE(PG8_SA(0, 0), cA, voffA); PG8_STAGE(PG8_SB(0, 1), cB + hstep, voffB); PG8_STAGE(PG8_SA(0, 1), cA + hstep, voffA);
        if (wr == 1) PG8_BAR;
        PG8_WAIT_V(4); PG8_BAR;
        PG8_STAGE(PG8_SB(1, 0), cB + kstep, voffB); PG8_STAGE(PG8_SA(1, 0), cA + kstep, voffA); PG8_STAGE(PG8_SB(1, 1), cB + hstep + kstep, voffB);
        PG8_WAIT_V(6); PG8_BAR;
    }
    for (;;) {
        const bool has_next = S.next(ui + 1, nxt);
        const char* nA = has_next ? (const char*)g.A + (size_t)nxt.pm * tstep : cA; const char* nB = has_next ? (const char*)g.Bt + (size_t)nxt.pn * tstep : cB;
        for (int t = 0; t < nt; t += 2) {
            const bool last = (t == nt - 2);
            const char* a1 = cA + (size_t)(t + 1) * kstep;
            const char* a2 = last ? nA : cA + (size_t)(t + 2) * kstep; const char* b2 = last ? nB : cB + (size_t)(t + 2) * kstep;
            const char* a3 = a2 + kstep; const char* b3 = b2 + kstep;
            if (last && has_next) S.a_ready(nxt);
            if constexpr (SP2) {
            PG8_LDB(B0, 0, 0); PG8_LDB(B1, 0, 1); PG8_SCHED; PG8_LDA(At, 0, 0); PG8_STAGE(PG8_SA(1, 1), a1 + hstep, voffA);
            PG8_WAIT_V(8); PG8_WAIT_L(0); PG8_BAR; PG8_MMA(0, 0, At, B0); PG8_MMA(0, 1, At, B1); PG8_BAR; PG8_SCHED;
            PG8_LDA(At, 0, 1); PG8_STAGE(PG8_SB(0, 0), b2, voffB); PG8_STAGE(PG8_SB(0, 1), b2 + hstep, voffB); PG8_STAGE(PG8_SA(0, 0), a2, voffA);
            PG8_WAIT_V(8); PG8_WAIT_L(0); PG8_BAR; PG8_MMA(1, 0, At, B0); PG8_MMA(1, 1, At, B1); PG8_BAR; PG8_SCHED;
            PG8_LDB(B0, 1, 0); PG8_LDB(B1, 1, 1); PG8_SCHED; PG8_LDA(At, 1, 0); PG8_STAGE(PG8_SA(0, 1), a2 + hstep, voffA);
            PG8_WAIT_V(8); PG8_WAIT_L(0); PG8_BAR; PG8_MMA(0, 0, At, B0); PG8_MMA(0, 1, At, B1); PG8_BAR; PG8_SCHED;
            PG8_LDA(At, 1, 1); PG8_STAGE(PG8_SB(1, 0), b3, voffB); PG8_STAGE(PG8_SB(1, 1), b3 + hstep, voffB); PG8_STAGE(PG8_SA(1, 0), a3, voffA);
            PG8_WAIT_V(8); PG8_WAIT_L(0); PG8_BAR; PG8_MMA(1, 0, At, B0); PG8_MMA(1, 1, At, B1); PG8_BAR; PG8_SCHED;
            } else {
            PG8_LDB(B0, 0, 0); PG8_SCHED; PG8_LDA(At, 0, 0); PG8_STAGE(PG8_SA(1, 1), a1 + hstep, voffA);
            PG8_WAIT_L(8); PG8_BAR; PG8_WAIT_L(0); PG8_MMA(0, 0, At, B0); PG8_BAR; PG8_SCHED;
            PG8_LDB(B1, 0, 1); PG8_STAGE(PG8_SB(0, 0), b2, voffB);
            PG8_BAR; PG8_WAIT_L(0); PG8_MMA(0, 1, At, B1); PG8_BAR;
            PG8_LDA(At, 0, 1); PG8_STAGE(PG8_SA(0, 0), a2, voffA);
            PG8_BAR; PG8_WAIT_L(0); PG8_MMA(1, 0, At, B0); PG8_BAR; PG8_SCHED;
            PG8_STAGE(PG8_SB(0, 1), b2 + hstep, voffB);
            PG8_WAIT_V(6); PG8_BAR; PG8_MMA(1, 1, At, B1); PG8_BAR;
            PG8_LDB(B0, 1, 0); PG8_SCHED; PG8_LDA(At, 1, 0); PG8_STAGE(PG8_SA(0, 1), a2 + hstep, voffA);
            PG8_WAIT_L(8); PG8_BAR; PG8_WAIT_L(0); PG8_MMA(0, 0, At, B0); PG8_BAR; PG8_SCHED;
            PG8_LDB(B1, 1, 1); PG8_STAGE(PG8_SB(1, 0), b3, voffB);
            PG8_BAR; PG8_WAIT_L(0); PG8_MMA(0, 1, At, B1); PG8_BAR;
            PG8_LDA(At, 1, 1); PG8_STAGE(PG8_SA(1, 0), a3, voffA);
            PG8_BAR; PG8_WAIT_L(0); PG8_MMA(1, 0, At, B0); PG8_BAR; PG8_SCHED;
            PG8_STAGE(PG8_SB(1, 1), b3 + hstep, voffB);
            PG8_WAIT_V(6); PG8_BAR; PG8_MMA(1, 1, At, B1); PG8_BAR;
            }
        }
        if constexpr (ALIGN_EPI) { if (wr == 0) PG8_BAR; }
        if constexpr (!Epi::AFTER_DRAIN) { E(acc, cur, wr, wc, fr, fq); S.done(cur); }
        if (!has_next) break;
        if (!epi_keep(E, cur)) {
#pragma unroll
        for (int a = 0; a < 2; ++a)
#pragma unroll
            for (int b = 0; b < 2; ++b)
#pragma unroll
                for (int m = 0; m < 4; ++m)
#pragma unroll
                    for (int n = 0; n < 2; ++n) acc[a][b][m][n] = (f32x4){0.f, 0.f, 0.f, 0.f}; }
        cur = nxt; cA = nA; cB = nB; ++ui;
        if constexpr (ALIGN_EPI) { if (wr == 1) PG8_BAR; }
    }
    PG8_WAIT_V(0);
    if constexpr (!ALIGN_EPI) { if (wr == 0) PG8_BAR; }
    PG8_BAR;
    if constexpr (Epi::AFTER_DRAIN) { E.fused(acc, cur, wr, wc, fr, fq, lds, wid, lane); S.done(cur); }
#undef PG8_SA
#undef PG8_SB
#undef PG8_STAGE
#undef PG8_LDA
#undef PG8_LDB
#undef PG8_MMA
#undef PG8_WAIT_V
#undef PG8_WAIT_L
#undef PG8_BAR
#undef PG8_SCHED
}
}
constexpr int CW_BAR = 4096;
__device__ __forceinline__ unsigned long long rt() { return __builtin_amdgcn_s_memrealtime(); }
#define XB_TMO      128
#define XB_XCNT(j)  (256  + 64 * (j))
#define XB_XSUB(j)  (1280 + 64 * (j))
#define XB_XGEN(j)  (2304 + 64 * (j))
#define XB_TOP      3328
#define XB_TOPGEN   3392
#define XCD_BAR_WORDS 3456
#define XB_SPIN_CAP (1u << 18)

__device__ __forceinline__ unsigned xb_ld(unsigned* p)              { return __hip_atomic_load(p, __ATOMIC_RELAXED, __HIP_MEMORY_SCOPE_AGENT); }
__device__ __forceinline__ unsigned xb_add(unsigned* p, unsigned v) { return __hip_atomic_fetch_add(p, v, __ATOMIC_RELAXED, __HIP_MEMORY_SCOPE_AGENT); }
__device__ __forceinline__ unsigned xb_xcc_id() { return (unsigned)__builtin_amdgcn_s_getreg((3 << 11) | 20) & 0xFu; }
#define XB_SPIN(cond, bar) do { unsigned _sp = 0; while (cond) { __builtin_amdgcn_s_sleep(1); \
    if ((++_sp & 255u) == 0u) { if (xb_ld(&(bar)[XB_TMO])) break; if (_sp > XB_SPIN_CAP) { atomicAdd(&(bar)[XB_TMO], 1u); break; } } } } while (0)

struct XcdBarrier {
    unsigned* bar; unsigned x;
    volatile LAS unsigned* st;
};

__device__ __forceinline__ XcdBarrier xcd_barrier_post(unsigned* bar, volatile LAS unsigned* st, int tid) {
    XcdBarrier b; b.bar = bar; b.x = xb_xcc_id(); b.st = st;
    if (tid == 0) (void)xb_add(&bar[XB_XCNT(b.x)], 1u);
    return b;
}
__device__ __forceinline__ void xcd_barrier_complete(unsigned* bar, unsigned x, unsigned& nloc, unsigned& nx) {
    const unsigned G = gridDim.x * gridDim.y * gridDim.z;
    unsigned sum, cnt, mine, sp = 0u;
    for (;;) {
        sum = 0u; cnt = 0u; mine = 0u;
#pragma unroll
        for (unsigned j = 0; j < 16; ++j) { const unsigned c = xb_ld(&bar[XB_XCNT(j)]); sum += c; cnt += (c > 0u) ? 1u : 0u; mine = (j == x) ? c : mine; }
        if (sum == G) break;
        __builtin_amdgcn_s_sleep(1);
        if ((++sp & 255u) == 0u) { if (xb_ld(&bar[XB_TMO])) break; if (sp > XB_SPIN_CAP) { atomicAdd(&bar[XB_TMO], 1u); break; } }
    }
    nloc = mine > 0u ? mine : 1u; nx = cnt > 0u ? cnt : 1u;
}

__device__ __forceinline__ void xcd_barrier(const XcdBarrier& b, int tid) {
    asm volatile("s_waitcnt vmcnt(0)" ::: "memory");
    __syncthreads();
    if (tid == 0) {
        unsigned* bar = b.bar;
        __builtin_amdgcn_s_waitcnt(0);
        unsigned nloc = b.st[0], nx = b.st[1];
        if (nloc == 0u) { xcd_barrier_complete(bar, b.x, nloc, nx); b.st[0] = nloc; b.st[1] = nx; }
        const unsigned old = xb_add(&bar[XB_XSUB(b.x)], 1u);
        const unsigned gen = old / nloc;
        if (old + 1u == (gen + 1u) * nloc) {
            __builtin_amdgcn_fence(__ATOMIC_RELEASE, "agent");
            asm volatile("s_waitcnt vmcnt(0)" ::: "memory");
            const unsigned og = xb_add(&bar[XB_TOP], 1u);
            const unsigned tg = og / nx;
            if (og + 1u == (tg + 1u) * nx) xb_add(&bar[XB_TOPGEN], 1u);
            else XB_SPIN(xb_ld(&bar[XB_TOPGEN]) == tg, bar);
            __builtin_amdgcn_fence(__ATOMIC_ACQUIRE, "agent");
            xb_add(&bar[XB_XGEN(b.x)], 1u);
            asm volatile("s_waitcnt vmcnt(0)" ::: "memory");
        } else {
            XB_SPIN(xb_ld(&bar[XB_XGEN(b.x)]) == gen, bar);
            __builtin_amdgcn_fence(__ATOMIC_ACQUIRE, "agent");
            asm volatile("s_waitcnt vmcnt(0)" ::: "memory");
        }
    }
    __syncthreads();
}

struct Args { const float* in[21]; float* out; unsigned char* ws; int ph_lo, ph_hi; };
enum { I_X = 0, I_N1 = 1, I_WIN = 2, I_LB = 3, I_HGN = 4, I_CW = 5, I_CB = 6, I_DTB = 7, I_ALOG = 8, I_DSK = 9, I_SSDN = 10, I_WSB = 11, I_WHG = 12, I_WSSD = 13, I_WOUT = 14,
       I_N2 = 15, I_WQ = 16, I_SK = 17, I_U = 18, I_V = 19, I_FN = 20 };
typedef const __attribute__((address_space(4))) Args* KArgs;
struct Frame {
    LAS unsigned char* lds;
    int tid, lane, wave, vcu, G, bx;
    KArgs ap;
};
#define WSP(T, off) ((T*)(F.ap->ws + (off)))

__device__ __forceinline__ void transpose_item(const float* W, int ldw, bf16* WT, int ldt, int nblk, LAS float* scr, int item, int lane) {
    const int kb = item / nblk, nb = item % nblk, k0 = 64 * kb, n0 = 64 * nb;
    f32x4 v[16];
#pragma unroll
    for (int i = 0; i < 16; ++i) v[i] = __builtin_nontemporal_load((const GAS f32x4*)(W + (size_t)(k0 + 4 * i + (lane >> 4)) * ldw + n0 + 4 * (lane & 15)));
#pragma unroll
    for (int i = 0; i < 16; ++i) { LAS float* d = scr + (4 * i + (lane >> 4)) * 65 + 4 * (lane & 15); d[0] = v[i].x; d[1] = v[i].y; d[2] = v[i].z; d[3] = v[i].w; }
    LDS_WAIT(); asm volatile("" ::: "memory");
    const int c = lane & 7;
#pragma unroll
    for (int j = 0; j < 8; ++j) { const int n = (lane >> 3) + 8 * j; const LAS float* s = scr + (8 * c) * 65 + n;
        v4u o; o.x = pk2(s[0 * 65], s[1 * 65]); o.y = pk2(s[2 * 65], s[3 * 65]); o.z = pk2(s[4 * 65], s[5 * 65]); o.w = pk2(s[6 * 65], s[7 * 65]);
        *(GAS v4u*)(WT + (size_t)(n0 + n) * ldt + k0 + 8 * c) = o; }
    LDS_WAIT(); asm volatile("" ::: "memory");
}
__device__ __forceinline__ void weff_item(Frame& F, const float* wq, const float* sk, bf16* WeffT, int item) {
    LAS float* skT = (LAS float*)F.lds;
    LAS float* wqT = (LAS float*)(F.lds + 128 * 132 * 4);
    const int g = item >> 4, d0 = (item & 15) * 64;
    for (int e = F.tid; e < 128 * 32; e += 512) { const int key = e >> 5, i4 = (e & 31) * 4; const f32x4 v = *(const GAS f32x4*)(sk + ((size_t)g * 128 + key) * 128 + i4);
        skT[(i4 + 0) * 132 + key] = v.x; skT[(i4 + 1) * 132 + key] = v.y; skT[(i4 + 2) * 132 + key] = v.z; skT[(i4 + 3) * 132 + key] = v.w; }
    for (int e = F.tid; e < 64 * 32; e += 512) { const int dl = e >> 5, i4 = (e & 31) * 4; const f32x4 v = *(const GAS f32x4*)(wq + (size_t)(d0 + dl) * 2048 + g * 128 + i4);
        wqT[(i4 + 0) * 68 + dl] = v.x; wqT[(i4 + 1) * 68 + dl] = v.y; wqT[(i4 + 2) * 68 + dl] = v.z; wqT[(i4 + 3) * 68 + dl] = v.w; }
    __syncthreads();
    const int ty = F.tid >> 4, tx = F.tid & 15;
    float acc[4][4];
#pragma unroll
    for (int a = 0; a < 4; ++a)
#pragma unroll
        for (int b = 0; b < 4; ++b) acc[a][b] = 0.f;
#pragma unroll 4
    for (int i = 0; i < 128; ++i) { const f32x4 a = *(const LAS f32x4*)(skT + i * 132 + 4 * ty), b = *(const LAS f32x4*)(wqT + i * 68 + 4 * tx);
#pragma unroll
        for (int p = 0; p < 4; ++p)
#pragma unroll
            for (int q = 0; q < 4; ++q) acc[p][q] += a[p] * b[q]; }
#pragma unroll
    for (int p = 0; p < 4; ++p) { v2u o; o.x = pk2(acc[p][0], acc[p][1]); o.y = pk2(acc[p][2], acc[p][3]);
        *(GAS v2u*)(WeffT + (size_t)(g * 128 + 4 * ty + p) * 1024 + d0 + 4 * tx) = o; }
    __syncthreads();
}
__device__ __forceinline__ void load_wdt(Frame& F, const float* w_in_l, LAS float* wdt) {
    for (int e = F.tid; e < 2048; e += 512) { const int d = e >> 1, hf = (e & 1) * 4; *(LAS f32x4*)(wdt + d * 8 + hf) = *(const GAS f32x4*)(w_in_l + (size_t)d * W_IN_COLS + W_DT_COL + hf); }
}
template <bool DO_DT> __device__ __forceinline__ void norm_row_from_regs(const f32x4 (&v)[4], const float* nw, bf16* xnrow, const LAS float* wdt, float* dtrow, int lane) {
    float s = 0.f;
#pragma unroll
    for (int j = 0; j < 4; ++j) s += (v[j].x * v[j].x + v[j].y * v[j].y) + (v[j].z * v[j].z + v[j].w * v[j].w);
    const float rstd = frsq(wave_sum(s, lane) * (1.f / DM) + EPS);
    f32x4 h[4];
#pragma unroll
    for (int j = 0; j < 4; ++j) { const f32x4 w = *(const GAS f32x4*)(nw + 4 * lane + 256 * j); h[j] = v[j] * rstd * w; }
    GAS unsigned long long* o8 = (GAS unsigned long long*)xnrow + lane;
#pragma unroll
    for (int j = 0; j < 4; ++j) o8[64 * j] = (unsigned long long)pk2(h[j].x, h[j].y) | ((unsigned long long)pk2(h[j].z, h[j].w) << 32);
    if constexpr (DO_DT) {
        float d[8];
#pragma unroll
        for (int q = 0; q < 8; ++q) d[q] = 0.f;
#pragma unroll
        for (int j = 0; j < 4; ++j)
#pragma unroll
            for (int e = 0; e < 4; ++e) { const float hv = __builtin_bit_cast(float, f2bf(h[j][e]) << 16);
                const LAS float* wp = wdt + (4 * lane + 256 * j + e) * 8; const f32x4 w0 = *(const LAS f32x4*)wp, w1 = *(const LAS f32x4*)(wp + 4);
                d[0] += hv * w0.x; d[1] += hv * w0.y; d[2] += hv * w0.z; d[3] += hv * w0.w; d[4] += hv * w1.x; d[5] += hv * w1.y; d[6] += hv * w1.z; d[7] += hv * w1.w; }
#pragma unroll
        for (int q = 0; q < 8; ++q) d[q] = wave_sum(d[q], lane);
        if (lane == 0) { *(GAS f32x4*)dtrow = (f32x4){d[0], d[1], d[2], d[3]}; *(GAS f32x4*)(dtrow + 4) = (f32x4){d[4], d[5], d[6], d[7]}; }
    }
}
constexpr int WT_NB_A = 4864 / 64, WT_NB_G = 3072 / 64;
constexpr int WT_I_A = 16 * WT_NB_A, WT_I_G = 16 * WT_NB_G, WT_I_BR = 8 * 16, WT_I_O = 16 * 16;
constexpr int WT_PER_LAYER = WT_I_A + WT_I_G + 3 * WT_I_BR + WT_I_O;
__device__ __forceinline__ void wt_item(Frame& F, int l, int r, LAS float* scr) {
    const float* win = F.ap->in[I_WIN] + (size_t)l * DM * W_IN_COLS; bf16* WinT = WSP(bf16, WS_WIN + (size_t)l * 16 * MiB);
    if (r < WT_I_A) { transpose_item(win, W_IN_COLS, WinT, DM, WT_NB_A, scr, r, F.lane); return; } r -= WT_I_A;
    if (r < WT_I_G) { transpose_item(win + W_GATE_COL, W_IN_COLS, WinT + (size_t)C_GATE * DM, DM, WT_NB_G, scr, r, F.lane); return; } r -= WT_I_G;
    bf16* WbrT = WSP(bf16, WS_WBR + (size_t)l * 3 * MiB);
    if (r < WT_I_BR) { transpose_item(F.ap->in[I_WSB] + (size_t)l * 512 * DM, DM, WbrT, 512, 16, scr, r, F.lane); return; } r -= WT_I_BR;
    if (r < WT_I_BR) { transpose_item(F.ap->in[I_WHG] + (size_t)l * 512 * DM, DM, WbrT + (size_t)1024 * 512, 512, 16, scr, r, F.lane); return; } r -= WT_I_BR;
    if (r < WT_I_BR) { transpose_item(F.ap->in[I_WSSD] + (size_t)l * 512 * DM, DM, WbrT + (size_t)2048 * 512, 512, 16, scr, r, F.lane); return; } r -= WT_I_BR;
    transpose_item(F.ap->in[I_WOUT] + (size_t)l * DM * DM, DM, WSP(bf16, WS_WOUT + (size_t)l * 2 * MiB), DM, 16, scr, r, F.lane);
}
__device__ __forceinline__ void p0_prologue(Frame& F) {
    const int gw = F.vcu * NWAVES + F.wave, NGW = F.G * NWAVES;
    {
        LAS float* scr = (LAS float*)(F.lds + F.wave * 16640);
        for (int it = gw; it < (MK_W1_LATE ? 1 : 2) * WT_PER_LAYER; it += NGW) { const int l = it / WT_PER_LAYER; wt_item(F, l, it - l * WT_PER_LAYER, scr); }
    }
    if (gw < 16) { const int l = gw >> 3, q = gw & 7; const float* win = F.ap->in[I_WIN] + (size_t)l * DM * W_IN_COLS + W_DT_COL + q; bf16* dst = WSP(bf16, WS_WIN + (size_t)l * 16 * MiB) + (size_t)(NP + q) * DM;
        for (int d = F.lane; d < DM; d += 64) dst[d] = (bf16)f2bf(win[(size_t)d * W_IN_COLS]); }
    __syncthreads();
    for (int it = F.vcu; it < 512; it += F.G) { const int l = it >> 8;
        weff_item(F, F.ap->in[I_WQ] + (size_t)l * DM * 2048, F.ap->in[I_SK] + (size_t)l * 16 * 128 * 128, WSP(bf16, WS_WEFF + (size_t)l * 4 * MiB), it & 255); }
    __syncthreads();
    { f32x4 nx[4];
      { const GAS f32x4* xr = (const GAS f32x4*)(F.ap->in[I_X] + (size_t)gw * DM) + F.lane;
#pragma unroll
        for (int j = 0; j < 4; ++j) nx[j] = xr[64 * j]; }
      for (int m = gw; m < TT; m += NGW) {
        f32x4 v[4];
#pragma unroll
        for (int j = 0; j < 4; ++j) v[j] = nx[j];
        if (m + NGW < TT) { const GAS f32x4* xr = (const GAS f32x4*)(F.ap->in[I_X] + (size_t)(m + NGW) * DM) + F.lane;
#pragma unroll
            for (int j = 0; j < 4; ++j) nx[j] = xr[64 * j]; }
        norm_row_from_regs<false>(v, F.ap->in[I_N1], XNP + (size_t)m * DM, (const LAS float*)F.lds, (float*)nullptr, F.lane);
      } }
    __syncthreads();
}
template <bool ISV> __device__ __forceinline__ void tables_items(Frame& F, int l, size_t i0, size_t step, size_t dstoff = (ISV ? WS_V8 : WS_U8)) {
    constexpr size_t N16 = (size_t)16384 * 1024 / 16;
    const float* T = F.ap->in[ISV ? I_V : I_U] + (size_t)l * 16384 * 1024; constexpr float sc = ISV ? 32.0f : 256.0f;
    for (size_t ib = i0; ib < N16; ib += 4 * step) {
        f32x4 a[4][4];
#pragma unroll
        for (int r = 0; r < 4; ++r) { const size_t j = ib + r * step; if (j < N16) {
#pragma unroll
            for (int q = 0; q < 4; ++q) a[r][q] = __builtin_nontemporal_load((const GAS f32x4*)(T + j * 16) + q); } }
#pragma unroll
        for (int r = 0; r < 4; ++r) { const size_t j = ib + r * step; if (j < N16) {
            v4u o;
#pragma unroll
            for (int q = 0; q < 4; ++q) { int p = 0; p = __builtin_amdgcn_cvt_pk_fp8_f32(a[r][q].x * sc, a[r][q].y * sc, p, false); p = __builtin_amdgcn_cvt_pk_fp8_f32(a[r][q].z * sc, a[r][q].w * sc, p, true); o[q] = (unsigned)p; }
            const size_t dst = (ISV || MK_UCOL) ? ((j & 63) >> 3) * (size_t)(16384 * 128) + (j >> 6) * 128 + (j & 7) * 16 : j * 16;
            *(GAS v4u*)(F.ap->ws + dstoff + dst) = o; } }
    }
}

__device__ __forceinline__ int crow(int r, int hi) { return (r & 3) + 8 * (r >> 2) + 4 * hi; }
__device__ __forceinline__ void sb_block(const f32x16& p, int kb  , int qi, float& R, float (&a)[16], int lane) {
    float beta[16], suf[16], tot[4], ptot[4];
#pragma unroll
    for (int g = 0; g < 4; ++g) {
        float omb[4];
#pragma unroll
        for (int i = 0; i < 4; ++i) { const int r = 4 * g + i; const float z = p[r] * 0.125f;
            const float e = __builtin_amdgcn_exp2f(-fabsf(z) * 1.4426950408889634f), rc = frcp(1.f + e), sm = e * rc;
            const bool pos = z >= 0.f, valid = (kb + i + 8 * g) < qi;
            beta[r] = valid ? (pos ? rc : sm) : 0.f; omb[i] = valid ? (pos ? sm : rc) : 1.f; }
        suf[4 * g + 3] = 1.f; suf[4 * g + 2] = omb[3]; suf[4 * g + 1] = omb[3] * omb[2]; suf[4 * g] = suf[4 * g + 1] * omb[1]; tot[g] = suf[4 * g] * omb[0];
    }
#pragma unroll
    for (int g = 0; g < 4; ++g) ptot[g] = shx(tot[g], 32, lane);
    const bool lo = lane < 32;
    float sp[4]; sp[3] = 1.f; sp[2] = tot[3] * ptot[3]; sp[1] = sp[2] * (tot[2] * ptot[2]); sp[0] = sp[1] * (tot[1] * ptot[1]);
    const float total = sp[0] * (tot[0] * ptot[0]);
#pragma unroll
    for (int g = 0; g < 4; ++g) { const float af = R * sp[g] * (lo ? ptot[g] : 1.f);
#pragma unroll
        for (int i = 0; i < 4; ++i) a[4 * g + i] = beta[4 * g + i] * af * suf[4 * g + i]; }
    R *= total;
}
__device__ __forceinline__ void sb_attn_wave(const bf16* PROJ, bf16* Y0, int b, int h, int qblk, LAS bf16* vt  , int lane) {
    const int r32 = lane & 31, hi = lane >> 5;
    const size_t rowbase = (size_t)b * SEQ;
    const int qw = qblk * 32, qi = qw + r32;
    bf16x8 qf[4];
    { const bf16* qp = PROJ + (rowbase + qi) * NP + C_SBQ + h * 64 + hi * 8;
#pragma unroll
      for (int d0 = 0; d0 < 4; ++d0) qf[d0] = *(const GAS bf16x8*)(qp + d0 * 16); }
    f32x16 o0 = {}, o1 = {};
    float R = 1.0f;
    for (int kt = (qw + 30) >> 6; kt >= 0; --kt) {
        const bf16* kp = PROJ + (rowbase + (size_t)kt * 64 + r32) * NP + C_SBK + h * 64 + hi * 8;
        bf16x8 kf0[4], kf1[4];
#pragma unroll
        for (int d0 = 0; d0 < 4; ++d0) { kf0[d0] = *(const GAS bf16x8*)(kp + d0 * 16); kf1[d0] = *(const GAS bf16x8*)(kp + (size_t)32 * NP + d0 * 16); }
        { const bf16* vp = PROJ + (rowbase + (size_t)kt * 64 + (lane >> 3)) * NP + C_SBV + h * 64 + (lane & 7) * 8;
          bf16x8 vv[8];
#pragma unroll
          for (int i = 0; i < 8; ++i) vv[i] = *(const GAS bf16x8*)(vp + (size_t)(8 * i) * NP);
#pragma unroll
          for (int i = 0; i < 8; ++i)
#pragma unroll
              for (int e = 0; e < 8; ++e) vt[((lane & 7) * 8 + e) * 72 + (lane >> 3) + 8 * i] = (bf16)vv[i][e]; }
        f32x16 p0 = {}, p1 = {};
#pragma unroll
        for (int d0 = 0; d0 < 4; ++d0) { p0 = MFMA32(kf0[d0], qf[d0], p0); p1 = MFMA32(kf1[d0], qf[d0], p1); }
        float a1[16], a0[16];
        sb_block(p1, kt * 64 + 32 + 4 * hi, qi, R, a1, lane);
        sb_block(p0, kt * 64 + 4 * hi, qi, R, a0, lane);
        bf16x8 pa[4]; pa[0] = pack8(a0); pa[1] = pack8(a0 + 8); pa[2] = pack8(a1); pa[3] = pack8(a1 + 8);
        LDS_WAIT();
#pragma unroll
        for (int s = 0; s < 4; ++s) {
            const LAS bf16* v0p = vt + r32 * 72 + 16 * s + 4 * hi; const LAS bf16* v1p = vt + (32 + r32) * 72 + 16 * s + 4 * hi;
            const v2u x0 = *(const LAS v2u*)v0p, x1 = *(const LAS v2u*)(v0p + 8), y0 = *(const LAS v2u*)v1p, y1 = *(const LAS v2u*)(v1p + 8);
            const bf16x8 vb0 = __builtin_bit_cast(bf16x8, (v4u){x0.x, x0.y, x1.x, x1.y}), vb1 = __builtin_bit_cast(bf16x8, (v4u){y0.x, y0.y, y1.x, y1.y});
            o0 = MFMA32(pa[s], vb0, o0); o1 = MFMA32(pa[s], vb1, o1);
        }
        LDS_WAIT();
        if (__all(R < 1e-37f)) break;
    }
    bf16* yp = Y0 + (rowbase + qw) * 512 + h * 64 + r32;
#pragma unroll
    for (int r = 0; r < 16; ++r) { const int q = crow(r, hi); yp[(size_t)q * 512] = (bf16)f2bf(o0[r]); yp[(size_t)q * 512 + 32] = (bf16)f2bf(o1[r]); }
}
__device__ __forceinline__ void p_sb_attn(Frame& F) {
    LAS bf16* vt = (LAS bf16*)(F.lds + F.wave * 9216);
    const int gw = F.vcu * NWAVES + F.wave, NGW = F.G * NWAVES;
    for (int u = gw, it_ = 0; u < 4096; u += NGW, ++it_) sb_attn_wave(WSP(bf16, WS_PROJ), WSP(bf16, WS_Y), u >> 11, (u >> 8) & 7, (it_ & 1) ? 255 - (u & 255) : (u & 255), vt, F.lane);
}

__device__ __forceinline__ float hg_lb(const float* lbl, int l, int kk) { return l == 0 ? 0.f : sigmoidf_(lbl[512 + kk] - lbl[kk]); }
__device__ __forceinline__ void ld8f(const LAS float* p, float* v) { const f32x4 a = *(const LAS f32x4*)p, b = *(const LAS f32x4*)(p + 4); v[0] = a.x; v[1] = a.y; v[2] = a.z; v[3] = a.w; v[4] = b.x; v[5] = b.y; v[6] = b.z; v[7] = b.w; }
constexpr int HG_P = 132;
__device__ __forceinline__ void hg_local_unit(Frame& F, int l, int b, int h, int c) {
    LAS float* Bc = (LAS float*)F.lds;
    LAS float* Ky = (LAS float*)(F.lds + 33792);
    LAS bf16* Vt = (LAS bf16*)(F.lds + 67584);
    LAS float* Sg = (LAS float*)(F.lds + 86016);
    const bf16* PROJ = WSP(bf16, WS_PROJ);
    const size_t row0 = (size_t)b * SEQ + (size_t)c * 64;
    const int tid = F.tid, lane = F.lane, w = F.wave, fr = lane & 15, quad = lane >> 4;
    float lbv[8];
#pragma unroll
    for (int j = 0; j < 8; ++j) lbv[j] = hg_lb(F.ap->in[I_LB], l, h * 128 + (tid & 15) * 8 + j);
    for (int e = tid; e < 64 * 16; e += 512) { const int t = e >> 4, k8 = (e & 15) * 8;
        float fv[8]; unpack8(*(const GAS v4u*)(PROJ + (row0 + t) * NP + C_HGF + h * 128 + k8), fv);
#pragma unroll
        for (int j = 0; j < 8; ++j) { const float lb = lbv[j];
            const float ee = fexp(-fabsf(fv[j])), rc = frcp(1.f + ee), sm = ee * rc; const bool pos = fv[j] >= 0.f;
            const float sg = pos ? rc : sm, sgn = pos ? sm : rc;
            const float f = lb + (1.f - lb) * sg;
            Bc[t * HG_P + k8 + j] = __logf(fmaxf(f, 1e-30f)); Ky[t * HG_P + k8 + j] = (1.f - lb) * sgn; }
        const v4u iv = *(const GAS v4u*)(PROJ + (row0 + t) * NP + C_HGI + h * 128 + k8);
        Vt[(k8 + 0) * 72 + t] = (bf16)(iv.x & 0xffff); Vt[(k8 + 1) * 72 + t] = (bf16)(iv.x >> 16); Vt[(k8 + 2) * 72 + t] = (bf16)(iv.y & 0xffff); Vt[(k8 + 3) * 72 + t] = (bf16)(iv.y >> 16);
        Vt[(k8 + 4) * 72 + t] = (bf16)(iv.z & 0xffff); Vt[(k8 + 5) * 72 + t] = (bf16)(iv.z >> 16); Vt[(k8 + 6) * 72 + t] = (bf16)(iv.w & 0xffff); Vt[(k8 + 7) * 72 + t] = (bf16)(iv.w >> 16); }
    __syncthreads();
    { const int seg = tid >> 7, k = tid & 127; float cv[16];
#pragma unroll
      for (int i = 0; i < 16; ++i) cv[i] = Bc[(seg * 16 + i) * HG_P + k];
#pragma unroll
      for (int i = 1; i < 16; ++i) cv[i] += cv[i - 1];
      Sg[seg * 128 + k] = cv[15];
      __syncthreads();
      float off = 0.f;
#pragma unroll
      for (int s = 0; s < 3; ++s) if (s < seg) off += Sg[s * 128 + k];
#pragma unroll
      for (int i = 0; i < 16; ++i) Bc[(seg * 16 + i) * HG_P + k] = cv[i] + off; }
    __syncthreads();
    if (tid < 128) WSP(float, WS_DCH)[(((size_t)(b * 4 + h)) * 128 + c) * 128 + tid] = fexp(Bc[63 * HG_P + tid]);
    {
        const int I = (w < 4) ? (w >> 1) : 3 - ((w - 4) >> 1), vh = w & 1;
        const int tl = 16 * I + fr;
        bf16x8 bq[4];
#pragma unroll
        for (int ks = 0; ks < 4; ++ks) { const int k0 = 32 * ks + 8 * quad;
            float qv[8], bt[8], rf[8], o[8], oq[8];
            unpack8(*(const GAS v4u*)(PROJ + (row0 + tl) * NP + C_HGQ + h * 128 + k0), qv);
            ld8f(Bc + tl * HG_P + k0, bt);
            if (I > 0) ld8f(Bc + (16 * I - 1) * HG_P + k0, rf); else {
#pragma unroll
                for (int j = 0; j < 8; ++j) rf[j] = 0.f; }
#pragma unroll
            for (int j = 0; j < 8; ++j) { const float qs = siluf_(qv[j]) * 0.08838834764831845f; o[j] = qs * fexp(bt[j] - rf[j]); oq[j] = qs * fexp(bt[j]); }
            bq[ks] = pack8(o);
            if (vh == 0) *(GAS bf16x8*)(WSP(bf16, WS_QT) + (row0 + tl) * 512 + h * 128 + k0) = pack8(oq);
        }
        f32x4 sT[4];
#pragma unroll
        for (int J = 0; J < 4; ++J) { sT[J] = (f32x4){0.f, 0.f, 0.f, 0.f};
            if (J <= I) { const int sl = 16 * J + fr;
#pragma unroll
                for (int ks = 0; ks < 4; ++ks) { const int k0 = 32 * ks + 8 * quad; float kv[8], bs[8], rf[8], o[8];
                    ld8f(Ky + sl * HG_P + k0, kv); ld8f(Bc + sl * HG_P + k0, bs);
                    if (I > 0) ld8f(Bc + (16 * I - 1) * HG_P + k0, rf); else {
#pragma unroll
                        for (int j = 0; j < 8; ++j) rf[j] = 0.f; }
#pragma unroll
                    for (int j = 0; j < 8; ++j) o[j] = kv[j] * fexp(fminf(rf[j] - bs[j], 80.f));
                    sT[J] = MFMA16(pack8(o), bq[ks], sT[J]); }
                if (J == I) {
#pragma unroll
                    for (int r = 0; r < 4; ++r) if (4 * quad + r > fr) sT[J][r] = 0.f; }
            } }
        bf16x8 bs0, bs1;
        { float t0[8] = {sT[0][0], sT[0][1], sT[0][2], sT[0][3], sT[1][0], sT[1][1], sT[1][2], sT[1][3]}; bs0 = pack8(t0);
          float t1[8] = {sT[2][0], sT[2][1], sT[2][2], sT[2][3], sT[3][0], sT[3][1], sT[3][2], sT[3][3]}; bs1 = pack8(t1); }
#pragma unroll
        for (int vi = 0; vi < 4; ++vi) { const int vb = vh * 4 + vi; const LAS bf16* vp = Vt + (16 * vb + fr) * 72 + 4 * quad;
            f32x4 acc = {0.f, 0.f, 0.f, 0.f};
            { const v2u x0 = *(const LAS v2u*)vp, x1 = *(const LAS v2u*)(vp + 16); acc = MFMA16(__builtin_bit_cast(bf16x8, (v4u){x0.x, x0.y, x1.x, x1.y}), bs0, acc); }
            if (I >= 2) { const v2u x0 = *(const LAS v2u*)(vp + 32), x1 = *(const LAS v2u*)(vp + 48); acc = MFMA16(__builtin_bit_cast(bf16x8, (v4u){x0.x, x0.y, x1.x, x1.y}), bs1, acc); }
            v2u o; o.x = pk2(acc[0], acc[1]); o.y = pk2(acc[2], acc[3]);
            *(GAS v2u*)(WSP(bf16, WS_OI) + (row0 + tl) * 512 + h * 128 + 16 * vb + 4 * quad) = o; }
    }
    {
        const int k = 16 * w + fr; const float bl = Bc[63 * HG_P + k];
        bf16x8 bk[2];
#pragma unroll
        for (int ks = 0; ks < 2; ++ks) { float o[8];
#pragma unroll
            for (int j = 0; j < 8; ++j) { const int s = 32 * ks + 8 * quad + j; o[j] = Ky[s * HG_P + k] * fexp(bl - Bc[s * HG_P + k]); }
            bk[ks] = pack8(o); }
        bf16* S = WSP(bf16, WS_HGS) + (((size_t)(b * 4 + h)) * 128 + c) * 16384;
#pragma unroll
        for (int vb = 0; vb < 8; ++vb) { f32x4 acc = {0.f, 0.f, 0.f, 0.f};
#pragma unroll
            for (int ks = 0; ks < 2; ++ks) acc = MFMA16(*(const LAS bf16x8*)(Vt + (16 * vb + fr) * 72 + 32 * ks + 8 * quad), bk[ks], acc);
#pragma unroll
            for (int r = 0; r < 4; ++r) S[(size_t)(16 * vb + 4 * quad + r) * 128 + k] = (bf16)f2bf(acc[r]); }
    }
    __syncthreads();
}
struct HgOutRegs { v4u qv[2]; bf16x8 af[4]; v2u oiv[4], gvv[4]; };
__device__ __forceinline__ void hg_out_load(Frame& F, int b, int h, int c, HgOutRegs& R) {
    const bf16* PROJ = WSP(bf16, WS_PROJ);
    const size_t row0 = (size_t)b * SEQ + (size_t)c * 64;
    const int lane = F.lane, w = F.wave, fr = lane & 15, quad = lane >> 4;
    const bf16* S = WSP(bf16, WS_HGS) + (((size_t)(b * 4 + h)) * 128 + c) * 16384;
#pragma unroll
    for (int it = 0; it < 2; ++it) { const int e = F.tid + 512 * it; R.qv[it] = *(const GAS v4u*)(WSP(bf16, WS_QT) + (row0 + (e >> 4)) * 512 + h * 128 + (e & 15) * 8); }
#pragma unroll
    for (int ks = 0; ks < 4; ++ks) R.af[ks] = *(const GAS bf16x8*)(S + (size_t)(16 * w + fr) * 128 + 32 * ks + 8 * quad);
#pragma unroll
    for (int tb = 0; tb < 4; ++tb) { R.oiv[tb] = *(const GAS v2u*)(WSP(bf16, WS_OI) + (row0 + 16 * tb + fr) * 512 + h * 128 + 16 * w + 4 * quad); R.gvv[tb] = *(const GAS v2u*)(PROJ + (row0 + 16 * tb + fr) * NP + C_HGG + h * 128 + 16 * w + 4 * quad); }
}
__device__ __forceinline__ void hg_out_compute(Frame& F, int l, int b, int h, int c, const HgOutRegs& R) {
    LAS float* SS = (LAS float*)F.lds;
    const size_t row0 = (size_t)b * SEQ + (size_t)c * 64;
    const int lane = F.lane, w = F.wave, fr = lane & 15, quad = lane >> 4;
    LAS bf16* Qs = (LAS bf16*)(F.lds + 2048);
    const f32x4 nw = *(const GAS f32x4*)(F.ap->in[I_HGN] + (size_t)l * 128 + 16 * w + 4 * quad);
#pragma unroll
    for (int it = 0; it < 2; ++it) { const int e = F.tid + 512 * it; *(LAS v4u*)(Qs + (e >> 4) * 136 + (e & 15) * 8) = R.qv[it]; }
    __syncthreads();
    f32x4 o[4];
#pragma unroll
    for (int tb = 0; tb < 4; ++tb) { o[tb] = (f32x4){0.f, 0.f, 0.f, 0.f};
#pragma unroll
        for (int ks = 0; ks < 4; ++ks) o[tb] = MFMA16(R.af[ks], *(const LAS bf16x8*)(Qs + (16 * tb + fr) * 136 + 32 * ks + 8 * quad), o[tb]);
        const v2u oi = R.oiv[tb];
        o[tb][0] += bflo(oi.x); o[tb][1] += bfhi(oi.x); o[tb][2] += bflo(oi.y); o[tb][3] += bfhi(oi.y);
        float ss = (o[tb][0] * o[tb][0] + o[tb][1] * o[tb][1]) + (o[tb][2] * o[tb][2] + o[tb][3] * o[tb][3]);
        ss += shx(ss, 16, lane); ss += shx(ss, 32, lane);
        if (quad == 0) SS[w * 64 + 16 * tb + fr] = ss; }
    __syncthreads();
#pragma unroll
    for (int tb = 0; tb < 4; ++tb) { const int t = 16 * tb + fr; float tot = 0.f;
#pragma unroll
        for (int ww = 0; ww < 8; ++ww) tot += SS[ww * 64 + t];
        const float rstd = frsq(tot * (1.f / 128.f) + EPS);
        const v2u gv = R.gvv[tb];
        const float y0 = o[tb][0] * rstd * nw.x * siluf_(bflo(gv.x)), y1 = o[tb][1] * rstd * nw.y * siluf_(bfhi(gv.x)), y2 = o[tb][2] * rstd * nw.z * siluf_(bflo(gv.y)), y3 = o[tb][3] * rstd * nw.w * siluf_(bfhi(gv.y));
        v2u ov; ov.x = pk2(y0, y1); ov.y = pk2(y2, y3);
        *(GAS v2u*)(WSP(bf16, WS_Y) + (size_t)TT * 512 + (row0 + t) * 512 + h * 128 + 16 * w + 4 * quad) = ov; }
    __syncthreads();
}
__device__ __forceinline__ void hg_out_units(Frame& F, int l, int first, int stride) {
    if (first >= 1024) return;
    HgOutRegs Ra, Rb;
#define HGO_B(u) ((u) >> 9)
#define HGO_H(u) (((u) >> 7) & 3)
#define HGO_C(u) ((u) & 127)
    hg_out_load(F, HGO_B(first), HGO_H(first), HGO_C(first), Ra);
    for (int u = first; u < 1024; u += 2 * stride) {
        const int u1 = u + stride, u2 = u + 2 * stride;
        { const int un = u1 < 1024 ? u1 : u; hg_out_load(F, HGO_B(un), HGO_H(un), HGO_C(un), Rb); }
        hg_out_compute(F, l, HGO_B(u), HGO_H(u), HGO_C(u), Ra);
        if (u1 >= 1024) break;
        { const int un = u2 < 1024 ? u2 : u1; hg_out_load(F, HGO_B(un), HGO_H(un), HGO_C(un), Ra); }
        hg_out_compute(F, l, HGO_B(u1), HGO_H(u1), HGO_C(u1), Rb);
    }
#undef HGO_B
#undef HGO_H
#undef HGO_C
}

constexpr int SL_CM = 0, SL_BM = 18432, SL_BT = 36864, SL_XT = 54272, SL_AC = 123904, SL_DT = 125952;
__device__ __forceinline__ void ssd_local_unit(Frame& F, int l, int b, int c, int g) {
    LAS bf16* Cm = (LAS bf16*)(F.lds + SL_CM); LAS bf16* Bm = (LAS bf16*)(F.lds + SL_BM); LAS bf16* Bt = (LAS bf16*)(F.lds + SL_BT); LAS bf16* Xt = (LAS bf16*)(F.lds + SL_XT);
    LAS float* AC = (LAS float*)(F.lds + SL_AC); LAS float* DT = (LAS float*)(F.lds + SL_DT);
    const bf16* PROJ = WSP(bf16, WS_PROJ);
    const size_t row0 = (size_t)b * SEQ + (size_t)c * 128;
    const int tid = F.tid, lane = F.lane, w = F.wave, fr = lane & 15, quad = lane >> 4;
    if (w < 4) { const int head = 4 * g + w; const float bias = F.ap->in[I_DTB][l * 8 + head], A = -fexp(F.ap->in[I_ALOG][l * 8 + head]);
        float dt[2], a[2];
#pragma unroll
        for (int i = 0; i < 2; ++i) { const float x = WSP(float, WS_DT)[(row0 + 2 * lane + i) * 8 + head] + bias; dt[i] = x > 20.f ? x : __logf(1.f + fexp(x)); a[i] = A * dt[i]; }
        float v = a[0] + a[1], inc = v;
#pragma unroll
        for (int o = 1; o < 64; o <<= 1) { const float t = shi(inc, lane >= o ? lane - o : lane); if (lane >= o) inc += t; }
        const float ex = inc - v;
        AC[w * 128 + 2 * lane] = ex + a[0]; AC[w * 128 + 2 * lane + 1] = ex + v; DT[w * 128 + 2 * lane] = dt[0]; DT[w * 128 + 2 * lane + 1] = dt[1]; }
    if (tid < 384) { const float* cw = F.ap->in[I_CW] + (size_t)l * 4 * 768; const float* cb = F.ap->in[I_CB] + (size_t)l * 768;
        const int cgp = tid % 48, rb = tid / 48;
        const int ch = cgp < 32 ? 256 * g + 8 * cgp : (cgp < 40 ? 512 + 64 * g + 8 * (cgp - 32) : 640 + 64 * g + 8 * (cgp - 40));
        f32x4 wk[4][2];
#pragma unroll
        for (int k = 0; k < 4; ++k) { wk[k][0] = *(const GAS f32x4*)(cw + k * 768 + ch); wk[k][1] = *(const GAS f32x4*)(cw + k * 768 + ch + 4); }
        const f32x4 b0 = *(const GAS f32x4*)(cb + ch), b1 = *(const GAS f32x4*)(cb + ch + 4);
#pragma unroll 1
        for (int hf = 0; hf < 2; ++hf) {
        v4u xr[11];
#pragma unroll
        for (int i = 0; i < 11; ++i) { const int lt = 16 * rb + 8 * hf - 3 + i; const bool ok = c > 0 || lt >= 0;
            xr[i] = *(const GAS v4u*)(PROJ + (size_t)((long)row0 + (ok ? lt : 0)) * NP + C_XBC + ch); if (!ok) xr[i] = (v4u){0u, 0u, 0u, 0u}; }
#pragma unroll
        for (int j = 0; j < 8; ++j) { const int lr = 16 * rb + 8 * hf + j;
            float acc[8] = {b0.x, b0.y, b0.z, b0.w, b1.x, b1.y, b1.z, b1.w};
#pragma unroll
            for (int k = 0; k < 4; ++k) { float xv[8]; unpack8(xr[j + k], xv);
                acc[0] += wk[k][0].x * xv[0]; acc[1] += wk[k][0].y * xv[1]; acc[2] += wk[k][0].z * xv[2]; acc[3] += wk[k][0].w * xv[3]; acc[4] += wk[k][1].x * xv[4]; acc[5] += wk[k][1].y * xv[5]; acc[6] += wk[k][1].z * xv[6]; acc[7] += wk[k][1].w * xv[7]; }
#pragma unroll
            for (int q = 0; q < 8; ++q) acc[q] = siluf_(acc[q]);
            if (cgp < 32) {
#pragma unroll
                for (int q = 0; q < 8; ++q) Xt[(8 * cgp + q) * 136 + lr] = (bf16)f2bf(acc[q]);
            } else if (cgp < 40) { const int n0 = 8 * (cgp - 32); *(LAS bf16x8*)(Bm + lr * 72 + n0) = pack8(acc);
#pragma unroll
                for (int q = 0; q < 8; ++q) Bt[(n0 + q) * 136 + lr] = (bf16)f2bf(acc[q]);
            } else { const int n0 = 8 * (cgp - 40); *(LAS bf16x8*)(Cm + lr * 72 + n0) = pack8(acc); } } } }
    __syncthreads();
    for (int e = tid; e < 128 * 32; e += 512) { const int lr = e >> 5, hh = (e >> 3) & 3, n8 = (e & 7) * 8; float cv[8]; unpack8(*(const LAS v4u*)(Cm + lr * 72 + n8), cv);
        const float ea = fexp(AC[hh * 128 + lr]);
#pragma unroll
        for (int j = 0; j < 8; ++j) cv[j] *= ea;
        *(GAS bf16x8*)(WSP(bf16, WS_CE) + (row0 + lr) * 512 + (4 * g + hh) * 64 + n8) = pack8(cv); }
    if (tid < 4) WSP(float, WS_ATOT)[((size_t)b * 64 + c) * 8 + 4 * g + tid] = AC[tid * 128 + 127];
    for (int ps_ = 0; ps_ < 2; ++ps_) { const int wq = ps_ ? 7 - w : w;
        const int ll = 16 * wq + fr;
        bf16x8 cf[2];
#pragma unroll
        for (int ks = 0; ks < 2; ++ks) cf[ks] = *(const LAS bf16x8*)(Cm + ll * 72 + 32 * ks + 8 * quad);
        f32x4 gT[8];
#pragma unroll
        for (int sb = 0; sb < 8; ++sb) { gT[sb] = (f32x4){0.f, 0.f, 0.f, 0.f};
            if (sb <= wq) {
#pragma unroll
                for (int ks = 0; ks < 2; ++ks) gT[sb] = MFMA16(*(const LAS bf16x8*)(Bm + (16 * sb + fr) * 72 + 32 * ks + 8 * quad), cf[ks], gT[sb]); } }
#pragma unroll 1
        for (int hh = 2 * ps_; hh < 2 * ps_ + 2; ++hh) { const int head = 4 * g + hh; const float al = AC[hh * 128 + ll], dsk = F.ap->in[I_DSK][l * 8 + head];
            f32x4 yT[4];
#pragma unroll
            for (int pb = 0; pb < 4; ++pb) yT[pb] = (f32x4){0.f, 0.f, 0.f, 0.f};
#pragma unroll
            for (int pj = 0; pj < 4; ++pj) if (2 * pj <= wq) {
                float o[8];
#pragma unroll
                for (int j = 0; j < 8; ++j) { const int sb = 2 * pj + (j >> 2), s = 16 * sb + 4 * quad + (j & 3);
                    const float gv = (j < 4) ? gT[2 * pj][j & 3] : gT[2 * pj + 1][j & 3];
                    float v = gv * fexp(fminf(al - AC[hh * 128 + s], 0.f)) * DT[hh * 128 + s];
                    if (s == ll) v += dsk;
                    o[j] = (s <= ll) ? v : 0.f; }
                const bf16x8 bfr = pack8(o);
#pragma unroll
                for (int pb = 0; pb < 4; ++pb) { const LAS bf16* xp = Xt + (hh * 64 + 16 * pb + fr) * 136 + 32 * pj + 4 * quad;
                    const v2u x0 = *(const LAS v2u*)xp, x1 = *(const LAS v2u*)(xp + 16);
                    yT[pb] = MFMA16(__builtin_bit_cast(bf16x8, (v4u){x0.x, x0.y, x1.x, x1.y}), bfr, yT[pb]); } }
#pragma unroll
            for (int pb = 0; pb < 4; ++pb) { v2u ov; ov.x = pk2(yT[pb][0], yT[pb][1]); ov.y = pk2(yT[pb][2], yT[pb][3]);
                *(GAS v2u*)(WSP(bf16, WS_YD) + (row0 + ll) * 512 + head * 64 + 16 * pb + 4 * quad) = ov; } }
    }
    {
        const int hh = w >> 1, head = 4 * g + hh, pb0 = (w & 1) * 2; const float alast = AC[hh * 128 + 127];
        f32x4 st[2][4];
#pragma unroll
        for (int i = 0; i < 2; ++i)
#pragma unroll
            for (int nb = 0; nb < 4; ++nb) st[i][nb] = (f32x4){0.f, 0.f, 0.f, 0.f};
#pragma unroll
        for (int ks = 0; ks < 4; ++ks) { const int s0 = 32 * ks + 8 * quad; float wv[8];
#pragma unroll
            for (int j = 0; j < 8; ++j) wv[j] = fexp(alast - AC[hh * 128 + s0 + j]) * DT[hh * 128 + s0 + j];
            bf16x8 xa[2];
#pragma unroll
            for (int i = 0; i < 2; ++i) xa[i] = *(const LAS bf16x8*)(Xt + (hh * 64 + 16 * (pb0 + i) + fr) * 136 + s0);
#pragma unroll
            for (int nb = 0; nb < 4; ++nb) { float bv[8]; unpack8(*(const LAS v4u*)(Bt + (16 * nb + fr) * 136 + s0), bv);
#pragma unroll
                for (int j = 0; j < 8; ++j) bv[j] *= wv[j];
                const bf16x8 bfr = pack8(bv);
#pragma unroll
                for (int i = 0; i < 2; ++i) st[i][nb] = MFMA16(xa[i], bfr, st[i][nb]); } }
        bf16* S = WSP(bf16, WS_SSDS) + ((((size_t)b * 64 + c) * 8 + head) * 4096);
#pragma unroll
        for (int i = 0; i < 2; ++i)
#pragma unroll
            for (int nb = 0; nb < 4; ++nb)
#pragma unroll
                for (int r = 0; r < 4; ++r) S[(size_t)(16 * (pb0 + i) + 4 * quad + r) * 64 + 16 * nb + fr] = (bf16)f2bf(st[i][nb][r]);
    }
    __syncthreads();
}
__device__ __forceinline__ void ssd_out_unit(Frame& F, int l, int b, int c, int g) {
    const bf16* PROJ = WSP(bf16, WS_PROJ);
    const size_t row0 = (size_t)b * SEQ + (size_t)c * 128;
    const int lane = F.lane, w = F.wave, fr = lane & 15, quad = lane >> 4;
    const size_t row = row0 + 16 * w + fr;
    f32x4 yT[4][4]; float ss = 0.f;
#pragma unroll
    for (int hh = 0; hh < 4; ++hh) { const int head = 4 * g + hh;
        bf16x8 cf[2];
#pragma unroll
        for (int ks = 0; ks < 2; ++ks) cf[ks] = *(const GAS bf16x8*)(WSP(bf16, WS_CE) + row * 512 + head * 64 + 32 * ks + 8 * quad);
        const bf16* S = WSP(bf16, WS_SSDS) + ((((size_t)b * 64 + c) * 8 + head) * 4096);
#pragma unroll
        for (int pb = 0; pb < 4; ++pb) { f32x4 acc = {0.f, 0.f, 0.f, 0.f};
#pragma unroll
            for (int ks = 0; ks < 2; ++ks) acc = MFMA16(*(const GAS bf16x8*)(S + (size_t)(16 * pb + fr) * 64 + 32 * ks + 8 * quad), cf[ks], acc);
            const int col = head * 64 + 16 * pb + 4 * quad;
            const v2u yd = *(const GAS v2u*)(WSP(bf16, WS_YD) + row * 512 + col), zv = *(const GAS v2u*)(PROJ + row * NP + C_SSDZ + col);
            acc[0] = (acc[0] + bflo(yd.x)) * siluf_(bflo(zv.x)); acc[1] = (acc[1] + bfhi(yd.x)) * siluf_(bfhi(zv.x)); acc[2] = (acc[2] + bflo(yd.y)) * siluf_(bflo(zv.y)); acc[3] = (acc[3] + bfhi(yd.y)) * siluf_(bfhi(zv.y));
            ss += (acc[0] * acc[0] + acc[1] * acc[1]) + (acc[2] * acc[2] + acc[3] * acc[3]);
            yT[hh][pb] = acc; } }
    ss += shx(ss, 16, lane); ss += shx(ss, 32, lane);
    const float rstd = frsq(ss * (1.f / 256.f) + EPS);
#pragma unroll
    for (int hh = 0; hh < 4; ++hh)
#pragma unroll
        for (int pb = 0; pb < 4; ++pb) { const int col = (4 * g + hh) * 64 + 16 * pb + 4 * quad; const f32x4 nw = *(const GAS f32x4*)(F.ap->in[I_SSDN] + (size_t)l * 512 + col);
            v2u ov; ov.x = pk2(yT[hh][pb][0] * rstd * nw.x, yT[hh][pb][1] * rstd * nw.y); ov.y = pk2(yT[hh][pb][2] * rstd * nw.z, yT[hh][pb][3] * rstd * nw.w);
            *(GAS v2u*)(WSP(bf16, WS_Y) + (size_t)2 * TT * 512 + row * 512 + col) = ov; }
}
template <bool DRY> __device__ __forceinline__ void p_scan(Frame& F) {
    if (F.wave < 4) {
        const int gt = F.vcu * 256 + F.tid;
        if (gt < 65536) {
        const int bh = gt >> 13, pr = gt & 8191, k = (2 * pr) & 127;
        unsigned* S = (unsigned*)(WSP(bf16, WS_HGS) + (size_t)bh * 128 * 16384) + pr; const float* D = WSP(float, WS_DCH) + (size_t)bh * 128 * 128 + k;
        float r0 = 0.f, r1 = 0.f;
        unsigned xa[16], xb[16]; f32x2 da[16], db[16];
#define SC_LD(X_, D_, c0) do { _Pragma("unroll") for (int i = 0; i < 16; ++i) { X_[i] = __builtin_nontemporal_load((const GAS unsigned*)(S + (size_t)((c0) + i) * 8192)); D_[i] = *(const GAS f32x2*)(D + (size_t)((c0) + i) * 128); } } while (0)
#define SC_PROC(X_, D_, c0) do { _Pragma("unroll") for (int i = 0; i < 16; ++i) { const unsigned pv = pk2(r0, r1); if constexpr (!DRY) *(GAS unsigned*)(S + (size_t)((c0) + i) * 8192) = pv; else asm volatile("" :: "v"(pv)); r0 = r0 * D_[i].x + bflo(X_[i]); r1 = r1 * D_[i].y + bfhi(X_[i]); } } while (0)
        SC_LD(xa, da, 0);
        for (int c0 = 0; c0 < 128; c0 += 32) { SC_LD(xb, db, c0 + 16); SC_PROC(xa, da, c0); if (c0 + 32 < 128) SC_LD(xa, da, c0 + 32); SC_PROC(xb, db, c0 + 16); }
#undef SC_LD
#undef SC_PROC
        }
    } else if (F.wave < 6) {
        const int e = F.vcu * 128 + (F.tid - 256);
        if (e < 32768) {
        const int bh = e >> 11, pr = e & 2047, b = bh >> 3, h = bh & 7;
        unsigned* S = (unsigned*)(WSP(bf16, WS_SSDS) + ((size_t)b * 64 * 8 + h) * 4096) + pr; const float* A = WSP(float, WS_ATOT) + (size_t)b * 64 * 8 + h;
        float r0 = 0.f, r1 = 0.f;
        unsigned xa[16], xb[16]; float da[16], db[16];
#define SC_LD(X_, D_, c0) do { _Pragma("unroll") for (int i = 0; i < 16; ++i) { X_[i] = __builtin_nontemporal_load((const GAS unsigned*)(S + (size_t)((c0) + i) * 8 * 2048)); D_[i] = A[(size_t)((c0) + i) * 8]; } } while (0)
#define SC_PROC(X_, D_, c0) do { _Pragma("unroll") for (int i = 0; i < 16; ++i) { const unsigned pv = pk2(r0, r1); if constexpr (!DRY) *(GAS unsigned*)(S + (size_t)((c0) + i) * 8 * 2048) = pv; else asm volatile("" :: "v"(pv)); const float dd = fexp(D_[i]); r0 = r0 * dd + bflo(X_[i]); r1 = r1 * dd + bfhi(X_[i]); } } while (0)
        SC_LD(xa, da, 0);
        for (int c0 = 0; c0 < 64; c0 += 32) { SC_LD(xb, db, c0 + 16); SC_PROC(xa, da, c0); if (c0 + 32 < 64) SC_LD(xa, da, c0 + 32); SC_PROC(xb, db, c0 + 16); }
#undef SC_LD
#undef SC_PROC
        }
    }
}
#ifndef MK_X0
#define MK_X0 xcc_id()
#endif
#ifndef MK_UNEW_OUT
#define MK_UNEW_OUT WS_W2
#endif

typedef __bf16 bf16x2_t __attribute__((ext_vector_type(2)));
__device__ __forceinline__ float dot2bf(unsigned a, unsigned b, float c) { return __builtin_amdgcn_fdot2_f32_bf16(__builtin_bit_cast(bf16x2_t, a), __builtin_bit_cast(bf16x2_t, b), c, false); }
__device__ __forceinline__ void ins16(float (&top)[16], float x) {
#pragma unroll
    for (int i = 0; i < 16; ++i) { const float hi = __builtin_fmaxf(top[i], x); x = __builtin_fminf(top[i], x); top[i] = hi; }
}
#define CEX(a, b) do { const float hi_ = __builtin_fmaxf(a, b), lo_ = __builtin_fminf(a, b); a = hi_; b = lo_; } while (0)
__device__ __forceinline__ void sort16_desc(float (&v)[16]) {
#define S2(a, b) CEX(v[a], v[b])
    S2(0,13); S2(1,12); S2(2,15); S2(3,14); S2(4,8); S2(5,6); S2(7,11); S2(9,10);
    S2(0,5); S2(1,7); S2(2,9); S2(3,4); S2(6,13); S2(8,14); S2(10,15); S2(11,12);
    S2(0,1); S2(2,3); S2(4,5); S2(6,8); S2(7,9); S2(10,11); S2(12,13); S2(14,15);
    S2(0,2); S2(1,3); S2(4,10); S2(5,11); S2(6,7); S2(8,9); S2(12,14); S2(13,15);
    S2(1,2); S2(3,12); S2(4,6); S2(5,7); S2(8,10); S2(9,11); S2(13,14);
    S2(1,4); S2(2,6); S2(5,8); S2(7,10); S2(9,13); S2(11,14);
    S2(2,4); S2(3,6); S2(9,12); S2(11,13);
    S2(3,5); S2(6,8); S2(7,9); S2(10,12);
    S2(3,4); S2(5,6); S2(7,8); S2(9,10); S2(11,12);
    S2(6,7); S2(8,9);
#undef S2
}
__device__ __forceinline__ void merge16_desc(float (&a)[16], const float (&b)[16]) {
#pragma unroll
    for (int i = 0; i < 16; ++i) a[i] = __builtin_fmaxf(a[i], b[15 - i]);
#pragma unroll
    for (int j = 8; j > 0; j >>= 1)
#pragma unroll
        for (int i = 0; i < 16; ++i) { const int l = i ^ j; if (l > i) CEX(a[i], a[l]); }
}
__device__ __forceinline__ void top16_half(float (&top)[16], const _Float16* base) {
#pragma unroll 1
    for (int g0 = 0; g0 < 8; ++g0) { float x[16];
#pragma unroll
        for (int i = 0; i < 16; ++i) x[i] = (float)__builtin_nontemporal_load((const GAS _Float16*)(base + (size_t)(16 * g0 + i) * TT));
#pragma unroll
        for (int i = 0; i < 16; ++i) x[i] = __builtin_bit_cast(float, (__builtin_bit_cast(unsigned, x[i]) & ~127u) | (unsigned)(16 * g0 + i));
        sort16_desc(x);
        if (g0 == 0) {
#pragma unroll
            for (int i = 0; i < 16; ++i) top[i] = x[i];
        } else merge16_desc(top, x);
    }
}
__device__ __forceinline__ float mkc(float a, float b, unsigned code) { return __builtin_bit_cast(float, (__builtin_bit_cast(unsigned, a + b) & ~255u) | code); }
constexpr int PL_SELB = 0, PL_IDX = 16384, PL_GATE = 32768;
constexpr int CW_PEER = 8192;
__device__ __forceinline__ unsigned xcc_id() { return (unsigned)__builtin_amdgcn_s_getreg((3 << 11) | 20) & 7u; }
__device__ __forceinline__ float row_rstd(const float* ssq, size_t tok) { const f32x4 a = *(const GAS f32x4*)(ssq + tok * 16), b = *(const GAS f32x4*)(ssq + tok * 16 + 4), c = *(const GAS f32x4*)(ssq + tok * 16 + 8), d = *(const GAS f32x4*)(ssq + tok * 16 + 12);
    const f32x4 s = (a + b) + (c + d); return frsq(((s.x + s.y) + (s.z + s.w)) * (1.f / DM) + EPS); }
__device__ __forceinline__ void p_select(Frame& F, int l) {
    LAS unsigned* selb = (LAS unsigned*)(F.lds + PL_SELB); LAS unsigned short* idxl = (LAS unsigned short*)(F.lds + PL_IDX); LAS float* gatel = (LAS float*)(F.lds + PL_GATE);
    const int lane = F.lane, w = F.wave;
    for (int st_ = 0; st_ < 2; ++st_) { const bool enc_ = (st_ == 0) == (MK_PAR_SEL ? (F.vcu & 1) != 0 : false); asm volatile("" ::: "memory");
    if (enc_) { if (!(MK_U8_EARLY && MK_UCOL) || l == 0) for (int q_ = 0; q_ < (MK_REPEAT_SP == 13 ? 2 : 1); ++q_) tables_items<false>(F, l, (size_t)F.vcu * 512 + F.tid, (size_t)F.G * 512);
                if (!MK_V8_IN_U) tables_items<true>(F, l, (size_t)F.vcu * 512 + F.tid, (size_t)F.G * 512); }
    else for (int q2_ = 0; q2_ < (MK_REPEAT_SP == 15 ? 2 : 1); ++q2_) for (int blk = F.vcu; blk < TT / 64; blk += F.G) {
        const int t0 = blk * 64;
        __syncthreads();
        {
            float t1[16], t2[16], fin[16];
            const _Float16* sb = WSP(_Float16, WS_ST) + (size_t)(w * 256) * TT + t0 + lane;
            top16_half(t1, sb); top16_half(t2, sb + (size_t)128 * TT);
            LAS unsigned* mys = selb + (w * 64 + lane) * 8;
#pragma unroll
            for (int q = 0; q < 4; ++q) { unsigned a = 0, b = 0;
#pragma unroll
                for (int i = 0; i < 4; ++i) { a |= (__builtin_bit_cast(unsigned, t1[4 * q + i]) & 127u) << (8 * i); b |= (__builtin_bit_cast(unsigned, t2[4 * q + i]) & 127u) << (8 * i); }
                mys[q] = a; mys[4 + q] = b; }
#pragma unroll
            for (int j = 0; j < 16; ++j) fin[j] = mkc(t1[0], t2[j], (unsigned)j);
#pragma unroll
            for (int i = 1; i < 16; ++i)
#pragma unroll
                for (int j = 0; j < 16; ++j) if ((i + 1) * (j + 1) <= 16) ins16(fin, mkc(t1[i], t2[j], (unsigned)(i * 16 + j)));
            float m = fin[0];
#pragma unroll
            for (int r = 1; r < 16; ++r) m = __builtin_fmaxf(m, fin[r]);
            float ex[16], sum = 0.f;
            const float rs_ = row_rstd(WSP(float, WS_SSQ), (size_t)t0 + lane);
#pragma unroll
            for (int r = 0; r < 16; ++r) { ex[r] = fexp((fin[r] - m) * rs_); sum += ex[r]; }
            if (w == 0) WSP(float, WS_RSTD)[t0 + lane] = rs_;
            const float inv = frcp(sum);
            LDS_WAIT();
            const LAS unsigned char* myb = (const LAS unsigned char*)mys;
#pragma unroll
            for (int r = 0; r < 16; ++r) { const unsigned code = __builtin_bit_cast(unsigned, fin[r]) & 255u; const unsigned i1 = myb[code >> 4], i2 = myb[16 + (code & 15u)];
                idxl[lane * 128 + w * 16 + r] = (unsigned short)(i1 * 128u + i2); gatel[lane * 128 + w * 16 + r] = ex[r] * inv; }
        }
        __syncthreads();
        for (int e = F.tid; e < 1024; e += 512) *(GAS v4u*)(WSP(unsigned char, WS_IDX) + (size_t)t0 * 256 + e * 16) = *(const LAS v4u*)((const LAS unsigned char*)idxl + e * 16);
        for (int e = F.tid; e < 2048; e += 512) *(GAS v4u*)(WSP(unsigned char, WS_W) + (size_t)t0 * 512 + e * 16) = *(const LAS v4u*)((const LAS unsigned char*)gatel + e * 16);
    }
    __syncthreads(); }
}
__device__ __forceinline__ void cvt16(v4u p, float* v) {
    const unsigned wds[4] = {p.x, p.y, p.z, p.w};
#pragma unroll
    for (int q = 0; q < 4; ++q) { const f32x2 lo = __builtin_amdgcn_cvt_pk_f32_fp8((int)wds[q], false), hi = __builtin_amdgcn_cvt_pk_f32_fp8((int)wds[q], true); v[4 * q] = lo.x; v[4 * q + 1] = lo.y; v[4 * q + 2] = hi.x; v[4 * q + 3] = hi.y; }
}
__device__ __forceinline__ unsigned peer_ticket(Frame& F, int cw, unsigned x) { unsigned t = 0; if (F.lane == 0) t = __hip_atomic_fetch_add((gu32*)(F.ap->ws + WS_CTL) + cw + x * 64, 1u, RLX_AGENT); return t; }
typedef __bf16 bf16x2v __attribute__((ext_vector_type(2)));
template <bool DRY> __device__ __forceinline__ void p_peer_u2(Frame& F, int l, int cset = 0) {
    constexpr int TPT = 8, NTASK = TT / TPT;
    LAS unsigned char* wl = F.lds + F.wave * 6144;
    LAS unsigned short* idxT = (LAS unsigned short*)wl;
    LAS unsigned char* hT = wl + 2048;
    const int lane = F.lane, g = lane >> 3, c = lane & 7;
    const unsigned char* U8 = (const unsigned char*)F.ap->ws + ((MK_U8_EARLY && l == 1) ? WS_WIN : WS_U8);
    const unsigned x0 = MK_X0; const int cw = CW_PEER + ((DRY ? 4 : cset) + l * 2 + 0) * 8 * 64;
    const int wdst = ((2 * lane) & 7) * 16 + (lane >> 2);
    if constexpr (!DRY && MK_V8_IN_U) { if (F.wave >= NWAVES - 2) tables_items<true>(F, l, ((size_t)F.vcu * 2 + (F.wave - (NWAVES - 2))) * 64 + lane, (size_t)F.G * 2 * 64); }
    for (unsigned so = 0; so < 8; ++so) { const unsigned x = (x0 + so) & 7u;
      unsigned cur = (unsigned)__builtin_amdgcn_readfirstlane((int)peer_ticket(F, cw, x));
      while (cur < (unsigned)NTASK) {
        const unsigned nxtv = peer_ticket(F, cw, x);
        const size_t tk0 = (size_t)cur * TPT;
        { unsigned pr[TPT];
#pragma unroll
          for (int k = 0; k < TPT; ++k) pr[k] = *(const GAS unsigned*)(WSP(unsigned, WS_IDX) + (tk0 + k) * 64 + lane);
          const bf16* hp = WSP(bf16, WS_XW) + (tk0 + g) * DM + 128 * (int)x + 16 * c;
          const v4u h0 = *(const GAS v4u*)hp, h1 = *(const GAS v4u*)(hp + 8);
#pragma unroll
          for (int k = 0; k < TPT; ++k) { idxT[k * 128 + wdst] = (unsigned short)(pr[k] & 0xffffu); idxT[k * 128 + wdst + 16] = (unsigned short)(pr[k] >> 16); }
          *(LAS v4u*)(hT + lane * 32) = h0; *(LAS v4u*)(hT + lane * 32 + 16) = h1; }
        LDS_WAIT();
        v4u rA[8], rB[8];
        float* pbase = WSP(float, WS_UP) + (tk0 * 8 + x) * 128 + 2 * lane;
        const unsigned char* ubase = U8 + (size_t)x * (16384 * 128) + 16 * c;
#define PU2_ISSUE(R, k, ih) do { const v4u iq = *(const LAS v4u*)(idxT + (k) * 128 + g * 16 + 8 * (ih)); const unsigned iw[4] = {iq.x, iq.y, iq.z, iq.w}; \
            _Pragma("unroll") for (int i = 0; i < 8; ++i) { const unsigned e = (i & 1) ? (iw[i >> 1] >> 16) : (iw[i >> 1] & 0xffffu); R[i] = *(const GAS v4u*)(ubase + (size_t)e * 128); } } while (0)
#define PU2_DOT(R, ih) do { _Pragma("unroll") for (int i = 0; i < 8; ++i) { const unsigned rq[4] = {R[i].x, R[i].y, R[i].z, R[i].w}; f32x2 a2 = {0.f, 0.f}; \
                _Pragma("unroll") for (int q = 0; q < 4; ++q) { a2 = __builtin_elementwise_fma(__builtin_amdgcn_cvt_pk_f32_fp8((int)rq[q], false), h2[2 * q], a2); a2 = __builtin_elementwise_fma(__builtin_amdgcn_cvt_pk_f32_fp8((int)rq[q], true), h2[2 * q + 1], a2); } \
                s[8 * (ih) + i] = a2[0] + a2[1]; } } while (0)
        PU2_ISSUE(rA, 0, 0);
#pragma unroll 1
        for (int k = 0; k < TPT; ++k) {
            PU2_ISSUE(rB, k, 1);
            f32x2 h2[8];
            { const v4u h0 = *(const LAS v4u*)(hT + (k * 8 + c) * 32), h1 = *(const LAS v4u*)(hT + (k * 8 + c) * 32 + 16); const unsigned hw[8] = {h0.x, h0.y, h0.z, h0.w, h1.x, h1.y, h1.z, h1.w};
#pragma unroll
              for (int q = 0; q < 8; ++q) h2[q] = (f32x2){bflo(hw[q]), bfhi(hw[q])}; }
            float s[16];
            PU2_DOT(rA, 0);
            if (k + 1 < TPT) PU2_ISSUE(rA, k + 1, 0);
            PU2_DOT(rB, 1);
#pragma unroll
            for (int i = 0; i < 8; ++i) s[i] = hsum4(s[i], s[i + 8], (lane & 4) != 0);
#pragma unroll
            for (int i = 0; i < 4; ++i) s[i] = hsum2(s[i], s[i + 4], (lane & 2) != 0);
#pragma unroll
            for (int i = 0; i < 2; ++i) s[i] = hsum1(s[i], s[i + 2], (lane & 1) != 0);
            const unsigned long long po = (unsigned long long)__builtin_bit_cast(unsigned, s[0]) | ((unsigned long long)__builtin_bit_cast(unsigned, s[1]) << 32);
            if constexpr (!DRY) *(GAS unsigned long long*)(pbase + (size_t)k * 1024) = po; else asm volatile("" :: "v"(po));
        }
#undef PU2_ISSUE
#undef PU2_DOT
        LDS_WAIT();
        cur = (unsigned)__builtin_amdgcn_readfirstlane((int)nxtv);
      } }
}
template <bool DRY> __device__ __forceinline__ void p_reduce_u(Frame& F) {
    const int gw = F.vcu * NWAVES + F.wave, NGW = F.G * NWAVES, lane = F.lane;
    const int p0 = 2 * lane, j0 = 8 * (p0 & 15) + (p0 >> 4), j1 = j0 + 8;
    for (int tb = gw * 4; tb < TT; tb += NGW * 4) {
        f32x2 v[4][8]; float g0[4], g1[4], rs[4];
#pragma unroll
        for (int q = 0; q < 4; ++q) { const size_t t = (size_t)tb + q;
#pragma unroll
            for (int x = 0; x < 8; ++x) v[q][x] = *(const GAS f32x2*)(WSP(float, WS_UP) + (t * 8 + x) * 128 + p0);
            g0[q] = WSP(float, WS_W)[t * 128 + j0]; g1[q] = WSP(float, WS_W)[t * 128 + j1]; rs[q] = WSP(float, WS_RSTD)[t]; }
#pragma unroll
        for (int q = 0; q < 4; ++q) { const size_t t = (size_t)tb + q;
            const f32x2 sm = ((v[q][0] + v[q][1]) + (v[q][2] + v[q][3])) + ((v[q][4] + v[q][5]) + (v[q][6] + v[q][7]));
            const float sc = rs[q] * (1.0f / 256.0f); const float w0 = g0[q] * geluf_(sm[0] * sc), w1 = g1[q] * geluf_(sm[1] * sc);
            const unsigned long long wo = (unsigned long long)__builtin_bit_cast(unsigned, w0) | ((unsigned long long)__builtin_bit_cast(unsigned, w1) << 32);
            if constexpr (!DRY) *(GAS unsigned long long*)(WSP(float, WS_W2) + t * 128 + p0) = wo; else asm volatile("" :: "v"(wo)); }
    }
}
template <bool DRY> __device__ __forceinline__ void p_peer_v(Frame& F, int l) {
    constexpr int TPT = 8, NTASK = TT / TPT;
    LAS unsigned char* wl = F.lds + F.wave * 6144;
    LAS unsigned short* idxT = (LAS unsigned short*)wl;
    LAS float* wT = (LAS float*)(wl + 2048);
    const int lane = F.lane, g = lane >> 3, c = lane & 7;
    const unsigned char* V8 = WSP(unsigned char, WS_V8);
    const unsigned x0 = MK_X0; const int cw = CW_PEER + ((DRY ? 4 : 0) + l * 2 + 1) * 8 * 64;
    const int colo = 16 * c + ((lane >> 5) & 1) * 8 + ((lane >> 4) & 1) * 4 + ((lane >> 3) & 1) * 2;
    const int wdst = ((2 * lane) & 7) * 16 + (lane >> 2);
    if constexpr (!DRY && MK_U8_EARLY && MK_UCOL) { if (l == 0 && F.wave >= NWAVES - 2) tables_items<false>(F, 1, ((size_t)F.vcu * 2 + (F.wave - (NWAVES - 2))) * 64 + lane, (size_t)F.G * 2 * 64, WS_WIN); }
    if constexpr (!DRY && MK_W1_LATE) { if (l == 0 && F.wave >= NWAVES - 2) { LAS float* scr = (LAS float*)(F.lds + 65536 + (F.wave - (NWAVES - 2)) * 16640);
        for (int it = F.vcu * 2 + (F.wave - (NWAVES - 2)); it < WT_PER_LAYER; it += F.G * 2) wt_item(F, 1, it, scr); } }
    for (unsigned so = 0; so < 8; ++so) { const unsigned x = (x0 + so) & 7u;
      unsigned cur = (unsigned)__builtin_amdgcn_readfirstlane((int)peer_ticket(F, cw, x));
      while (cur < (unsigned)NTASK) {
        const unsigned nxtv = peer_ticket(F, cw, x);
        const size_t tk0 = (size_t)cur * TPT;
        { unsigned pr[TPT]; unsigned long long wv[TPT];
#pragma unroll
          for (int k = 0; k < TPT; ++k) { pr[k] = *(const GAS unsigned*)(WSP(unsigned, WS_IDX) + (tk0 + k) * 64 + lane); wv[k] = *(const GAS unsigned long long*)(WSP(float, WS_W2) + (tk0 + k) * 128 + 2 * lane); }
#pragma unroll
          for (int k = 0; k < TPT; ++k) { idxT[k * 128 + wdst] = (unsigned short)(pr[k] & 0xffffu); idxT[k * 128 + wdst + 16] = (unsigned short)(pr[k] >> 16);
              if (MK_UCOL) *(LAS unsigned long long*)(wT + k * 128 + 2 * lane) = wv[k];
              else { wT[k * 128 + wdst] = __builtin_bit_cast(float, (unsigned)wv[k]); wT[k * 128 + wdst + 16] = __builtin_bit_cast(float, (unsigned)(wv[k] >> 32)); } } }
        LDS_WAIT();
        v4u rA[8], rB[8]; unsigned xv; f32x2 acc2[8];
        bf16* xbase = WSP(bf16, WS_XB) + tk0 * DM + 128 * (int)x + colo;
        float w1a = 0.f, w1b = 0.f; if (l == 0) { const float* wp_ = F.ap->in[I_N1] + DM + 128 * (int)x + colo; w1a = wp_[0]; w1b = wp_[1]; }
        const unsigned char* vbase = V8 + (size_t)x * (16384 * 128) + 16 * c;
#define PV_ISSUE(R, k, ih) do { const v4u iq = *(const LAS v4u*)(idxT + (k) * 128 + g * 16 + 8 * (ih)); const unsigned iw[4] = {iq.x, iq.y, iq.z, iq.w}; \
            _Pragma("unroll") for (int i = 0; i < 8; ++i) { const unsigned e = (i & 1) ? (iw[i >> 1] >> 16) : (iw[i >> 1] & 0xffffu); R[i] = *(const GAS v4u*)(vbase + (size_t)e * 128); } } while (0)
#define PV_ACC(R, k, ih) do { const f32x4 wq0 = *(const LAS f32x4*)(wT + (k) * 128 + g * 16 + 8 * (ih)), wq1 = *(const LAS f32x4*)(wT + (k) * 128 + g * 16 + 8 * (ih) + 4); \
            const float wa[8] = {wq0.x, wq0.y, wq0.z, wq0.w, wq1.x, wq1.y, wq1.z, wq1.w}; \
            _Pragma("unroll") for (int i = 0; i < 8; ++i) { const f32x2 w2 = {wa[i], wa[i]}; const unsigned rq[4] = {R[i].x, R[i].y, R[i].z, R[i].w}; \
                _Pragma("unroll") for (int q = 0; q < 4; ++q) { acc2[2 * q] = __builtin_elementwise_fma(__builtin_amdgcn_cvt_pk_f32_fp8((int)rq[q], false), w2, acc2[2 * q]); \
                                                               acc2[2 * q + 1] = __builtin_elementwise_fma(__builtin_amdgcn_cvt_pk_f32_fp8((int)rq[q], true), w2, acc2[2 * q + 1]); } } } while (0)
        PV_ISSUE(rA, 0, 0);
#pragma unroll 1
        for (int k = 0; k < TPT; ++k) {
            PV_ISSUE(rB, k, 1); xv = *(const GAS unsigned*)(xbase + (size_t)k * DM);
#pragma unroll
            for (int q = 0; q < 8; ++q) acc2[q] = (f32x2){0.f, 0.f};
            PV_ACC(rA, k, 0);
            if (k + 1 < TPT) PV_ISSUE(rA, k + 1, 0);
            PV_ACC(rB, k, 1);
            float acc[16];
#pragma unroll
            for (int q = 0; q < 8; ++q) { acc[2 * q] = acc2[q][0]; acc[2 * q + 1] = acc2[q][1]; }
#pragma unroll
            for (int i = 0; i < 8; ++i) acc[i] = hsum32(acc[i], acc[i + 8]);
#pragma unroll
            for (int i = 0; i < 4; ++i) acc[i] = hsum16(acc[i], acc[i + 4]);
#pragma unroll
            for (int i = 0; i < 2; ++i) acc[i] = hsum8(acc[i], acc[i + 2], (lane & 8) != 0);
            const float o0 = bflo(xv) + acc[0] * (1.0f / 32.0f), o1 = bfhi(xv) + acc[1] * (1.0f / 32.0f);
            const unsigned xo = pk2(o0, o1);
            if constexpr (!DRY) *(GAS unsigned*)(xbase + (size_t)k * DM) = xo; else asm volatile("" :: "v"(xo));
            if (l == 0) { const unsigned yw = pk2(o0 * w1a, o1 * w1b); const float ss = wave_sum(o0 * o0 + o1 * o1, lane);
                if constexpr (!DRY) { *(GAS unsigned*)(XNP + (tk0 + k) * DM + 128 * (int)x + colo) = yw; if (lane == 0) WSP(float, WS_SSQ1)[(tk0 + k) * 8 + x] = ss; } else asm volatile("" :: "v"(yw), "v"(ss)); }
        }
#undef PV_ISSUE
#undef PV_ACC
        LDS_WAIT();
        cur = (unsigned)__builtin_amdgcn_readfirstlane((int)nxtv);
      } }
}
template <bool DRY> __device__ __forceinline__ void p_rownorm(Frame& F, int l, bool last) {
    const int gw = F.vcu * NWAVES + F.wave, NGW = F.G * NWAVES;
    const bf16* X = WSP(bf16, WS_XB);
    v2u nx[4];
    { const GAS v2u* x0 = (const GAS v2u*)(X + (size_t)gw * DM) + F.lane;
#pragma unroll
      for (int j = 0; j < 4; ++j) nx[j] = x0[64 * j]; }
    for (int m = gw; m < TT; m += NGW) {
        GAS f32x4* xr = (GAS f32x4*)(F.ap->out + (size_t)m * DM) + F.lane;
        f32x4 v[4];
#pragma unroll
        for (int j = 0; j < 4; ++j) v[j] = (f32x4){bflo(nx[j].x), bfhi(nx[j].x), bflo(nx[j].y), bfhi(nx[j].y)};
        if (m + NGW < TT) { const GAS v2u* xn_ = (const GAS v2u*)(X + (size_t)(m + NGW) * DM) + F.lane;
#pragma unroll
            for (int j = 0; j < 4; ++j) nx[j] = xn_[64 * j]; }
        float s = 0.f;
#pragma unroll
        for (int j = 0; j < 4; ++j) s += (v[j].x * v[j].x + v[j].y * v[j].y) + (v[j].z * v[j].z + v[j].w * v[j].w);
        const float rstd = frsq(wave_sum(s, F.lane) * (1.f / DM) + EPS);
#pragma unroll
        for (int j = 0; j < 4; ++j) { const f32x4 wv = *(const GAS f32x4*)(F.ap->in[I_FN] + 4 * F.lane + 256 * j); const f32x4 ov = v[j] * rstd * wv; if constexpr (!DRY) xr[64 * j] = ov; else asm volatile("" :: "v"(ov)); }
    }
    __syncthreads();
}

#ifndef MK_PHASE_MASK
#define MK_PHASE_MASK 0x3ff
#endif
#ifndef MK_DBLBAR
#define MK_DBLBAR 0
#endif
#ifndef MK_SP2
#define MK_SP2 true
#endif
#ifndef MK_REPEAT_SP
#define MK_REPEAT_SP -1
#endif
#ifndef MK_MIX_SUB
#define MK_MIX_SUB 7
#endif
#define MIXS(k) ((MK_MIX_SUB >> (k)) & 1)
#define REP(k) (MK_REPEAT_SP == (k))
#define PHM(k) ((MK_PHASE_MASK >> (k)) & 1)
#ifndef MK_STOP_PHASE
#define MK_STOP_PHASE (22 + 2 * MK_UCOL)
#endif
constexpr int N_PHASES = MK_STOP_PHASE;
#define MK_LAUNDER() do { { KArgs ap = (KArgs)__builtin_amdgcn_kernarg_segment_ptr(); asm volatile("" : "+s"(ap)); F.ap = ap; } { int w0 = wave0; asm volatile("" : "+s"(w0)); int ln; asm volatile("v_mbcnt_lo_u32_b32 %0, -1, 0\n\tv_mbcnt_hi_u32_b32 %0, -1, %0" : "=v"(ln)); F.wave = w0; F.lane = ln; F.tid = w0 * 64 + ln; } { int G = gridDim.x, bx = blockIdx.x; asm volatile("" : "+s"(G), "+s"(bx)); F.G = G; F.vcu = (G % 8 == 0) ? (bx % 8) * (G / 8) + bx / 8 : bx; F.bx = bx; } { LAS unsigned char* lp = (LAS unsigned char*)lds; asm volatile("" : "+s"(lp)); F.lds = lp; } } while (0)
__global__ void __launch_bounds__(NWAVES * 64, 2) fwd_kernel(Args args) {
    extern __shared__ __attribute__((aligned(16))) unsigned char lds[];
    Frame F;
#if MK_BARRIER == 1
    { LAS unsigned* z = (LAS unsigned*)((LAS unsigned char*)lds + LDSCTL_OFF); for (int u = threadIdx.x; u < (LDS_BYTES - LDSCTL_OFF) / 4; u += NWAVES * 64) z[u] = 0u; }
    __syncthreads();
    const int wave0 = __builtin_amdgcn_readfirstlane((int)threadIdx.x >> 6);
    (void)xcd_barrier_post((unsigned*)(args.ws + WS_CTL) + CW_BAR, (volatile LAS unsigned*)((LAS unsigned char*)lds + MISC_OFF) + 8, (int)threadIdx.x);
#endif
    int rep_ph = -1;
    for (int ph = args.ph_lo; ph < args.ph_hi; ++ph) {
        MK_LAUNDER();
        {
        if (ph == 0) { if (PHM(0)) for (int r_ = 0; r_ < (REP(12) ? 2 : 1); ++r_) p0_prologue(F); }
        else {
            constexpr int NS0 = 10 + MK_UCOL;
            const int l = (ph - 1) >= NS0 ? 1 : 0; int sp = (ph - 1) - NS0 * l; if (sp >= 6) ++sp;
            if (MK_UCOL) { if (sp == 10) sp = 12; else if (sp > 10) --sp; }
            if (sp == 0) { if (PHM(1)) {
                LAS float* rsl = (LAS float*)(F.lds + RING_BYTES); const int xg = F.bx & 7;
                for (int r = F.tid; r < 2048; r += 512) { float v = 1.f;
                    if (l > 0) { const float* pp = WSP(float, WS_SSQ1) + ((size_t)xg * 2048 + r) * 8; const f32x4 a = *(const GAS f32x4*)pp, b = *(const GAS f32x4*)(pp + 4); v = frsq((((a.x + a.y) + (a.z + a.w)) + ((b.x + b.y) + (b.z + b.w))) * (1.f / DM) + EPS); }
                    rsl[r] = v; }
                __syncthreads();
                pg8::Gemm g{XNP, WSP(bf16, WS_WIN + (size_t)l * 16 * MiB), TT, NP + 256, DM}; pg8::StaticOrder S; S.init(TT, NP + 256, F.G, F.bx);
                pg8::EpiProj E{WSP(bf16, WS_PROJ), NP, WSP(float, WS_DT), rsl, (F.G % 8 == 0) ? xg : -1, WSP(float, WS_SSQ1), l > 0};
                pg8::gemm_phase<pg8::EpiProj, pg8::StaticOrder, true, MK_SP2>(F.lds, g, S, E, F.tid);
            } } else if (sp == 1) { if (PHM(2)) {
                for (int r_ = 0; r_ < (REP(1) ? 2 : 1); ++r_)
                { const bool odd_ = MK_PAR_MIX1 && (F.vcu & 1) != 0;
                  if (odd_) { for (int q_ = 0; q_ < (MK_REPEAT_SP == 22 ? 2 : 1); ++q_) p_sb_attn(F); __syncthreads(); }
                  MK_LAUNDER();
                  for (int q_ = 0; q_ < (MK_REPEAT_SP == 20 ? 2 : 1); ++q_) for (int u = F.vcu; u < 1024; u += F.G) hg_local_unit(F, l, u >> 9, (u >> 7) & 3, u & 127);
                  for (int q_ = 0; q_ < (MK_REPEAT_SP == 21 ? 2 : 1); ++q_) for (int u = F.vcu; u < 256; u += F.G) ssd_local_unit(F, l, u >> 7, (u >> 1) & 63, u & 1);
                  MK_LAUNDER();
                  if (!odd_) { __syncthreads(); for (int q_ = 0; q_ < (MK_REPEAT_SP == 22 ? 2 : 1); ++q_) p_sb_attn(F); } }
            } } else if (sp == 2) { if (PHM(3)) {
                if (REP(2)) p_scan<true>(F);
                p_scan<false>(F);
            } } else if (sp == 3) { if (PHM(4)) {
                for (int r_ = 0; r_ < (REP(3) ? 2 : 1); ++r_) {
                hg_out_units(F, l, F.vcu, F.G);
                for (int u = F.vcu; u < 256; u += F.G) ssd_out_unit(F, l, u >> 7, (u >> 1) & 63, u & 1); }
            } } else if (sp == 4) { if (PHM(5)) {
                pg8::Gemm g{WSP(bf16, WS_Y), WSP(bf16, WS_WBR + (size_t)l * 3 * MiB), 3 * TT, 3 * DM, 512}; pg8::MergeOrder S{F.vcu, F.G};
                pg8::EpiMerge2 E{WSP(bf16, WS_PROJ) + C_GATE, NP, XNP, DM};
                pg8::gemm_phase<pg8::EpiMerge2, pg8::MergeOrder, true, MK_SP2>(F.lds, g, S, E, F.tid);
            } } else if (sp == 5) { if (PHM(6)) {
                pg8::Gemm g{XNP, WSP(bf16, WS_WOUT + (size_t)l * 2 * MiB), TT, DM, DM}; pg8::StaticOrder S; S.init(TT, DM, F.G, F.bx);
                if (l == 0) { pg8::EpiResNorm<true> E{F.ap->in[I_X], WSP(bf16, WS_XB), DM, F.ap->in[I_N2] + (size_t)l * DM, WSP(bf16, WS_XW), WSP(float, WS_SSQ)};
                    pg8::gemm_phase<pg8::EpiResNorm<true>, pg8::StaticOrder, true, MK_SP2>(F.lds, g, S, E, F.tid); }
                else { pg8::EpiResNorm<false> E{WSP(bf16, WS_XB), WSP(bf16, WS_XB), DM, F.ap->in[I_N2] + (size_t)l * DM, WSP(bf16, WS_XW), WSP(float, WS_SSQ)};
                    pg8::gemm_phase<pg8::EpiResNorm<false>, pg8::StaticOrder, true, MK_SP2>(F.lds, g, S, E, F.tid); }
            } } else if (sp == 7) { if (PHM(8)) {
                pg8::Gemm g{WSP(bf16, WS_WEFF + (size_t)l * 4 * MiB), WSP(bf16, WS_XW), 2048, TT, DM}; pg8::StaticOrder S; S.init(2048, TT, F.G, F.bx);
                pg8::EpiF16 E{WSP(_Float16, WS_ST), TT};
                pg8::gemm_phase<pg8::EpiF16, pg8::StaticOrder, true, MK_SP2>(F.lds, g, S, E, F.tid);
            } } else if (sp == 8) { if (PHM(9)) for (int r_ = 0; r_ < (REP(8) ? 2 : 1); ++r_) p_select(F, l);
            } else if (sp == 12) { if (PHM(9)) { if (REP(14)) p_reduce_u<true>(F); p_reduce_u<false>(F); }
            } else if (sp == 9 && MK_UCOL) { if (PHM(9) && MIXS(0)) { if (REP(9)) p_peer_u2<true>(F, l); if (REP(16)) p_peer_u2<false>(F, l, 4); p_peer_u2<false>(F, l); }
            } else if (sp == 10) { if (PHM(9) && MIXS(1)) { if (REP(10)) p_peer_v<true>(F, l); p_peer_v<false>(F, l); }
            } else { if (PHM(9)) { if (REP(11)) p_rownorm<true>(F, l, true); p_rownorm<false>(F, l, true); }
            }
        }
        }
        if ((MK_REPEAT_SP == 0 || MK_REPEAT_SP == 4 || MK_REPEAT_SP == 7) && ph > 0 && (((ph - 1) >= 10 + MK_UCOL ? ph - 11 - MK_UCOL : ph - 1) + ((((ph - 1) >= 10 + MK_UCOL ? ph - 11 - MK_UCOL : ph - 1)) >= 6 ? 1 : 0)) == MK_REPEAT_SP && rep_ph != ph) { rep_ph = ph; --ph; __syncthreads(); continue; }
#if MK_BARRIER == 1
        if (ph + 1 < args.ph_hi) { if (args.ph_hi - args.ph_lo == 2) cg::this_grid().sync();
            else { XcdBarrier bar; bar.bar = (unsigned*)(F.ap->ws + WS_CTL) + CW_BAR; bar.x = xb_xcc_id(); bar.st = (volatile LAS unsigned*)((LAS unsigned char*)lds + MISC_OFF) + 8; xcd_barrier(bar, F.tid); if (MK_DBLBAR) xcd_barrier(bar, F.tid); } }
#else
        if (ph + 1 < args.ph_hi) cg::this_grid().sync();
#endif
    }
}

extern "C" void kernel_launch(void* const* d_in, const int* in_sizes, int n_in, void* d_out, int out_size, void* d_ws, size_t ws_size, hipStream_t stream) {
    static int grid = 0;
    if (grid == 0) {
        if (n_in != 21 || out_size != TT * DM || ws_size < WS_END) { fprintf(stderr, "kernel_launch: unexpected shapes (n_in %d out %d ws %zu)\n", n_in, out_size, ws_size); grid = -1; return; }
        int dev = 0, cus = 0, per_cu = 0;
        if (hipGetDevice(&dev) != hipSuccess || hipDeviceGetAttribute(&cus, hipDeviceAttributeMultiprocessorCount, dev) != hipSuccess) { grid = -1; return; }
        if (hipFuncSetAttribute((const void*)fwd_kernel, hipFuncAttributeMaxDynamicSharedMemorySize, LDS_BYTES) != hipSuccess) { fprintf(stderr, "kernel_launch: hipFuncSetAttribute failed\n"); grid = -1; return; }
        if (hipOccupancyMaxActiveBlocksPerMultiprocessor(&per_cu, (const void*)fwd_kernel, NWAVES * 64, LDS_BYTES) != hipSuccess || per_cu < 1) { fprintf(stderr, "kernel_launch: occupancy query says %d\n", per_cu); (void)hipGetLastError(); per_cu = 1; }
        grid = cus;
        if (grid > 256) grid = 256;
    }
    if (grid < 0) return;
#if MK_BARRIER == 1
    if (hipMemsetAsync((char*)d_ws + WS_CTL, 0, CTL_ZERO_BYTES, stream) != hipSuccess) { fprintf(stderr, "kernel_launch: memset failed\n"); return; }
#endif
    Args a{};
    for (int i = 0; i < 21; ++i) a.in[i] = (const float*)d_in[i];
    a.out = (float*)d_out; a.ws = (unsigned char*)d_ws;
#if MK_N_LAUNCHES == 1
    a.ph_lo = 0; a.ph_hi = N_PHASES;
    void* kargs[] = {&a};
    hipError_t e = hipLaunchCooperativeKernel((const void*)fwd_kernel, dim3(grid), dim3(NWAVES * 64), kargs, LDS_BYTES, stream);
    if (e != hipSuccess) fprintf(stderr, "kernel_launch: cooperative launch failed: %s (grid %d)\n", hipGetErrorString(e), grid);
#else
    for (int ph = 0; ph < N_PHASES; ++ph) { a.ph_lo = ph; a.ph_hi = ph + 1;
        hipLaunchKernelGGL(fwd_kernel, dim3(grid), dim3(NWAVES * 64), LDS_BYTES, stream, a); }
#ifdef MK_DIAG
    a.ph_lo = MK_DIAG; a.ph_hi = MK_DIAG + 1; hipLaunchKernelGGL(fwd_kernel, dim3(grid), dim3(NWAVES * 64), LDS_BYTES, stream, a);
#endif
#endif
}
```

```cpp
#include <hip/hip_runtime.h>
#include <hip/hip_cooperative_groups.h>
#include <cstdio>
#include <cstdint>
namespace cg = cooperative_groups;

#ifndef MK_N_LAUNCHES
#define MK_N_LAUNCHES 1
#ifndef MK_REPEAT_SP
#define MK_REPEAT_SP -1
#endif
#endif
#ifndef MK_PAR_MIX1
#define MK_PAR_MIX1 0
#endif
#ifndef MK_PAR_SEL
#define MK_PAR_SEL 0
#endif
#ifndef MK_V8_IN_U
#define MK_V8_IN_U 1
#endif
#ifndef MK_UCOL
#define MK_UCOL 1
#endif
#ifndef MK_U8_EARLY
#define MK_U8_EARLY 0
#endif
#ifndef MK_W1_LATE
#define MK_W1_LATE 0
#endif
#ifndef MK_WT_STORES
#define MK_WT_STORES 1
#endif
#ifndef MK_BARRIER
#define MK_BARRIER 1
#endif

constexpr int TT = 16384;
constexpr int SEQ = 8192;
constexpr int DM = 1024;
constexpr int NP = 7936;
constexpr int C_SBQ = 0, C_SBK = 512, C_SBV = 1024, C_HGF = 1536, C_HGQ = 2048, C_HGI = 2560, C_HGG = 3072, C_SSDZ = 3584, C_XBC = 4096, C_GATE = 4864;
constexpr int W_IN_COLS = 7944, W_DT_COL = 4864, W_GATE_COL = 4872;
constexpr float EPS = 1e-6f;

constexpr size_t MiB = 1u << 20;
constexpr size_t WS_CTL = 0, CTL_ZERO_BYTES = 1 * MiB;
constexpr size_t WS_WIN = 2 * MiB;
constexpr size_t WS_WBR = 34 * MiB;
constexpr size_t WS_WOUT = 40 * MiB;
constexpr size_t WS_WEFF = 44 * MiB;
constexpr size_t WS_XB = 64 * MiB;
#define XNP ((bf16*)F.ap->out)
constexpr size_t WS_PROJ = 96 * MiB;
constexpr size_t WS_ST = 96 * MiB;
constexpr size_t WS_U8 = 224 * MiB, WS_V8 = 240 * MiB;
constexpr size_t WS_IDX = 52 * MiB;
constexpr size_t WS_W = 56 * MiB;
constexpr size_t WS_Y = 344 * MiB;
constexpr size_t WS_QT = 392 * MiB;
constexpr size_t WS_OI = 408 * MiB;
constexpr size_t WS_HGS = 424 * MiB;
constexpr size_t WS_CE = 456 * MiB;
constexpr size_t WS_YD = 472 * MiB;
constexpr size_t WS_SSDS = 488 * MiB;
constexpr size_t WS_DT = 496 * MiB;
constexpr size_t WS_DCH = 497 * MiB;
constexpr size_t WS_ATOT = 498 * MiB;
constexpr size_t WS_SSQ = 499 * MiB;
constexpr size_t WS_XW = 160 * MiB;
constexpr size_t WS_RSTD = 498 * MiB + 512 * 1024;
constexpr size_t WS_SSQ1 = 497 * MiB + 512 * 1024;
constexpr size_t WS_UP = 344 * MiB;
constexpr size_t WS_W2 = 500 * MiB;
constexpr size_t WS_END = 508 * MiB;

constexpr int RING_BYTES = 131072;
constexpr int LDSCTL_OFF = 143360, MISC_OFF = LDSCTL_OFF + 320;
constexpr int LDS_BYTES = 147456;
constexpr int NWAVES = 8;

#define GAS __attribute__((address_space(1)))
#define LAS __attribute__((address_space(3)))
typedef unsigned short bf16;
typedef unsigned v4u __attribute__((ext_vector_type(4)));
typedef unsigned v2u __attribute__((ext_vector_type(2)));
typedef float f32x4 __attribute__((ext_vector_type(4)));
typedef float f32x2 __attribute__((ext_vector_type(2)));
typedef float f32x16 __attribute__((ext_vector_type(16)));
typedef short bf16x8 __attribute__((ext_vector_type(8)));
typedef short bf16x4 __attribute__((ext_vector_type(4)));
typedef GAS unsigned gu32;
typedef GAS unsigned long long gu64;
#define RLX_AGENT __ATOMIC_RELAXED, __HIP_MEMORY_SCOPE_AGENT
#define LDS_WAIT() asm volatile("s_waitcnt lgkmcnt(0)" ::: "memory")
#define VM_WAIT() asm volatile("s_waitcnt vmcnt(0)" ::: "memory")
__device__ __forceinline__ void st16wt(void* p, v4u v) { asm volatile("global_store_dwordx4 %0, %1, off sc1\n\ts_nop 1" :: "v"(p), "v"(v) : "memory"); }
__device__ __forceinline__ void st8wt(void* p, v2u v) { asm volatile("global_store_dwordx2 %0, %1, off sc1\n\ts_nop 1" :: "v"(p), "v"(v) : "memory"); }
__device__ __forceinline__ unsigned f2bf(float f) { unsigned u = __builtin_bit_cast(unsigned, f); return (u + 0x7fffu + ((u >> 16) & 1u)) >> 16; }
__device__ __forceinline__ unsigned pk2(float lo, float hi) { return f2bf(lo) | (f2bf(hi) << 16); }
__device__ __forceinline__ float bf2f(unsigned short v) { return __builtin_bit_cast(float, (unsigned)v << 16); }
__device__ __forceinline__ float bflo(unsigned w) { return __builtin_bit_cast(float, w << 16); }
__device__ __forceinline__ float bfhi(unsigned w) { return __builtin_bit_cast(float, w & 0xffff0000u); }
__device__ __forceinline__ float fexp(float x) { return __builtin_amdgcn_exp2f(x * 1.4426950408889634f); }
__device__ __forceinline__ float frcp(float x) { return __builtin_amdgcn_rcpf(x); }
__device__ __forceinline__ float frsq(float x) { return __builtin_amdgcn_rsqf(x); }
__device__ __forceinline__ float geluf_(float v) { const float t = frcp(fabsf(v) * 0.2316418882f + 1.0f);
    float q = t * 0.5307027145f - 0.7265760135f; q = q * t + 0.7107068705f; q = q * t - 0.142248368f; q = q * t + 0.127414796f; q = q * t;
    const float m = v * (q * __builtin_amdgcn_exp2f(v * v * -0.72134752044f)); return v < 0.f ? m : v - m; }
__device__ __forceinline__ float sigmoidf_(float x) { const float e = fexp(-fabsf(x)), r = frcp(1.f + e); return x >= 0.f ? r : e * r; }
__device__ __forceinline__ float siluf_(float x) { return x * sigmoidf_(x); }
__device__ __forceinline__ bf16x8 pack8(const float* v) { v4u w; w.x = pk2(v[0], v[1]); w.y = pk2(v[2], v[3]); w.z = pk2(v[4], v[5]); w.w = pk2(v[6], v[7]); return __builtin_bit_cast(bf16x8, w); }
__device__ __forceinline__ void unpack8(v4u w, float* v) { v[0] = bflo(w.x); v[1] = bfhi(w.x); v[2] = bflo(w.y); v[3] = bfhi(w.y); v[4] = bflo(w.z); v[5] = bfhi(w.z); v[6] = bflo(w.w); v[7] = bfhi(w.w); }
__device__ __forceinline__ float shx(float v, int m, int lane) { return __builtin_bit_cast(float, __builtin_amdgcn_ds_bpermute((lane ^ m) << 2, __builtin_bit_cast(int, v))); }
__device__ __forceinline__ float shi(float v, int src) { return __builtin_bit_cast(float, __builtin_amdgcn_ds_bpermute(src << 2, __builtin_bit_cast(int, v))); }
__device__ __forceinline__ float wave_sum(float v, int lane) {
#pragma unroll
    for (int o = 1; o < 64; o <<= 1) v += shx(v, o, lane);
    return v;
}
__device__ __forceinline__ float hsum32(float a, float b) { auto r = __builtin_amdgcn_permlane32_swap(__builtin_bit_cast(unsigned, a), __builtin_bit_cast(unsigned, b), false, false); const unsigned r0 = r[0], r1 = r[1]; return __builtin_bit_cast(float, r0) + __builtin_bit_cast(float, r1); }
__device__ __forceinline__ float hsum16(float a, float b) { auto r = __builtin_amdgcn_permlane16_swap(__builtin_bit_cast(unsigned, a), __builtin_bit_cast(unsigned, b), false, false); const unsigned r0 = r[0], r1 = r[1]; return __builtin_bit_cast(float, r0) + __builtin_bit_cast(float, r1); }
__device__ __forceinline__ float hsum8(float a, float b, bool up) { asm volatile("" : "+v"(a), "+v"(b)); const float send = up ? a : b, keep = up ? b : a; return keep + __builtin_bit_cast(float, __builtin_amdgcn_update_dpp(0, __builtin_bit_cast(int, send), 0x128, 0xf, 0xf, false)); }
__device__ __forceinline__ float hsum4(float a, float b, bool up) { asm volatile("" : "+v"(a), "+v"(b)); const float send = up ? a : b, keep = up ? b : a;
    int t = __builtin_amdgcn_update_dpp(0, __builtin_bit_cast(int, send), 0x141, 0xf, 0xf, false); t = __builtin_amdgcn_update_dpp(0, t, 0x1b, 0xf, 0xf, false); return keep + __builtin_bit_cast(float, t); }
__device__ __forceinline__ float hsum2(float a, float b, bool up) { asm volatile("" : "+v"(a), "+v"(b)); const float send = up ? a : b, keep = up ? b : a; return keep + __builtin_bit_cast(float, __builtin_amdgcn_update_dpp(0, __builtin_bit_cast(int, send), 0x4e, 0xf, 0xf, false)); }
__device__ __forceinline__ float hsum1(float a, float b, bool up) { asm volatile("" : "+v"(a), "+v"(b)); const float send = up ? a : b, keep = up ? b : a; return keep + __builtin_bit_cast(float, __builtin_amdgcn_update_dpp(0, __builtin_bit_cast(int, send), 0xb1, 0xf, 0xf, false)); }
__device__ __forceinline__ float sum8lanes(float a) {
    a += __builtin_bit_cast(float, __builtin_amdgcn_update_dpp(0, __builtin_bit_cast(int, a), 0x141, 0xf, 0xf, false));
    a += __builtin_bit_cast(float, __builtin_amdgcn_update_dpp(0, __builtin_bit_cast(int, a), 0x1b, 0xf, 0xf, false));
    a += __builtin_bit_cast(float, __builtin_amdgcn_update_dpp(0, __builtin_bit_cast(int, a), 0xb1, 0xf, 0xf, false));
    return a; }
#define MFMA16(a, b, c) __builtin_amdgcn_mfma_f32_16x16x32_bf16((a), (b), (c), 0, 0, 0)
#define MFMA32(a, b, c) __builtin_amdgcn_mfma_f32_32x32x16_bf16((a), (b), (c), 0, 0, 0)
namespace pg8 {
#define PG8_LAS __attribute__((address_space(3)))
typedef unsigned short bf16_t;
typedef short bf16x8 __attribute__((ext_vector_type(8)));
typedef float f32x4 __attribute__((ext_vector_type(4)));
typedef unsigned u32x4 __attribute__((ext_vector_type(4)));
constexpr int BM = 256, BK = 64, HALF = 128, HTB = HALF * BK * 2  , STAGE_BYTES = 8 * HTB, NXCD = 8, WGM = 8;

__host__ __device__ __forceinline__ int lds_byte(int r, int c) { const int st = (r >> 4) * 2 + (c >> 5), rr = r & 15, cc = c & 31, ob = rr * 64 + cc * 2; return st * 1024 + (ob ^ (((ob >> 9) & 1) << 5)); }
__host__ __device__ __forceinline__ void stage_rc(int b, int& R, int& C) { const int st = b / 1024, sb = b % 1024, swz = sb ^ (((sb >> 9) & 1) << 5); R = (st >> 1) * 16 + swz / 64; C = (st & 1) * 32 + (swz % 64) / 2; }
__host__ __device__ __forceinline__ int perm32(int rho) { const int n = rho >> 4, i = rho & 15; return 8 * (i >> 2) + 4 * n + (i & 3); }

struct Unit { int pm, pn; };
struct Gemm { const bf16_t* A; const bf16_t* Bt; int M, N, K; };

struct StaticOrder {
    int nM, nN, nwg, G, c;
    __host__ __device__ void init(int M, int N, int G_, int c_) { nM = M / BM; nN = N / BM; nwg = nM * nN; G = G_; c = c_; }
    __host__ __device__ bool next(int i, Unit& u) const {
        const long L = (long)i * G + c; if (L >= nwg) return false;
        int wgid = (int)L; { const int q = nwg / NXCD, r = nwg % NXCD, xcd = wgid % NXCD, off = wgid / NXCD; wgid = (xcd < r ? xcd * (q + 1) : r * (q + 1) + (xcd - r) * q) + off; }
        const int nig = WGM * nN, gid = wgid / nig, fm = gid * WGM, gsz = (nM - fm) < WGM ? (nM - fm) : WGM;
        u.pm = fm + ((wgid % nig) % gsz); u.pn = (wgid % nig) / gsz; return true;
    }
    __device__ __forceinline__ void a_ready(const Unit&) const {}
    __device__ __forceinline__ void done(const Unit&) const {}
};

__device__ __forceinline__ unsigned cvt_pk_bf16(float lo, float hi) { unsigned r; asm volatile("v_cvt_pk_bf16_f32 %0, %1, %2" : "=v"(r) : "v"(lo), "v"(hi)); return r; }
typedef float f32x2 __attribute__((ext_vector_type(2)));
typedef unsigned u32x2 __attribute__((ext_vector_type(2)));
__device__ __forceinline__ void st16_wt(void* p, u32x4 v) {
#if MK_WT_STORES
    asm volatile("global_store_dwordx4 %0, %1, off sc1\n\ts_nop 1" :: "v"(p), "v"(v) : "memory");
#else
    *(u32x4*)p = v;
#endif
}
struct EpiBf16 {
    static constexpr bool PERM = true, AFTER_DRAIN = false;
    bf16_t* O; int ldc;
    __device__ __forceinline__ void operator()(const f32x4 (&acc)[2][2][4][2], const Unit& u, int wr, int wc, int fr, int fq) const {
        const int row0 = u.pm * BM + wr * 64 + fr; const int col0 = u.pn * BM + wc * 32 + 8 * fq;
#pragma unroll
        for (int ai = 0; ai < 2; ++ai)
#pragma unroll
            for (int m = 0; m < 4; ++m) { bf16_t* rowp = O + (size_t)(row0 + ai * HALF + m * 16) * ldc + col0;
#pragma unroll
                for (int bj = 0; bj < 2; ++bj) { const f32x4 v0 = acc[ai][bj][m][0], v1 = acc[ai][bj][m][1];
                    u32x4 w; w.x = cvt_pk_bf16(v0[0], v0[1]); w.y = cvt_pk_bf16(v0[2], v0[3]); w.z = cvt_pk_bf16(v1[0], v1[1]); w.w = cvt_pk_bf16(v1[2], v1[3]);
                    st16_wt(rowp + bj * HALF, w); } }
    }
};
struct EpiProj {
    static constexpr bool PERM = true, AFTER_DRAIN = false;
    bf16_t* O; int ldc; float* dt; const PG8_LAS float* rsl; int xg; const float* ssq8; bool scale;
    __device__ __forceinline__ void operator()(const f32x4 (&acc)[2][2][4][2], const Unit& u, int wr, int wc, int fr, int fq) const {
        const int rl0 = wr * 64 + fr, row0 = u.pm * BM + rl0; const int col0 = u.pn * BM + wc * 32 + 8 * fq;
        float sc[2][4];
        if ((u.pm >> 3) == xg) {
#pragma unroll
            for (int ai = 0; ai < 2; ++ai)
#pragma unroll
                for (int m = 0; m < 4; ++m) sc[ai][m] = rsl[(u.pm & 7) * BM + rl0 + ai * HALF + m * 16];
        } else {
#pragma unroll
            for (int ai = 0; ai < 2; ++ai)
#pragma unroll
                for (int m = 0; m < 4; ++m) { sc[ai][m] = 1.f; if (scale) { const float* pp = ssq8 + (size_t)(row0 + ai * HALF + m * 16) * 8; const f32x4 a = *(const f32x4*)pp, b = *(const f32x4*)(pp + 4);
                    sc[ai][m] = __builtin_amdgcn_rsqf((((a[0] + a[1]) + (a[2] + a[3])) + ((b[0] + b[1]) + (b[2] + b[3]))) * (1.f / 1024.f) + 1e-6f); } }
        }
        if (u.pn == 31) {
            if (wc == 0 && fq == 0) {
#pragma unroll
                for (int ai = 0; ai < 2; ++ai)
#pragma unroll
                    for (int m = 0; m < 4; ++m) { float* dp = dt + (size_t)(row0 + ai * HALF + m * 16) * 8; *(f32x4*)dp = acc[ai][0][m][0] * sc[ai][m]; *(f32x4*)(dp + 4) = acc[ai][0][m][1] * sc[ai][m]; }
            }
            return;
        }
#pragma unroll
        for (int ai = 0; ai < 2; ++ai)
#pragma unroll
            for (int m = 0; m < 4; ++m) { bf16_t* rowp = O + (size_t)(row0 + ai * HALF + m * 16) * ldc + col0;
#pragma unroll
                for (int bj = 0; bj < 2; ++bj) { const f32x4 v0 = acc[ai][bj][m][0] * sc[ai][m], v1 = acc[ai][bj][m][1] * sc[ai][m];
                    u32x4 w; w.x = cvt_pk_bf16(v0[0], v0[1]); w.y = cvt_pk_bf16(v0[2], v0[3]); w.z = cvt_pk_bf16(v1[0], v1[1]); w.w = cvt_pk_bf16(v1[2], v1[3]);
                    st16_wt(rowp + bj * HALF, w); } }
    }
};
struct EpiF32 {
    static constexpr bool PERM = false, AFTER_DRAIN = false;
    float* C; int ldc;
    __device__ __forceinline__ void operator()(const f32x4 (&acc)[2][2][4][2], const Unit& u, int wr, int wc, int fr, int fq) const {
        const int row0 = u.pm * BM + wr * 64 + fr, col0 = u.pn * BM + wc * 32 + 4 * fq;
#pragma unroll
        for (int ai = 0; ai < 2; ++ai)
#pragma unroll
            for (int m = 0; m < 4; ++m) { float* rowp = C + (size_t)(row0 + ai * HALF + m * 16) * ldc + col0;
#pragma unroll
                for (int bj = 0; bj < 2; ++bj)
#pragma unroll
                    for (int n = 0; n < 2; ++n) st16_wt(rowp + bj * HALF + n * 16, __builtin_bit_cast(u32x4, acc[ai][bj][m][n])); }
    }
};
struct EpiF16 {
    static constexpr bool PERM = true, AFTER_DRAIN = false;
    _Float16* C; int ldc;
    __device__ __forceinline__ void operator()(const f32x4 (&acc)[2][2][4][2], const Unit& u, int wr, int wc, int fr, int fq) const {
        typedef _Float16 h2 __attribute__((ext_vector_type(2)));
        const int row0 = u.pm * BM + wr * 64 + fr; const int col0 = u.pn * BM + wc * 32 + 8 * fq;
#pragma unroll
        for (int ai = 0; ai < 2; ++ai)
#pragma unroll
            for (int m = 0; m < 4; ++m) { _Float16* rowp = C + (size_t)(row0 + ai * HALF + m * 16) * ldc + col0;
#pragma unroll
                for (int bj = 0; bj < 2; ++bj) { const f32x4 v0 = acc[ai][bj][m][0], v1 = acc[ai][bj][m][1];
                    const h2 a = {(_Float16)v0[0], (_Float16)v0[1]}, b = {(_Float16)v0[2], (_Float16)v0[3]}, c = {(_Float16)v1[0], (_Float16)v1[1]}, d = {(_Float16)v1[2], (_Float16)v1[3]};
                    u32x4 w; w.x = __builtin_bit_cast(unsigned, a); w.y = __builtin_bit_cast(unsigned, b); w.z = __builtin_bit_cast(unsigned, c); w.w = __builtin_bit_cast(unsigned, d);
                    st16_wt(rowp + bj * HALF, w); } }
    }
};
template <bool DRY> struct EpiResF32 {
    static constexpr bool PERM = false, AFTER_DRAIN = false;
    float* C; int ldc;
    __device__ __forceinline__ void operator()(const f32x4 (&acc)[2][2][4][2], const Unit& u, int wr, int wc, int fr, int fq) const {
        const int row0 = u.pm * BM + wr * 64 + fr, col0 = u.pn * BM + wc * 32 + 4 * fq;
#pragma unroll
        for (int ai = 0; ai < 2; ++ai)
#pragma unroll
            for (int m = 0; m < 4; ++m) { float* rowp = C + (size_t)(row0 + ai * HALF + m * 16) * ldc + col0;
                f32x4 old[2][2];
#pragma unroll
                for (int bj = 0; bj < 2; ++bj)
#pragma unroll
                    for (int n = 0; n < 2; ++n) old[bj][n] = *(const f32x4*)(rowp + bj * HALF + n * 16);
#pragma unroll
                for (int bj = 0; bj < 2; ++bj)
#pragma unroll
                    for (int n = 0; n < 2; ++n) { const f32x4 r = old[bj][n] + acc[ai][bj][m][n]; if constexpr (!DRY) *(f32x4*)(rowp + bj * HALF + n * 16) = r; else asm volatile("" :: "v"(r)); } }
    }
};
template <bool CIN_F32> struct EpiResNorm {
    static constexpr bool PERM = true, AFTER_DRAIN = false;
    const void* Cin; bf16_t* C; int ldc; const float* w; bf16_t* XW; float* ssq;
    __device__ __forceinline__ void operator()(const f32x4 (&acc)[2][2][4][2], const Unit& u, int wr, int wc, int fr, int fq) const {
        const int row0 = u.pm * BM + wr * 64 + fr, col0 = u.pn * BM + wc * 32 + 8 * fq;
        f32x4 wv[2][2];
#pragma unroll
        for (int bj = 0; bj < 2; ++bj)
#pragma unroll
            for (int n = 0; n < 2; ++n) wv[bj][n] = *(const f32x4*)(w + col0 + bj * HALF + 4 * n);
        f32x4 xf[3][2][2]; u32x4 xh[3][2];
#define ERN_LD(i, s) do { const size_t ro_ = (size_t)(row0 + ((i) >> 2) * HALF + ((i) & 3) * 16) * ldc + col0; \
            if constexpr (CIN_F32) { _Pragma("unroll") for (int bj = 0; bj < 2; ++bj) _Pragma("unroll") for (int n = 0; n < 2; ++n) xf[s][bj][n] = *(const f32x4*)((const float*)Cin + ro_ + bj * HALF + 4 * n); } \
            else { _Pragma("unroll") for (int bj = 0; bj < 2; ++bj) xh[s][bj] = *(const u32x4*)((const bf16_t*)Cin + ro_ + bj * HALF); } } while (0)
#define ERN_COMP(i, s) do { constexpr int ai = (i) >> 2, m = (i) & 3; const size_t row = (size_t)(row0 + ai * HALF + m * 16); float ss = 0.f; \
            _Pragma("unroll") for (int bj = 0; bj < 2; ++bj) { f32x4 xx[2]; \
                if constexpr (CIN_F32) { xx[0] = xf[s][bj][0]; xx[1] = xf[s][bj][1]; } \
                else { const u32x4 q_ = xh[s][bj]; xx[0] = (f32x4){__builtin_bit_cast(float, q_.x << 16), __builtin_bit_cast(float, q_.x & 0xffff0000u), __builtin_bit_cast(float, q_.y << 16), __builtin_bit_cast(float, q_.y & 0xffff0000u)}; \
                       xx[1] = (f32x4){__builtin_bit_cast(float, q_.z << 16), __builtin_bit_cast(float, q_.z & 0xffff0000u), __builtin_bit_cast(float, q_.w << 16), __builtin_bit_cast(float, q_.w & 0xffff0000u)}; } \
                _Pragma("unroll") for (int n = 0; n < 2; ++n) { xx[n] = xx[n] + acc[ai][bj][m][n]; \
                    ss += (xx[n][0] * xx[n][0] + xx[n][1] * xx[n][1]) + (xx[n][2] * xx[n][2] + xx[n][3] * xx[n][3]); } \
                u32x4 xo; xo.x = cvt_pk_bf16(xx[0][0], xx[0][1]); xo.y = cvt_pk_bf16(xx[0][2], xx[0][3]); xo.z = cvt_pk_bf16(xx[1][0], xx[1][1]); xo.w = cvt_pk_bf16(xx[1][2], xx[1][3]); \
                *(u32x4*)(C + row * ldc + col0 + bj * HALF) = xo; \
                const f32x4 y0 = xx[0] * wv[bj][0], y1 = xx[1] * wv[bj][1]; \
                u32x4 o; o.x = cvt_pk_bf16(y0[0], y0[1]); o.y = cvt_pk_bf16(y0[2], y0[3]); o.z = cvt_pk_bf16(y1[0], y1[1]); o.w = cvt_pk_bf16(y1[2], y1[3]); \
                *(u32x4*)(XW + row * ldc + col0 + bj * HALF) = o; } \
              \
            { auto r1 = __builtin_amdgcn_permlane16_swap(__builtin_bit_cast(unsigned, ss), __builtin_bit_cast(unsigned, ss), false, false); const unsigned a1 = r1[0], b1 = r1[1]; ss = __builtin_bit_cast(float, a1) + __builtin_bit_cast(float, b1); \
              auto r2 = __builtin_amdgcn_permlane32_swap(__builtin_bit_cast(unsigned, ss), __builtin_bit_cast(unsigned, ss), false, false); const unsigned a2 = r2[0], b2 = r2[1]; ss = __builtin_bit_cast(float, a2) + __builtin_bit_cast(float, b2); } \
            if (fq == 0) ssq[row * 16 + 4 * u.pn + wc] = ss; } while (0)
        ERN_LD(0, 0); ERN_LD(1, 1); ERN_LD(2, 2);
        ERN_COMP(0, 0); ERN_LD(3, 0); ERN_COMP(1, 1); ERN_LD(4, 1); ERN_COMP(2, 2); ERN_LD(5, 2); ERN_COMP(3, 0); ERN_LD(6, 0); ERN_COMP(4, 1); ERN_LD(7, 1); ERN_COMP(5, 2); ERN_COMP(6, 0); ERN_COMP(7, 1);
#undef ERN_LD
#undef ERN_COMP
    }
};
struct EpiMerge {
    static constexpr bool PERM = true, AFTER_DRAIN = false;
    const bf16_t* gate; int ldg;
    bf16_t* O; int ldc;
    __device__ __forceinline__ void operator()(const f32x4 (&acc)[2][2][4][2], const Unit& u, int wr, int wc, int fr, int fq) const {
        const int br = u.pm >> 6, pm = u.pm & 63, pn = u.pn & 3;
        const int row0 = pm * BM + wr * 64 + fr, col0 = pn * BM + wc * 32 + 8 * fq;
        const bf16_t* gbase = gate + (size_t)row0 * ldg + br * 1024 + col0; bf16_t* obase = O + (size_t)row0 * ldc + col0;
        u32x4 gq[2][4], oq[2][4];
#define EMG_LD(b, s) do { _Pragma("unroll") for (int mm = 0; mm < 2; ++mm) _Pragma("unroll") for (int bj = 0; bj < 2; ++bj) { const size_t r = (size_t)(((b) >> 1) * HALF + (2 * ((b) & 1) + mm) * 16); \
            gq[s][mm * 2 + bj] = *(const u32x4*)(gbase + r * ldg + bj * HALF); oq[s][mm * 2 + bj] = *(const u32x4*)(obase + r * ldc + bj * HALF); } } while (0)
#define EMG_COMP(b, s) do { _Pragma("unroll") for (int mm = 0; mm < 2; ++mm) _Pragma("unroll") for (int bj = 0; bj < 2; ++bj) { constexpr int ai = (b) >> 1; const int m = 2 * ((b) & 1) + mm; const size_t r = (size_t)(ai * HALF + m * 16); \
            const u32x4 gw = gq[s][mm * 2 + bj]; \
            float v[8] = {acc[ai][bj][m][0][0], acc[ai][bj][m][0][1], acc[ai][bj][m][0][2], acc[ai][bj][m][0][3], acc[ai][bj][m][1][0], acc[ai][bj][m][1][1], acc[ai][bj][m][1][2], acc[ai][bj][m][1][3]}; \
            float g[8]; { g[0] = __builtin_bit_cast(float, gw.x << 16); g[1] = __builtin_bit_cast(float, gw.x & 0xffff0000u); g[2] = __builtin_bit_cast(float, gw.y << 16); g[3] = __builtin_bit_cast(float, gw.y & 0xffff0000u); \
                          g[4] = __builtin_bit_cast(float, gw.z << 16); g[5] = __builtin_bit_cast(float, gw.z & 0xffff0000u); g[6] = __builtin_bit_cast(float, gw.w << 16); g[7] = __builtin_bit_cast(float, gw.w & 0xffff0000u); } \
            _Pragma("unroll") for (int j = 0; j < 8; ++j) {   v[j] *= __builtin_amdgcn_rcpf(1.f + __builtin_amdgcn_exp2f(g[j] * -1.4426950408889634f)); } \
            if (br != 0) { const u32x4 ow = oq[s][mm * 2 + bj]; \
                v[0] += __builtin_bit_cast(float, ow.x << 16); v[1] += __builtin_bit_cast(float, ow.x & 0xffff0000u); v[2] += __builtin_bit_cast(float, ow.y << 16); v[3] += __builtin_bit_cast(float, ow.y & 0xffff0000u); \
                v[4] += __builtin_bit_cast(float, ow.z << 16); v[5] += __builtin_bit_cast(float, ow.z & 0xffff0000u); v[6] += __builtin_bit_cast(float, ow.w << 16); v[7] += __builtin_bit_cast(float, ow.w & 0xffff0000u); } \
            u32x4 wq; wq.x = cvt_pk_bf16(v[0], v[1]); wq.y = cvt_pk_bf16(v[2], v[3]); wq.z = cvt_pk_bf16(v[4], v[5]); wq.w = cvt_pk_bf16(v[6], v[7]); \
            *(u32x4*)(obase + r * ldc + bj * HALF) = wq; } } while (0)
        EMG_LD(0, 0); EMG_LD(1, 1); EMG_COMP(0, 0); EMG_LD(2, 0); EMG_COMP(1, 1); EMG_LD(3, 1); EMG_COMP(2, 0); EMG_COMP(3, 1);
#undef EMG_LD
#undef EMG_COMP
    }
};
struct EpiMerge2 {
    static constexpr bool PERM = true, AFTER_DRAIN = false;
    const bf16_t* gate; int ldg;
    bf16_t* O; int ldc;
    __device__ __forceinline__ void operator()(f32x4 (&acc)[2][2][4][2], const Unit& u, int wr, int wc, int fr, int fq) const {
        const int br = u.pm >> 6, pm = u.pm & 63, pn = u.pn & 3;
        const int row0 = pm * BM + wr * 64 + fr, col0 = pn * BM + wc * 32 + 8 * fq;
        const bf16_t* gbase = gate + (size_t)row0 * ldg + br * 1024 + col0; bf16_t* obase = O + (size_t)row0 * ldc + col0;
        const int nxo = br < 2 ? 1024 : 0;
        u32x4 gq[2][4], hq[2][4];
#define EM2_LD(b, s) do { _Pragma("unroll") for (int mm = 0; mm < 2; ++mm) _Pragma("unroll") for (int bj = 0; bj < 2; ++bj) { const size_t r = (size_t)(((b) >> 1) * HALF + (2 * ((b) & 1) + mm) * 16); \
            gq[s][mm * 2 + bj] = *(const u32x4*)(gbase + r * ldg + bj * HALF); hq[s][mm * 2 + bj] = *(const u32x4*)(gbase + r * ldg + bj * HALF + nxo); } } while (0)
#define EM2_E(x) __builtin_amdgcn_exp2f(__builtin_amdgcn_fmed3f((x), -30.f, 30.f) * -1.4426950408889634f)
#define EM2_COMP(b, s) do { _Pragma("unroll") for (int mm = 0; mm < 2; ++mm) _Pragma("unroll") for (int bj = 0; bj < 2; ++bj) { constexpr int ai = (b) >> 1; const int m = 2 * ((b) & 1) + mm; const size_t r = (size_t)(ai * HALF + m * 16); \
            const u32x4 gw = gq[s][mm * 2 + bj], hw = hq[s][mm * 2 + bj]; \
            const float g[8] = {__builtin_bit_cast(float, gw.x << 16), __builtin_bit_cast(float, gw.x & 0xffff0000u), __builtin_bit_cast(float, gw.y << 16), __builtin_bit_cast(float, gw.y & 0xffff0000u), \
                                __builtin_bit_cast(float, gw.z << 16), __builtin_bit_cast(float, gw.z & 0xffff0000u), __builtin_bit_cast(float, gw.w << 16), __builtin_bit_cast(float, gw.w & 0xffff0000u)}; \
            const float hh[8] = {__builtin_bit_cast(float, hw.x << 16), __builtin_bit_cast(float, hw.x & 0xffff0000u), __builtin_bit_cast(float, hw.y << 16), __builtin_bit_cast(float, hw.y & 0xffff0000u), \
                                 __builtin_bit_cast(float, hw.z << 16), __builtin_bit_cast(float, hw.z & 0xffff0000u), __builtin_bit_cast(float, hw.w << 16), __builtin_bit_cast(float, hw.w & 0xffff0000u)}; \
            float f[8]; \
            if (br < 2) { _Pragma("unroll") for (int j = 0; j < 8; ++j) f[j] = (1.f + EM2_E(hh[j])) * __builtin_amdgcn_rcpf(1.f + EM2_E(g[j])); } \
            else        { _Pragma("unroll") for (int j = 0; j < 8; ++j) f[j] = __builtin_amdgcn_rcpf(1.f + EM2_E(g[j])); } \
            _Pragma("unroll") for (int j = 0; j < 8; ++j) acc[ai][bj][m][j >> 2][j & 3] *= f[j]; \
            if (br == 2) { u32x4 wq; wq.x = cvt_pk_bf16(acc[ai][bj][m][0][0], acc[ai][bj][m][0][1]); wq.y = cvt_pk_bf16(acc[ai][bj][m][0][2], acc[ai][bj][m][0][3]); \
                wq.z = cvt_pk_bf16(acc[ai][bj][m][1][0], acc[ai][bj][m][1][1]); wq.w = cvt_pk_bf16(acc[ai][bj][m][1][2], acc[ai][bj][m][1][3]); \
                *(u32x4*)(obase + r * ldc + bj * HALF) = wq; } } } while (0)
        EM2_LD(0, 0); EM2_LD(1, 1); EM2_COMP(0, 0); EM2_LD(2, 0); EM2_COMP(1, 1); EM2_LD(3, 1); EM2_COMP(2, 0); EM2_COMP(3, 1);
#undef EM2_LD
#undef EM2_E
#undef EM2_COMP
    }
};
template <class Epi> __device__ __forceinline__ bool epi_keep(const Epi&, const Unit&) { return false; }
__device__ __forceinline__ bool epi_keep(const EpiMerge2&, const Unit& u) { return (u.pm >> 6) < 2; }
struct MergeOrder {
    int v, G;
    __device__ __forceinline__ bool next(int i, Unit& u) const { const int bi = i / 3, br = i - bi * 3; const long L = (long)bi * G + v; if (L >= 256) return false;
        u.pm = br * 64 + (int)(L >> 2); u.pn = br * 4 + (int)(L & 3); return true; }
    __device__ __forceinline__ void a_ready(const Unit&) const {}
    __device__ __forceinline__ void done(const Unit&) const {}
};
template <class Epi, class Sched, bool ALIGN_EPI = false, bool SP2 = false>
__device__ __forceinline__ void gemm_phase(PG8_LAS unsigned char* lds, const Gemm g, const Sched& S, const Epi& E, int tid_) {
    const int tid = tid_, wid = __builtin_amdgcn_readfirstlane(tid >> 6), lane = tid & 63, wr = wid >> 2, wc = wid & 3, fr = lane & 15, fq = lane >> 4;
    const int K = g.K, nt = K / BK;
    unsigned voffA[2], voffB[2];
#pragma unroll
    for (int i = 0; i < 2; ++i) { int R, C; stage_rc(tid * 16 + i * 8192, R, C); const int Rb = Epi::PERM ? ((R & ~31) + perm32(R & 31)) : R;
        voffA[i] = (unsigned)(R * K + C) * 2u; voffB[i] = (unsigned)(Rb * K + C) * 2u; }
    const size_t kstep = (size_t)(BK * 2);
    const size_t hstep = (size_t)HALF * K * 2;
    const size_t tstep = 2 * hstep;
    const unsigned ldsw = (unsigned)wid * 1024u;
    const int aoff = lds_byte(wr * 64 + fr, fq * 8), boff = lds_byte(wc * 32 + fr, fq * 8);
#define PG8_SA(b, h) (((b) * 2 + (h)) * HTB)
#define PG8_SB(b, h) ((4 + (b) * 2 + (h)) * HTB)
#define PG8_STAGE(bufoff, gbase, voff) do { _Pragma("unroll") for (int _i = 0; _i < 2; ++_i) \
        __builtin_amdgcn_global_load_lds((const unsigned*)((const char*)(gbase) + (voff)[_i]), (PG8_LAS unsigned*)(lds + (bufoff) + ldsw + _i * 8192), 16, 0, 0); } while (0)
#define PG8_LDA(dst, b, h) do { _Pragma("unroll") for (int m = 0; m < 4; ++m) _Pragma("unroll") for (int k = 0; k < 2; ++k) dst[m][k] = *(const PG8_LAS bf16x8*)(lds + PG8_SA(b, h) + aoff + m * 2048 + k * 1024); } while (0)
#define PG8_LDB(dst, b, h) do { _Pragma("unroll") for (int n = 0; n < 2; ++n) _Pragma("unroll") for (int k = 0; k < 2; ++k) dst[n][k] = *(const PG8_LAS bf16x8*)(lds + PG8_SB(b, h) + boff + n * 2048 + k * 1024); } while (0)
#define PG8_MMA(ai, bj, At, Bt) do { __builtin_amdgcn_s_setprio(1); _Pragma("unroll") for (int m = 0; m < 4; ++m) _Pragma("unroll") for (int n = 0; n < 2; ++n) _Pragma("unroll") for (int k = 0; k < 2; ++k) \
        acc[ai][bj][m][n] = __builtin_amdgcn_mfma_f32_16x16x32_bf16(Bt[n][k], At[m][k], acc[ai][bj][m][n], 0, 0, 0); __builtin_amdgcn_s_setprio(0); } while (0)
#define PG8_WAIT_V(n) asm volatile("s_waitcnt vmcnt(" #n ")" ::: "memory")
#define PG8_WAIT_L(n) asm volatile("s_waitcnt lgkmcnt(" #n ")" ::: "memory")
#define PG8_BAR __builtin_amdgcn_s_barrier()
#define PG8_SCHED __builtin_amdgcn_sched_barrier(0)
    Unit cur, nxt; int ui = 0;
    if (!S.next(0, cur)) return;
    f32x4 acc[2][2][4][2];
#pragma unroll
    for (int a = 0; a < 2; ++a)
#pragma unroll
        for (int b = 0; b < 2; ++b)
#pragma unroll
            for (int m = 0; m < 4; ++m)
#pragma unroll
                for (int n = 0; n < 2; ++n) acc[a][b][m][n] = (f32x4){0.f, 0.f, 0.f, 0.f};
    bf16x8 At[4][2], B0[2][2], B1[2][2];
    const char* cA = (const char*)g.A + (size_t)cur.pm * tstep; const char* cB = (const char*)g.Bt + (size_t)cur.pn * tstep;
    S.a_ready(cur);
    if constexpr (SP2) {
        PG8_STAGE(PG8_SB(0, 0), cB, voffB); PG8_STAGE(PG8_SB(0, 1), cB + hstep, voffB); PG8_STAGE(PG8_SA(0, 0), cA, voffA); PG8_STAGE(PG8_SA(0, 1), cA + hstep, voffA);
        if (wr == 1) PG8_BAR;
        PG8_WAIT_V(2); PG8_BAR;
        PG8_STAGE(PG8_SB(1, 0), cB + kstep, voffB); PG8_STAGE(PG8_SA(1, 0), cA + kstep, voffA); PG8_STAGE(PG8_SB(1, 1), cB + hstep + kstep, voffB);
        PG8_WAIT_V(6); PG8_BAR;
    } else {
        PG8_STAGE(PG8_SB(0, 0), cB, voffB); PG8_STAGE(PG8_SA(0, 0), cA, voffA); PG8_STAGE(PG8_SB(0, 1), cB + hstep, voffB); PG8_STAGE(PG8_SA(0, 1), cA + hstep, voffA);
        if (wr == 1) PG8_BAR;
        PG8_WAIT_V(4); PG8_BAR;
        PG8_STAGE(PG8_SB(1, 0), cB + kstep, voffB); PG8_STAGE(PG8_SA(1, 0), cA + kstep, voffA); PG8_STAGE(PG8_SB(1, 1), cB + hstep + kstep, voffB);
        PG8_WAIT_V(6); PG8_BAR;
    }
    for (;;) {
        const bool has_next = S.next(ui + 1, nxt);
        const char* nA = has_next ? (const char*)g.A + (size_t)nxt.pm * tstep : cA; const char* nB = has_next ? (const char*)g.Bt + (size_t)nxt.pn * tstep : cB;
        for (int t = 0; t < nt; t += 2) {
            const bool last = (t == nt - 2);
            const char* a1 = cA + (size_t)(t + 1) * kstep;
            const char* a2 = last ? nA : cA + (size_t)(t + 2) * kstep; const char* b2 = last ? nB : cB + (size_t)(t + 2) * kstep;
            const char* a3 = a2 + kstep; const char* b3 = b2 + kstep;
            if (last && has_next) S.a_ready(nxt);
            if constexpr (SP2) {
            PG8_LDB(B0, 0, 0); PG8_LDB(B1, 0, 1); PG8_SCHED; PG8_LDA(At, 0, 0); PG8_STAGE(PG8_SA(1, 1), a1 + hstep, voffA);
            PG8_WAIT_V(8); PG8_WAIT_L(0); PG8_BAR; PG8_MMA(0, 0, At, B0); PG8_MMA(0, 1, At, B1); PG8_BAR; PG8_SCHED;
            PG8_LDA(At, 0, 1); PG8_STAGE(PG8_SB(0, 0), b2, voffB); PG8_STAGE(PG8_SB(0, 1), b2 + hstep, voffB); PG8_STAGE(PG8_SA(0, 0), a2, voffA);
            PG8_WAIT_V(8); PG8_WAIT_L(0); PG8_BAR; PG8_MMA(1, 0, At, B0); PG8_MMA(1, 1, At, B1); PG8_BAR; PG8_SCHED;
            PG8_LDB(B0, 1, 0); PG8_LDB(B1, 1, 1); PG8_SCHED; PG8_LDA(At, 1, 0); PG8_STAGE(PG8_SA(0, 1), a2 + hstep, voffA);
            PG8_WAIT_V(8); PG8_WAIT_L(0); PG8_BAR; PG8_MMA(0, 0, At, B0); PG8_MMA(0, 1, At, B1); PG8_BAR; PG8_SCHED;
            PG8_LDA(At, 1, 1); PG8_STAGE(PG8_SB(1, 0), b3, voffB); PG8_STAGE(PG8_SB(1, 1), b3 + hstep, voffB); PG8_STAGE(PG8_SA(1, 0), a3, voffA);
            PG8_WAIT_V(8); PG8_WAIT_L(0); PG8_BAR; PG8_MMA(1, 0, At, B0); PG8_MMA(1, 1, At, B1); PG8_BAR; PG8_SCHED;
            } else {
            PG8_LDB(B0, 0, 0); PG8_SCHED; PG8_LDA(At, 0, 0); PG8_STAGE(PG8_SA(1, 1), a1 + hstep, voffA);
            PG8_WAIT_L(8); PG8_BAR; PG8_WAIT_L(0); PG8_MMA(0, 0, At, B0); PG8_BAR; PG8_SCHED;
            PG8_LDB(B1, 0, 1); PG8_STAGE(PG8_SB(0, 0), b2, voffB);
            PG8_BAR; PG8_WAIT_L(0); PG8_MMA(0, 1, At, B1); PG8_BAR;
            PG8_LDA(At, 0, 1); PG8_STAGE(PG8_SA(0, 0), a2, voffA);
            PG8_BAR; PG8_WAIT_L(0); PG8_MMA(1, 0, At, B0); PG8_BAR; PG8_SCHED;
            PG8_STAGE(PG8_SB(0, 1), b2 + hstep, voffB);
            PG8_WAIT_V(6); PG8_BAR; PG8_MMA(1, 1, At, B1); PG8_BAR;
            PG8_LDB(B0, 1, 0); PG8_SCHED; PG8_LDA(At, 1, 0); PG8_STAGE(PG8_SA(0, 1), a2 + hstep, voffA);
            PG8_WAIT_L(8); PG8_BAR; PG8_WAIT_L(0); PG8_MMA(0, 0, At, B0); PG8_BAR; PG8_SCHED;
            PG8_LDB(B1, 1, 1); PG8_STAGE(PG8_SB(1, 0), b3, voffB);
            PG8_BAR; PG8_WAIT_L(0); PG8_MMA(0, 1, At, B1); PG8_BAR;
            PG8_LDA(At, 1, 1); PG8_STAGE(PG8_SA(1, 0), a3, voffA);
            PG8_BAR; PG8_WAIT_L(0); PG8_MMA(1, 0, At, B0); PG8_BAR; PG8_SCHED;
            PG8_STAGE(PG8_SB(1, 1), b3 + hstep, voffB);
            PG8_WAIT_V(6); PG8_BAR; PG8_MMA(1, 1, At, B1); PG8_BAR;
            }
        }
        if constexpr (ALIGN_EPI) { if (wr == 0) PG8_BAR; }
        if constexpr (!Epi::AFTER_DRAIN) { E(acc, cur, wr, wc, fr, fq); S.done(cur); }
        if (!has_next) break;
        if (!epi_keep(E, cur)) {
#pragma unroll
        for (int a = 0; a < 2; ++a)
#pragma unroll
            for (int b = 0; b < 2; ++b)
#pragma unroll
                for (int m = 0; m < 4; ++m)
#pragma unroll
                    for (int n = 0; n < 2; ++n) acc[a][b][m][n] = (f32x4){0.f, 0.f, 0.f, 0.f}; }
        cur = nxt; cA = nA; cB = nB; ++ui;
        if constexpr (ALIGN_EPI) { if (wr == 1) PG8_BAR; }
    }
    PG8_WAIT_V(0);
    if constexpr (!ALIGN_EPI) { if (wr == 0) PG8_BAR; }
    PG8_BAR;
    if constexpr (Epi::AFTER_DRAIN) { E.fused(acc, cur, wr, wc, fr, fq, lds, wid, lane); S.done(cur); }
#undef PG8_SA
#undef PG8_SB
#undef PG8_STAGE
#undef PG8_LDA
#undef PG8_LDB
#undef PG8_MMA
#undef PG8_WAIT_V
#undef PG8_WAIT_L
#undef PG8_BAR
#undef PG8_SCHED
}
}
constexpr int CW_BAR = 4096;
__device__ __forceinline__ unsigned long long rt() { return __builtin_amdgcn_s_memrealtime(); }
#define XB_TMO      128
#define XB_XCNT(j)  (256  + 64 * (j))
#define XB_XSUB(j)  (1280 + 64 * (j))
#define XB_XGEN(j)  (2304 + 64 * (j))
#define XB_TOP      3328
#define XB_TOPGEN   3392
#define XCD_BAR_WORDS 3456
#define XB_SPIN_CAP (1u << 18)

__device__ __forceinline__ unsigned xb_ld(unsigned* p)              { return __hip_atomic_load(p, __ATOMIC_RELAXED, __HIP_MEMORY_SCOPE_AGENT); }
__device__ __forceinline__ unsigned xb_add(unsigned* p, unsigned v) { return __hip_atomic_fetch_add(p, v, __ATOMIC_RELAXED, __HIP_MEMORY_SCOPE_AGENT); }
__device__ __forceinline__ unsigned xb_xcc_id() { return (unsigned)__builtin_amdgcn_s_getreg((3 << 11) | 20) & 0xFu; }
#define XB_SPIN(cond, bar) do { unsigned _sp = 0; while (cond) { __builtin_amdgcn_s_sleep(1); \
    if ((++_sp & 255u) == 0u) { if (xb_ld(&(bar)[XB_TMO])) break; if (_sp > XB_SPIN_CAP) { atomicAdd(&(bar)[XB_TMO], 1u); break; } } } } while (0)

struct XcdBarrier {
    unsigned* bar; unsigned x;
    volatile LAS unsigned* st;
};

__device__ __forceinline__ XcdBarrier xcd_barrier_post(unsigned* bar, volatile LAS unsigned* st, int tid) {
    XcdBarrier b; b.bar = bar; b.x = xb_xcc_id(); b.st = st;
    if (tid == 0) (void)xb_add(&bar[XB_XCNT(b.x)], 1u);
    return b;
}
__device__ __forceinline__ void xcd_barrier_complete(unsigned* bar, unsigned x, unsigned& nloc, unsigned& nx) {
    const unsigned G = gridDim.x * gridDim.y * gridDim.z;
    unsigned sum, cnt, mine, sp = 0u;
    for (;;) {
        sum = 0u; cnt = 0u; mine = 0u;
#pragma unroll
        for (unsigned j = 0; j < 16; ++j) { const unsigned c = xb_ld(&bar[XB_XCNT(j)]); sum += c; cnt += (c > 0u) ? 1u : 0u; mine = (j == x) ? c : mine; }
        if (sum == G) break;
        __builtin_amdgcn_s_sleep(1);
        if ((++sp & 255u) == 0u) { if (xb_ld(&bar[XB_TMO])) break; if (sp > XB_SPIN_CAP) { atomicAdd(&bar[XB_TMO], 1u); break; } }
    }
    nloc = mine > 0u ? mine : 1u; nx = cnt > 0u ? cnt : 1u;
}

__device__ __forceinline__ void xcd_barrier(const XcdBarrier& b, int tid) {
    asm volatile("s_waitcnt vmcnt(0)" ::: "memory");
    __syncthreads();
    if (tid == 0) {
        unsigned* bar = b.bar;
        __builtin_amdgcn_s_waitcnt(0);
        unsigned nloc = b.st[0], nx = b.st[1];
        if (nloc == 0u) { xcd_barrier_complete(bar, b.x, nloc, nx); b.st[0] = nloc; b.st[1] = nx; }
        const unsigned old = xb_add(&bar[XB_XSUB(b.x)], 1u);
        const unsigned gen = old / nloc;
        if (old + 1u == (gen + 1u) * nloc) {
            __builtin_amdgcn_fence(__ATOMIC_RELEASE, "agent");
            asm volatile("s_waitcnt vmcnt(0)" ::: "memory");
            const unsigned og = xb_add(&bar[XB_TOP], 1u);
            const unsigned tg = og / nx;
            if (og + 1u == (tg + 1u) * nx) xb_add(&bar[XB_TOPGEN], 1u);
            else XB_SPIN(xb_ld(&bar[XB_TOPGEN]) == tg, bar);
            __builtin_amdgcn_fence(__ATOMIC_ACQUIRE, "agent");
            xb_add(&bar[XB_XGEN(b.x)], 1u);
            asm volatile("s_waitcnt vmcnt(0)" ::: "memory");
        } else {
            XB_SPIN(xb_ld(&bar[XB_XGEN(b.x)]) == gen, bar);
            __builtin_amdgcn_fence(__ATOMIC_ACQUIRE, "agent");
            asm volatile("s_waitcnt vmcnt(0)" ::: "memory");
        }
    }
    __syncthreads();
}

struct Args { const float* in[21]; float* out; unsigned char* ws; int ph_lo, ph_hi; };
enum { I_X = 0, I_N1 = 1, I_WIN = 2, I_LB = 3, I_HGN = 4, I_CW = 5, I_CB = 6, I_DTB = 7, I_ALOG = 8, I_DSK = 9, I_SSDN = 10, I_WSB = 11, I_WHG = 12, I_WSSD = 13, I_WOUT = 14,
       I_N2 = 15, I_WQ = 16, I_SK = 17, I_U = 18, I_V = 19, I_FN = 20 };
typedef const __attribute__((address_space(4))) Args* KArgs;
struct Frame {
    LAS unsigned char* lds;
    int tid, lane, wave, vcu, G, bx;
    KArgs ap;
};
#define WSP(T, off) ((T*)(F.ap->ws + (off)))

__device__ __forceinline__ void transpose_item(const float* W, int ldw, bf16* WT, int ldt, int nblk, LAS float* scr, int item, int lane) {
    const int kb = item / nblk, nb = item % nblk, k0 = 64 * kb, n0 = 64 * nb;
    f32x4 v[16];
#pragma unroll
    for (int i = 0; i < 16; ++i) v[i] = __builtin_nontemporal_load((const GAS f32x4*)(W + (size_t)(k0 + 4 * i + (lane >> 4)) * ldw + n0 + 4 * (lane & 15)));
#pragma unroll
    for (int i = 0; i < 16; ++i) { LAS float* d = scr + (4 * i + (lane >> 4)) * 65 + 4 * (lane & 15); d[0] = v[i].x; d[1] = v[i].y; d[2] = v[i].z; d[3] = v[i].w; }
    LDS_WAIT(); asm volatile("" ::: "memory");
    const int c = lane & 7;
#pragma unroll
    for (int j = 0; j < 8; ++j) { const int n = (lane >> 3) + 8 * j; const LAS float* s = scr + (8 * c) * 65 + n;
        v4u o; o.x = pk2(s[0 * 65], s[1 * 65]); o.y = pk2(s[2 * 65], s[3 * 65]); o.z = pk2(s[4 * 65], s[5 * 65]); o.w = pk2(s[6 * 65], s[7 * 65]);
        *(GAS v4u*)(WT + (size_t)(n0 + n) * ldt + k0 + 8 * c) = o; }
    LDS_WAIT(); asm volatile("" ::: "memory");
}
__device__ __forceinline__ void weff_item(Frame& F, const float* wq, const float* sk, bf16* WeffT, int item) {
    LAS float* skT = (LAS float*)F.lds;
    LAS float* wqT = (LAS float*)(F.lds + 128 * 132 * 4);
    const int g = item >> 4, d0 = (item & 15) * 64;
    for (int e = F.tid; e < 128 * 32; e += 512) { const int key = e >> 5, i4 = (e & 31) * 4; const f32x4 v = *(const GAS f32x4*)(sk + ((size_t)g * 128 + key) * 128 + i4);
        skT[(i4 + 0) * 132 + key] = v.x; skT[(i4 + 1) * 132 + key] = v.y; skT[(i4 + 2) * 132 + key] = v.z; skT[(i4 + 3) * 132 + key] = v.w; }
    for (int e = F.tid; e < 64 * 32; e += 512) { const int dl = e >> 5, i4 = (e & 31) * 4; const f32x4 v = *(const GAS f32x4*)(wq + (size_t)(d0 + dl) * 2048 + g * 128 + i4);
        wqT[(i4 + 0) * 68 + dl] = v.x; wqT[(i4 + 1) * 68 + dl] = v.y; wqT[(i4 + 2) * 68 + dl] = v.z; wqT[(i4 + 3) * 68 + dl] = v.w; }
    __syncthreads();
    const int ty = F.tid >> 4, tx = F.tid & 15;
    float acc[4][4];
#pragma unroll
    for (int a = 0; a < 4; ++a)
#pragma unroll
        for (int b = 0; b < 4; ++b) acc[a][b] = 0.f;
#pragma unroll 4
    for (int i = 0; i < 128; ++i) { const f32x4 a = *(const LAS f32x4*)(skT + i * 132 + 4 * ty), b = *(const LAS f32x4*)(wqT + i * 68 + 4 * tx);
#pragma unroll
        for (int p = 0; p < 4; ++p)
#pragma unroll
            for (int q = 0; q < 4; ++q) acc[p][q] += a[p] * b[q]; }
#pragma unroll
    for (int p = 0; p < 4; ++p) { v2u o; o.x = pk2(acc[p][0], acc[p][1]); o.y = pk2(acc[p][2], acc[p][3]);
        *(GAS v2u*)(WeffT + (size_t)(g * 128 + 4 * ty + p) * 1024 + d0 + 4 * tx) = o; }
    __syncthreads();
}
__device__ __forceinline__ void load_wdt(Frame& F, const float* w_in_l, LAS float* wdt) {
    for (int e = F.tid; e < 2048; e += 512) { const int d = e >> 1, hf = (e & 1) * 4; *(LAS f32x4*)(wdt + d * 8 + hf) = *(const GAS f32x4*)(w_in_l + (size_t)d * W_IN_COLS + W_DT_COL + hf); }
}
template <bool DO_DT> __device__ __forceinline__ void norm_row_from_regs(const f32x4 (&v)[4], const float* nw, bf16* xnrow, const LAS float* wdt, float* dtrow, int lane) {
    float s = 0.f;
#pragma unroll
    for (int j = 0; j < 4; ++j) s += (v[j].x * v[j].x + v[j].y * v[j].y) + (v[j].z * v[j].z + v[j].w * v[j].w);
    const float rstd = frsq(wave_sum(s, lane) * (1.f / DM) + EPS);
    f32x4 h[4];
#pragma unroll
    for (int j = 0; j < 4; ++j) { const f32x4 w = *(const GAS f32x4*)(nw + 4 * lane + 256 * j); h[j] = v[j] * rstd * w; }
    GAS unsigned long long* o8 = (GAS unsigned long long*)xnrow + lane;
#pragma unroll
    for (int j = 0; j < 4; ++j) o8[64 * j] = (unsigned long long)pk2(h[j].x, h[j].y) | ((unsigned long long)pk2(h[j].z, h[j].w) << 32);
    if constexpr (DO_DT) {
        float d[8];
#pragma unroll
        for (int q = 0; q < 8; ++q) d[q] = 0.f;
#pragma unroll
        for (int j = 0; j < 4; ++j)
#pragma unroll
            for (int e = 0; e < 4; ++e) { const float hv = __builtin_bit_cast(float, f2bf(h[j][e]) << 16);
                const LAS float* wp = wdt + (4 * lane + 256 * j + e) * 8; const f32x4 w0 = *(const LAS f32x4*)wp, w1 = *(const LAS f32x4*)(wp + 4);
                d[0] += hv * w0.x; d[1] += hv * w0.y; d[2] += hv * w0.z; d[3] += hv * w0.w; d[4] += hv * w1.x; d[5] += hv * w1.y; d[6] += hv * w1.z; d[7] += hv * w1.w; }
#pragma unroll
        for (int q = 0; q < 8; ++q) d[q] = wave_sum(d[q], lane);
        if (lane == 0) { *(GAS f32x4*)dtrow = (f32x4){d[0], d[1], d[2], d[3]}; *(GAS f32x4*)(dtrow + 4) = (f32x4){d[4], d[5], d[6], d[7]}; }
    }
}
constexpr int WT_NB_A = 4864 / 64, WT_NB_G = 3072 / 64;
constexpr int WT_I_A = 16 * WT_NB_A, WT_I_G = 16 * WT_NB_G, WT_I_BR = 8 * 16, WT_I_O = 16 * 16;
constexpr int WT_PER_LAYER = WT_I_A + WT_I_G + 3 * WT_I_BR + WT_I_O;
__device__ __forceinline__ void wt_item(Frame& F, int l, int r, LAS float* scr) {
    const float* win = F.ap->in[I_WIN] + (size_t)l * DM * W_IN_COLS; bf16* WinT = WSP(bf16, WS_WIN + (size_t)l * 16 * MiB);
    if (r < WT_I_A) { transpose_item(win, W_IN_COLS, WinT, DM, WT_NB_A, scr, r, F.lane); return; } r -= WT_I_A;
    if (r < WT_I_G) { transpose_item(win + W_GATE_COL, W_IN_COLS, WinT + (size_t)C_GATE * DM, DM, WT_NB_G, scr, r, F.lane); return; } r -= WT_I_G;
    bf16* WbrT = WSP(bf16, WS_WBR + (size_t)l * 3 * MiB);
    if (r < WT_I_BR) { transpose_item(F.ap->in[I_WSB] + (size_t)l * 512 * DM, DM, WbrT, 512, 16, scr, r, F.lane); return; } r -= WT_I_BR;
    if (r < WT_I_BR) { transpose_item(F.ap->in[I_WHG] + (size_t)l * 512 * DM, DM, WbrT + (size_t)1024 * 512, 512, 16, scr, r, F.lane); return; } r -= WT_I_BR;
    if (r < WT_I_BR) { transpose_item(F.ap->in[I_WSSD] + (size_t)l * 512 * DM, DM, WbrT + (size_t)2048 * 512, 512, 16, scr, r, F.lane); return; } r -= WT_I_BR;
    transpose_item(F.ap->in[I_WOUT] + (size_t)l * DM * DM, DM, WSP(bf16, WS_WOUT + (size_t)l * 2 * MiB), DM, 16, scr, r, F.lane);
}
__device__ __forceinline__ void p0_prologue(Frame& F) {
    const int gw = F.vcu * NWAVES + F.wave, NGW = F.G * NWAVES;
    {
        LAS float* scr = (LAS float*)(F.lds + F.wave * 16640);
        for (int it = gw; it < (MK_W1_LATE ? 1 : 2) * WT_PER_LAYER; it += NGW) { const int l = it / WT_PER_LAYER; wt_item(F, l, it - l * WT_PER_LAYER, scr); }
    }
    if (gw < 16) { const int l = gw >> 3, q = gw & 7; const float* win = F.ap->in[I_WIN] + (size_t)l * DM * W_IN_COLS + W_DT_COL + q; bf16* dst = WSP(bf16, WS_WIN + (size_t)l * 16 * MiB) + (size_t)(NP + q) * DM;
        for (int d = F.lane; d < DM; d += 64) dst[d] = (bf16)f2bf(win[(size_t)d * W_IN_COLS]); }
    __syncthreads();
    for (int it = F.vcu; it < 512; it += F.G) { const int l = it >> 8;
        weff_item(F, F.ap->in[I_WQ] + (size_t)l * DM * 2048, F.ap->in[I_SK] + (size_t)l * 16 * 128 * 128, WSP(bf16, WS_WEFF + (size_t)l * 4 * MiB), it & 255); }
    __syncthreads();
    { f32x4 nx[4];
      { const GAS f32x4* xr = (const GAS f32x4*)(F.ap->in[I_X] + (size_t)gw * DM) + F.lane;
#pragma unroll
        for (int j = 0; j < 4; ++j) nx[j] = xr[64 * j]; }
      for (int m = gw; m < TT; m += NGW) {
        f32x4 v[4];
#pragma unroll
        for (int j = 0; j < 4; ++j) v[j] = nx[j];
        if (m + NGW < TT) { const GAS f32x4* xr = (const GAS f32x4*)(F.ap->in[I_X] + (size_t)(m + NGW) * DM) + F.lane;
#pragma unroll
            for (int j = 0; j < 4; ++j) nx[j] = xr[64 * j]; }
        norm_row_from_regs<false>(v, F.ap->in[I_N1], XNP + (size_t)m * DM, (const LAS float*)F.lds, (float*)nullptr, F.lane);
      } }
    __syncthreads();
}
template <bool ISV> __device__ __forceinline__ void tables_items(Frame& F, int l, size_t i0, size_t step, size_t dstoff = (ISV ? WS_V8 : WS_U8)) {
    constexpr size_t N16 = (size_t)16384 * 1024 / 16;
    const float* T = F.ap->in[ISV ? I_V : I_U] + (size_t)l * 16384 * 1024; constexpr float sc = ISV ? 32.0f : 256.0f;
    for (size_t ib = i0; ib < N16; ib += 4 * step) {
        f32x4 a[4][4];
#pragma unroll
        for (int r = 0; r < 4; ++r) { const size_t j = ib + r * step; if (j < N16) {
#pragma unroll
            for (int q = 0; q < 4; ++q) a[r][q] = __builtin_nontemporal_load((const GAS f32x4*)(T + j * 16) + q); } }
#pragma unroll
        for (int r = 0; r < 4; ++r) { const size_t j = ib + r * step; if (j < N16) {
            v4u o;
#pragma unroll
            for (int q = 0; q < 4; ++q) { int p = 0; p = __builtin_amdgcn_cvt_pk_fp8_f32(a[r][q].x * sc, a[r][q].y * sc, p, false); p = __builtin_amdgcn_cvt_pk_fp8_f32(a[r][q].z * sc, a[r][q].w * sc, p, true); o[q] = (unsigned)p; }
            const size_t dst = (ISV || MK_UCOL) ? ((j & 63) >> 3) * (size_t)(16384 * 128) + (j >> 6) * 128 + (j & 7) * 16 : j * 16;
            *(GAS v4u*)(F.ap->ws + dstoff + dst) = o; } }
    }
}

__device__ __forceinline__ int crow(int r, int hi) { return (r & 3) + 8 * (r >> 2) + 4 * hi; }
__device__ __forceinline__ void sb_block(const f32x16& p, int kb  , int qi, float& R, float (&a)[16], int lane) {
    float beta[16], suf[16], tot[4], ptot[4];
#pragma unroll
    for (int g = 0; g < 4; ++g) {
        float omb[4];
#pragma unroll
        for (int i = 0; i < 4; ++i) { const int r = 4 * g + i; const float z = p[r] * 0.125f;
            const float e = __builtin_amdgcn_exp2f(-fabsf(z) * 1.4426950408889634f), rc = frcp(1.f + e), sm = e * rc;
            const bool pos = z >= 0.f, valid = (kb + i + 8 * g) < qi;
            beta[r] = valid ? (pos ? rc : sm) : 0.f; omb[i] = valid ? (pos ? sm : rc) : 1.f; }
        suf[4 * g + 3] = 1.f; suf[4 * g + 2] = omb[3]; suf[4 * g + 1] = omb[3] * omb[2]; suf[4 * g] = suf[4 * g + 1] * omb[1]; tot[g] = suf[4 * g] * omb[0];
    }
#pragma unroll
    for (int g = 0; g < 4; ++g) ptot[g] = shx(tot[g], 32, lane);
    const bool lo = lane < 32;
    float sp[4]; sp[3] = 1.f; sp[2] = tot[3] * ptot[3]; sp[1] = sp[2] * (tot[2] * ptot[2]); sp[0] = sp[1] * (tot[1] * ptot[1]);
    const float total = sp[0] * (tot[0] * ptot[0]);
#pragma unroll
    for (int g = 0; g < 4; ++g) { const float af = R * sp[g] * (lo ? ptot[g] : 1.f);
#pragma unroll
        for (int i = 0; i < 4; ++i) a[4 * g + i] = beta[4 * g + i] * af * suf[4 * g + i]; }
    R *= total;
}
__device__ __forceinline__ void sb_attn_wave(const bf16* PROJ, bf16* Y0, int b, int h, int qblk, LAS bf16* vt  , int lane) {
    const int r32 = lane & 31, hi = lane >> 5;
    const size_t rowbase = (size_t)b * SEQ;
    const int qw = qblk * 32, qi = qw + r32;
    bf16x8 qf[4];
    { const bf16* qp = PROJ + (rowbase + qi) * NP + C_SBQ + h * 64 + hi * 8;
#pragma unroll
      for (int d0 = 0; d0 < 4; ++d0) qf[d0] = *(const GAS bf16x8*)(qp + d0 * 16); }
    f32x16 o0 = {}, o1 = {};
    float R = 1.0f;
    for (int kt = (qw + 30) >> 6; kt >= 0; --kt) {
        const bf16* kp = PROJ + (rowbase + (size_t)kt * 64 + r32) * NP + C_SBK + h * 64 + hi * 8;
        bf16x8 kf0[4], kf1[4];
#pragma unroll
        for (int d0 = 0; d0 < 4; ++d0) { kf0[d0] = *(const GAS bf16x8*)(kp + d0 * 16); kf1[d0] = *(const GAS bf16x8*)(kp + (size_t)32 * NP + d0 * 16); }
        { const bf16* vp = PROJ + (rowbase + (size_t)kt * 64 + (lane >> 3)) * NP + C_SBV + h * 64 + (lane & 7) * 8;
          bf16x8 vv[8];
#pragma unroll
          for (int i = 0; i < 8; ++i) vv[i] = *(const GAS bf16x8*)(vp + (size_t)(8 * i) * NP);
#pragma unroll
          for (int i = 0; i < 8; ++i)
#pragma unroll
              for (int e = 0; e < 8; ++e) vt[((lane & 7) * 8 + e) * 72 + (lane >> 3) + 8 * i] = (bf16)vv[i][e]; }
        f32x16 p0 = {}, p1 = {};
#pragma unroll
        for (int d0 = 0; d0 < 4; ++d0) { p0 = MFMA32(kf0[d0], qf[d0], p0); p1 = MFMA32(kf1[d0], qf[d0], p1); }
        float a1[16], a0[16];
        sb_block(p1, kt * 64 + 32 + 4 * hi, qi, R, a1, lane);
        sb_block(p0, kt * 64 + 4 * hi, qi, R, a0, lane);
        bf16x8 pa[4]; pa[0] = pack8(a0); pa[1] = pack8(a0 + 8); pa[2] = pack8(a1); pa[3] = pack8(a1 + 8);
        LDS_WAIT();
#pragma unroll
        for (int s = 0; s < 4; ++s) {
            const LAS bf16* v0p = vt + r32 * 72 + 16 * s + 4 * hi; const LAS bf16* v1p = vt + (32 + r32) * 72 + 16 * s + 4 * hi;
            const v2u x0 = *(const LAS v2u*)v0p, x1 = *(const LAS v2u*)(v0p + 8), y0 = *(const LAS v2u*)v1p, y1 = *(const LAS v2u*)(v1p + 8);
            const bf16x8 vb0 = __builtin_bit_cast(bf16x8, (v4u){x0.x, x0.y, x1.x, x1.y}), vb1 = __builtin_bit_cast(bf16x8, (v4u){y0.x, y0.y, y1.x, y1.y});
            o0 = MFMA32(pa[s], vb0, o0); o1 = MFMA32(pa[s], vb1, o1);
        }
        LDS_WAIT();
        if (__all(R < 1e-37f)) break;
    }
    bf16* yp = Y0 + (rowbase + qw) * 512 + h * 64 + r32;
#pragma unroll
    for (int r = 0; r < 16; ++r) { const int q = crow(r, hi); yp[(size_t)q * 512] = (bf16)f2bf(o0[r]); yp[(size_t)q * 512 + 32] = (bf16)f2bf(o1[r]); }
}
__device__ __forceinline__ void p_sb_attn(Frame& F) {
    LAS bf16* vt = (LAS bf16*)(F.lds + F.wave * 9216);
    const int gw = F.vcu * NWAVES + F.wave, NGW = F.G * NWAVES;
    for (int u = gw, it_ = 0; u < 4096; u += NGW, ++it_) sb_attn_wave(WSP(bf16, WS_PROJ), WSP(bf16, WS_Y), u >> 11, (u >> 8) & 7, (it_ & 1) ? 255 - (u & 255) : (u & 255), vt, F.lane);
}

__device__ __forceinline__ float hg_lb(const float* lbl, int l, int kk) { return l == 0 ? 0.f : sigmoidf_(lbl[512 + kk] - lbl[kk]); }
__device__ __forceinline__ void ld8f(const LAS float* p, float* v) { const f32x4 a = *(const LAS f32x4*)p, b = *(const LAS f32x4*)(p + 4); v[0] = a.x; v[1] = a.y; v[2] = a.z; v[3] = a.w; v[4] = b.x; v[5] = b.y; v[6] = b.z; v[7] = b.w; }
constexpr int HG_P = 132;
__device__ __forceinline__ void hg_local_unit(Frame& F, int l, int b, int h, int c) {
    LAS float* Bc = (LAS float*)F.lds;
    LAS float* Ky = (LAS float*)(F.lds + 33792);
    LAS bf16* Vt = (LAS bf16*)(F.lds + 67584);
    LAS float* Sg = (LAS float*)(F.lds + 86016);
    const bf16* PROJ = WSP(bf16, WS_PROJ);
    const size_t row0 = (size_t)b * SEQ + (size_t)c * 64;
    const int tid = F.tid, lane = F.lane, w = F.wave, fr = lane & 15, quad = lane >> 4;
    float lbv[8];
#pragma unroll
    for (int j = 0; j < 8; ++j) lbv[j] = hg_lb(F.ap->in[I_LB], l, h * 128 + (tid & 15) * 8 + j);
    for (int e = tid; e < 64 * 16; e += 512) { const int t = e >> 4, k8 = (e & 15) * 8;
        float fv[8]; unpack8(*(const GAS v4u*)(PROJ + (row0 + t) * NP + C_HGF + h * 128 + k8), fv);
#pragma unroll
        for (int j = 0; j < 8; ++j) { const float lb = lbv[j];
            const float ee = fexp(-fabsf(fv[j])), rc = frcp(1.f + ee), sm = ee * rc; const bool pos = fv[j] >= 0.f;
            const float sg = pos ? rc : sm, sgn = pos ? sm : rc;
            const float f = lb + (1.f - lb) * sg;
            Bc[t * HG_P + k8 + j] = __logf(fmaxf(f, 1e-30f)); Ky[t * HG_P + k8 + j] = (1.f - lb) * sgn; }
        const v4u iv = *(const GAS v4u*)(PROJ + (row0 + t) * NP + C_HGI + h * 128 + k8);
        Vt[(k8 + 0) * 72 + t] = (bf16)(iv.x & 0xffff); Vt[(k8 + 1) * 72 + t] = (bf16)(iv.x >> 16); Vt[(k8 + 2) * 72 + t] = (bf16)(iv.y & 0xffff); Vt[(k8 + 3) * 72 + t] = (bf16)(iv.y >> 16);
        Vt[(k8 + 4) * 72 + t] = (bf16)(iv.z & 0xffff); Vt[(k8 + 5) * 72 + t] = (bf16)(iv.z >> 16); Vt[(k8 + 6) * 72 + t] = (bf16)(iv.w & 0xffff); Vt[(k8 + 7) * 72 + t] = (bf16)(iv.w >> 16); }
    __syncthreads();
    { const int seg = tid >> 7, k = tid & 127; float run = 0.f;
#pragma unroll
      for (int i = 0; i < 16; ++i) { run += Bc[(seg * 16 + i) * HG_P + k]; Bc[(seg * 16 + i) * HG_P + k] = run; }
      Sg[seg * 128 + k] = run;
      __syncthreads();
      float off = 0.f;
#pragma unroll
      for (int s = 0; s < 3; ++s) if (s < seg) off += Sg[s * 128 + k];
      if (seg)
#pragma unroll
          for (int i = 0; i < 16; ++i) Bc[(seg * 16 + i) * HG_P + k] += off; }
    __syncthreads();
    if (tid < 128) WSP(float, WS_DCH)[(((size_t)(b * 4 + h)) * 128 + c) * 128 + tid] = fexp(Bc[63 * HG_P + tid]);
    {
        const int I = (w < 4) ? (w >> 1) : 3 - ((w - 4) >> 1), vh = w & 1;
        const int tl = 16 * I + fr;
        bf16x8 bq[4];
#pragma unroll
        for (int ks = 0; ks < 4; ++ks) { const int k0 = 32 * ks + 8 * quad;
            float qv[8], bt[8], rf[8], o[8], oq[8];
            unpack8(*(const GAS v4u*)(PROJ + (row0 + tl) * NP + C_HGQ + h * 128 + k0), qv);
            ld8f(Bc + tl * HG_P + k0, bt);
            if (I > 0) ld8f(Bc + (16 * I - 1) * HG_P + k0, rf); else {
#pragma unroll
                for (int j = 0; j < 8; ++j) rf[j] = 0.f; }
#pragma unroll
            for (int j = 0; j < 8; ++j) { const float qs = siluf_(qv[j]) * 0.08838834764831845f; o[j] = qs * fexp(bt[j] - rf[j]); oq[j] = qs * fexp(bt[j]); }
            bq[ks] = pack8(o);
            if (vh == 0) *(GAS bf16x8*)(WSP(bf16, WS_QT) + (row0 + tl) * 512 + h * 128 + k0) = pack8(oq);
        }
        f32x4 sT[4];
#pragma unroll
        for (int J = 0; J < 4; ++J) { sT[J] = (f32x4){0.f, 0.f, 0.f, 0.f};
            if (J <= I) { const int sl = 16 * J + fr;
#pragma unroll
                for (int ks = 0; ks < 4; ++ks) { const int k0 = 32 * ks + 8 * quad; float kv[8], bs[8], rf[8], o[8];
                    ld8f(Ky + sl * HG_P + k0, kv); ld8f(Bc + sl * HG_P + k0, bs);
                    if (I > 0) ld8f(Bc + (16 * I - 1) * HG_P + k0, rf); else {
#pragma unroll
                        for (int j = 0; j < 8; ++j) rf[j] = 0.f; }
#pragma unroll
                    for (int j = 0; j < 8; ++j) o[j] = kv[j] * fexp(fminf(rf[j] - bs[j], 80.f));
                    sT[J] = MFMA16(pack8(o), bq[ks], sT[J]); }
                if (J == I) {
#pragma unroll
                    for (int r = 0; r < 4; ++r) if (4 * quad + r > fr) sT[J][r] = 0.f; }
            } }
        bf16x8 bs0, bs1;
        { float t0[8] = {sT[0][0], sT[0][1], sT[0][2], sT[0][3], sT[1][0], sT[1][1], sT[1][2], sT[1][3]}; bs0 = pack8(t0);
          float t1[8] = {sT[2][0], sT[2][1], sT[2][2], sT[2][3], sT[3][0], sT[3][1], sT[3][2], sT[3][3]}; bs1 = pack8(t1); }
#pragma unroll
        for (int vi = 0; vi < 4; ++vi) { const int vb = vh * 4 + vi; const LAS bf16* vp = Vt + (16 * vb + fr) * 72 + 4 * quad;
            f32x4 acc = {0.f, 0.f, 0.f, 0.f};
            { const v2u x0 = *(const LAS v2u*)vp, x1 = *(const LAS v2u*)(vp + 16); acc = MFMA16(__builtin_bit_cast(bf16x8, (v4u){x0.x, x0.y, x1.x, x1.y}), bs0, acc); }
            if (I >= 2) { const v2u x0 = *(const LAS v2u*)(vp + 32), x1 = *(const LAS v2u*)(vp + 48); acc = MFMA16(__builtin_bit_cast(bf16x8, (v4u){x0.x, x0.y, x1.x, x1.y}), bs1, acc); }
            v2u o; o.x = pk2(acc[0], acc[1]); o.y = pk2(acc[2], acc[3]);
            *(GAS v2u*)(WSP(bf16, WS_OI) + (row0 + tl) * 512 + h * 128 + 16 * vb + 4 * quad) = o; }
    }
    {
        const int k = 16 * w + fr; const float bl = Bc[63 * HG_P + k];
        bf16x8 bk[2];
#pragma unroll
        for (int ks = 0; ks < 2; ++ks) { float o[8];
#pragma unroll
            for (int j = 0; j < 8; ++j) { const int s = 32 * ks + 8 * quad + j; o[j] = Ky[s * HG_P + k] * fexp(bl - Bc[s * HG_P + k]); }
            bk[ks] = pack8(o); }
        bf16* S = WSP(bf16, WS_HGS) + (((size_t)(b * 4 + h)) * 128 + c) * 16384;
#pragma unroll
        for (int vb = 0; vb < 8; ++vb) { f32x4 acc = {0.f, 0.f, 0.f, 0.f};
#pragma unroll
            for (int ks = 0; ks < 2; ++ks) acc = MFMA16(*(const LAS bf16x8*)(Vt + (16 * vb + fr) * 72 + 32 * ks + 8 * quad), bk[ks], acc);
#pragma unroll
            for (int r = 0; r < 4; ++r) S[(size_t)(16 * vb + 4 * quad + r) * 128 + k] = (bf16)f2bf(acc[r]); }
    }
    __syncthreads();
}
struct HgOutRegs { v4u qv[2]; bf16x8 af[4]; v2u oiv[4], gvv[4]; };
__device__ __forceinline__ void hg_out_load(Frame& F, int b, int h, int c, HgOutRegs& R) {
    const bf16* PROJ = WSP(bf16, WS_PROJ);
    const size_t row0 = (size_t)b * SEQ + (size_t)c * 64;
    const int lane = F.lane, w = F.wave, fr = lane & 15, quad = lane >> 4;
    const bf16* S = WSP(bf16, WS_HGS) + (((size_t)(b * 4 + h)) * 128 + c) * 16384;
#pragma unroll
    for (int it = 0; it < 2; ++it) { const int e = F.tid + 512 * it; R.qv[it] = *(const GAS v4u*)(WSP(bf16, WS_QT) + (row0 + (e >> 4)) * 512 + h * 128 + (e & 15) * 8); }
#pragma unroll
    for (int ks = 0; ks < 4; ++ks) R.af[ks] = *(const GAS bf16x8*)(S + (size_t)(16 * w + fr) * 128 + 32 * ks + 8 * quad);
#pragma unroll
    for (int tb = 0; tb < 4; ++tb) { R.oiv[tb] = *(const GAS v2u*)(WSP(bf16, WS_OI) + (row0 + 16 * tb + fr) * 512 + h * 128 + 16 * w + 4 * quad); R.gvv[tb] = *(const GAS v2u*)(PROJ + (row0 + 16 * tb + fr) * NP + C_HGG + h * 128 + 16 * w + 4 * quad); }
}
__device__ __forceinline__ void hg_out_compute(Frame& F, int l, int b, int h, int c, const HgOutRegs& R) {
    LAS float* SS = (LAS float*)F.lds;
    const size_t row0 = (size_t)b * SEQ + (size_t)c * 64;
    const int lane = F.lane, w = F.wave, fr = lane & 15, quad = lane >> 4;
    LAS bf16* Qs = (LAS bf16*)(F.lds + 2048);
    const f32x4 nw = *(const GAS f32x4*)(F.ap->in[I_HGN] + (size_t)l * 128 + 16 * w + 4 * quad);
#pragma unroll
    for (int it = 0; it < 2; ++it) { const int e = F.tid + 512 * it; *(LAS v4u*)(Qs + (e >> 4) * 136 + (e & 15) * 8) = R.qv[it]; }
    __syncthreads();
    f32x4 o[4];
#pragma unroll
    for (int tb = 0; tb < 4; ++tb) { o[tb] = (f32x4){0.f, 0.f, 0.f, 0.f};
#pragma unroll
        for (int ks = 0; ks < 4; ++ks) o[tb] = MFMA16(R.af[ks], *(const LAS bf16x8*)(Qs + (16 * tb + fr) * 136 + 32 * ks + 8 * quad), o[tb]);
        const v2u oi = R.oiv[tb];
        o[tb][0] += bflo(oi.x); o[tb][1] += bfhi(oi.x); o[tb][2] += bflo(oi.y); o[tb][3] += bfhi(oi.y);
        float ss = (o[tb][0] * o[tb][0] + o[tb][1] * o[tb][1]) + (o[tb][2] * o[tb][2] + o[tb][3] * o[tb][3]);
        ss += shx(ss, 16, lane); ss += shx(ss, 32, lane);
        if (quad == 0) SS[w * 64 + 16 * tb + fr] = ss; }
    __syncthreads();
#pragma unroll
    for (int tb = 0; tb < 4; ++tb) { const int t = 16 * tb + fr; float tot = 0.f;
#pragma unroll
        for (int ww = 0; ww < 8; ++ww) tot += SS[ww * 64 + t];
        const float rstd = frsq(tot * (1.f / 128.f) + EPS);
        const v2u gv = R.gvv[tb];
        const float y0 = o[tb][0] * rstd * nw.x * siluf_(bflo(gv.x)), y1 = o[tb][1] * rstd * nw.y * siluf_(bfhi(gv.x)), y2 = o[tb][2] * rstd * nw.z * siluf_(bflo(gv.y)), y3 = o[tb][3] * rstd * nw.w * siluf_(bfhi(gv.y));
        v2u ov; ov.x = pk2(y0, y1); ov.y = pk2(y2, y3);
        *(GAS v2u*)(WSP(bf16, WS_Y) + (size_t)TT * 512 + (row0 + t) * 512 + h * 128 + 16 * w + 4 * quad) = ov; }
    __syncthreads();
}
__device__ __forceinline__ void hg_out_units(Frame& F, int l, int first, int stride) {
    if (first >= 1024) return;
    HgOutRegs Ra, Rb;
#define HGO_B(u) ((u) >> 9)
#define HGO_H(u) (((u) >> 7) & 3)
#define HGO_C(u) ((u) & 127)
    hg_out_load(F, HGO_B(first), HGO_H(first), HGO_C(first), Ra);
    for (int u = first; u < 1024; u += 2 * stride) {
        const int u1 = u + stride, u2 = u + 2 * stride;
        { const int un = u1 < 1024 ? u1 : u; hg_out_load(F, HGO_B(un), HGO_H(un), HGO_C(un), Rb); }
        hg_out_compute(F, l, HGO_B(u), HGO_H(u), HGO_C(u), Ra);
        if (u1 >= 1024) break;
        { const int un = u2 < 1024 ? u2 : u1; hg_out_load(F, HGO_B(un), HGO_H(un), HGO_C(un), Ra); }
        hg_out_compute(F, l, HGO_B(u1), HGO_H(u1), HGO_C(u1), Rb);
    }
#undef HGO_B
#undef HGO_H
#undef HGO_C
}

constexpr int SL_CM = 0, SL_BM = 18432, SL_BT = 36864, SL_XT = 54272, SL_AC = 123904, SL_DT = 125952;
#define SL_SWZ(row) ((((row) >> 3) & 15) << 3)
__device__ __forceinline__ void ssd_local_unit(Frame& F, int l, int b, int c, int g) {
    LAS bf16* Cm = (LAS bf16*)(F.lds + SL_CM); LAS bf16* Bm = (LAS bf16*)(F.lds + SL_BM); LAS bf16* Bt = (LAS bf16*)(F.lds + SL_BT); LAS bf16* Xt = (LAS bf16*)(F.lds + SL_XT);
    LAS float* AC = (LAS float*)(F.lds + SL_AC); LAS float* DT = (LAS float*)(F.lds + SL_DT);
    const bf16* PROJ = WSP(bf16, WS_PROJ);
    const size_t row0 = (size_t)b * SEQ + (size_t)c * 128;
    const int tid = F.tid, lane = F.lane, w = F.wave, fr = lane & 15, quad = lane >> 4;
    if (w < 4) { const int head = 4 * g + w; const float bias = F.ap->in[I_DTB][l * 8 + head], A = -fexp(F.ap->in[I_ALOG][l * 8 + head]);
        float dt[2], a[2];
#pragma unroll
        for (int i = 0; i < 2; ++i) { const float x = WSP(float, WS_DT)[(row0 + 2 * lane + i) * 8 + head] + bias; dt[i] = x > 20.f ? x : __logf(1.f + fexp(x)); a[i] = A * dt[i]; }
        float v = a[0] + a[1], inc = v;
#pragma unroll
        for (int o = 1; o < 64; o <<= 1) { const float t = shi(inc, lane >= o ? lane - o : lane); if (lane >= o) inc += t; }
        const float ex = inc - v;
        AC[w * 128 + 2 * lane] = ex + a[0]; AC[w * 128 + 2 * lane + 1] = ex + v; DT[w * 128 + 2 * lane] = dt[0]; DT[w * 128 + 2 * lane + 1] = dt[1]; }
    if (tid < 384) { const float* cw = F.ap->in[I_CW] + (size_t)l * 4 * 768; const float* cb = F.ap->in[I_CB] + (size_t)l * 768;
        const int cgp = tid % 48, rb = tid / 48;
        const int ch = cgp < 32 ? 256 * g + 8 * cgp : (cgp < 40 ? 512 + 64 * g + 8 * (cgp - 32) : 640 + 64 * g + 8 * (cgp - 40));
        f32x4 wk[4][2];
#pragma unroll
        for (int k = 0; k < 4; ++k) { wk[k][0] = *(const GAS f32x4*)(cw + k * 768 + ch); wk[k][1] = *(const GAS f32x4*)(cw + k * 768 + ch + 4); }
        const f32x4 b0 = *(const GAS f32x4*)(cb + ch), b1 = *(const GAS f32x4*)(cb + ch + 4);
#pragma unroll 1
        for (int hf = 0; hf < 2; ++hf) {
        v4u xr[11];
#pragma unroll
        for (int i = 0; i < 11; ++i) { const int lt = 16 * rb + 8 * hf - 3 + i; const bool ok = c > 0 || lt >= 0;
            xr[i] = *(const GAS v4u*)(PROJ + (size_t)((long)row0 + (ok ? lt : 0)) * NP + C_XBC + ch); if (!ok) xr[i] = (v4u){0u, 0u, 0u, 0u}; }
#pragma unroll
        for (int j = 0; j < 8; ++j) { const int lr = 16 * rb + 8 * hf + j;
            float acc[8] = {b0.x, b0.y, b0.z, b0.w, b1.x, b1.y, b1.z, b1.w};
#pragma unroll
            for (int k = 0; k < 4; ++k) { float xv[8]; unpack8(xr[j + k], xv);
                acc[0] += wk[k][0].x * xv[0]; acc[1] += wk[k][0].y * xv[1]; acc[2] += wk[k][0].z * xv[2]; acc[3] += wk[k][0].w * xv[3]; acc[4] += wk[k][1].x * xv[4]; acc[5] += wk[k][1].y * xv[5]; acc[6] += wk[k][1].z * xv[6]; acc[7] += wk[k][1].w * xv[7]; }
#pragma unroll
            for (int q = 0; q < 8; ++q) acc[q] = siluf_(acc[q]);
            if (cgp < 32) {
#pragma unroll
                for (int q = 0; q < 8; ++q) Xt[(8 * cgp + q) * 136 + (lr ^ SL_SWZ(8 * cgp + q))] = (bf16)f2bf(acc[q]);
            } else if (cgp < 40) { const int n0 = 8 * (cgp - 32); *(LAS bf16x8*)(Bm + lr * 72 + n0) = pack8(acc);
#pragma unroll
                for (int q = 0; q < 8; ++q) Bt[(n0 + q) * 136 + (lr ^ SL_SWZ(n0 + q))] = (bf16)f2bf(acc[q]);
            } else { const int n0 = 8 * (cgp - 40); *(LAS bf16x8*)(Cm + lr * 72 + n0) = pack8(acc); } } } }
    __syncthreads();
    for (int e = tid; e < 128 * 32; e += 512) { const int lr = e >> 5, hh = (e >> 3) & 3, n8 = (e & 7) * 8; float cv[8]; unpack8(*(const LAS v4u*)(Cm + lr * 72 + n8), cv);
        const float ea = fexp(AC[hh * 128 + lr]);
#pragma unroll
        for (int j = 0; j < 8; ++j) cv[j] *= ea;
        *(GAS bf16x8*)(WSP(bf16, WS_CE) + (row0 + lr) * 512 + (4 * g + hh) * 64 + n8) = pack8(cv); }
    if (tid < 4) WSP(float, WS_ATOT)[((size_t)b * 64 + c) * 8 + 4 * g + tid] = AC[tid * 128 + 127];
    for (int ps_ = 0; ps_ < 2; ++ps_) { const int wq = ps_ ? 7 - w : w;
        const int ll = 16 * wq + fr;
        bf16x8 cf[2];
#pragma unroll
        for (int ks = 0; ks < 2; ++ks) cf[ks] = *(const LAS bf16x8*)(Cm + ll * 72 + 32 * ks + 8 * quad);
        f32x4 gT[8];
#pragma unroll
        for (int sb = 0; sb < 8; ++sb) { gT[sb] = (f32x4){0.f, 0.f, 0.f, 0.f};
            if (sb <= wq) {
#pragma unroll
                for (int ks = 0; ks < 2; ++ks) gT[sb] = MFMA16(*(const LAS bf16x8*)(Bm + (16 * sb + fr) * 72 + 32 * ks + 8 * quad), cf[ks], gT[sb]); } }
#pragma unroll 1
        for (int hh = 2 * ps_; hh < 2 * ps_ + 2; ++hh) { const int head = 4 * g + hh; const float al = AC[hh * 128 + ll], dsk = F.ap->in[I_DSK][l * 8 + head];
            f32x4 yT[4];
#pragma unroll
            for (int pb = 0; pb < 4; ++pb) yT[pb] = (f32x4){0.f, 0.f, 0.f, 0.f};
#pragma unroll
            for (int pj = 0; pj < 4; ++pj) if (2 * pj <= wq) {
                float o[8];
#pragma unroll
                for (int j = 0; j < 8; ++j) { const int sb = 2 * pj + (j >> 2), s = 16 * sb + 4 * quad + (j & 3);
                    const float gv = (j < 4) ? gT[2 * pj][j & 3] : gT[2 * pj + 1][j & 3];
                    float v = gv * fexp(fminf(al - AC[hh * 128 + s], 0.f)) * DT[hh * 128 + s];
                    if (s == ll) v += dsk;
                    o[j] = (s <= ll) ? v : 0.f; }
                const bf16x8 bfr = pack8(o);
#pragma unroll
                for (int pb = 0; pb < 4; ++pb) { const int xr_ = hh * 64 + 16 * pb + fr; const LAS bf16* xp = Xt + xr_ * 136;
                    const v2u x0 = *(const LAS v2u*)(xp + ((32 * pj + 4 * quad) ^ SL_SWZ(xr_))), x1 = *(const LAS v2u*)(xp + ((32 * pj + 4 * quad + 16) ^ SL_SWZ(xr_)));
                    yT[pb] = MFMA16(__builtin_bit_cast(bf16x8, (v4u){x0.x, x0.y, x1.x, x1.y}), bfr, yT[pb]); } }
#pragma unroll
            for (int pb = 0; pb < 4; ++pb) { v2u ov; ov.x = pk2(yT[pb][0], yT[pb][1]); ov.y = pk2(yT[pb][2], yT[pb][3]);
                *(GAS v2u*)(WSP(bf16, WS_YD) + (row0 + ll) * 512 + head * 64 + 16 * pb + 4 * quad) = ov; } }
    }
    {
        const int hh = w >> 1, head = 4 * g + hh, pb0 = (w & 1) * 2; const float alast = AC[hh * 128 + 127];
        f32x4 st[2][4];
#pragma unroll
        for (int i = 0; i < 2; ++i)
#pragma unroll
            for (int nb = 0; nb < 4; ++nb) st[i][nb] = (f32x4){0.f, 0.f, 0.f, 0.f};
#pragma unroll
        for (int ks = 0; ks < 4; ++ks) { const int s0 = 32 * ks + 8 * quad; float wv[8];
#pragma unroll
            for (int j = 0; j < 8; ++j) wv[j] = fexp(alast - AC[hh * 128 + s0 + j]) * DT[hh * 128 + s0 + j];
            bf16x8 xa[2];
#pragma unroll
            for (int i = 0; i < 2; ++i) { const int xr_ = hh * 64 + 16 * (pb0 + i) + fr; xa[i] = *(const LAS bf16x8*)(Xt + xr_ * 136 + (s0 ^ SL_SWZ(xr_))); }
#pragma unroll
            for (int nb = 0; nb < 4; ++nb) { float bv[8]; unpack8(*(const LAS v4u*)(Bt + (16 * nb + fr) * 136 + (s0 ^ SL_SWZ(16 * nb + fr))), bv);
#pragma unroll
                for (int j = 0; j < 8; ++j) bv[j] *= wv[j];
                const bf16x8 bfr = pack8(bv);
#pragma unroll
                for (int i = 0; i < 2; ++i) st[i][nb] = MFMA16(xa[i], bfr, st[i][nb]); } }
        bf16* S = WSP(bf16, WS_SSDS) + ((((size_t)b * 64 + c) * 8 + head) * 4096);
#pragma unroll
        for (int i = 0; i < 2; ++i)
#pragma unroll
            for (int nb = 0; nb < 4; ++nb)
#pragma unroll
                for (int r = 0; r < 4; ++r) S[(size_t)(16 * (pb0 + i) + 4 * quad + r) * 64 + 16 * nb + fr] = (bf16)f2bf(st[i][nb][r]);
    }
    __syncthreads();
}
__device__ __forceinline__ void ssd_out_unit(Frame& F, int l, int b, int c, int g) {
    const bf16* PROJ = WSP(bf16, WS_PROJ);
    const size_t row0 = (size_t)b * SEQ + (size_t)c * 128;
    const int lane = F.lane, w = F.wave, fr = lane & 15, quad = lane >> 4;
    const size_t row = row0 + 16 * w + fr;
    f32x4 yT[4][4]; float ss = 0.f;
#pragma unroll
    for (int hh = 0; hh < 4; ++hh) { const int head = 4 * g + hh;
        bf16x8 cf[2];
#pragma unroll
        for (int ks = 0; ks < 2; ++ks) cf[ks] = *(const GAS bf16x8*)(WSP(bf16, WS_CE) + row * 512 + head * 64 + 32 * ks + 8 * quad);
        const bf16* S = WSP(bf16, WS_SSDS) + ((((size_t)b * 64 + c) * 8 + head) * 4096);
#pragma unroll
        for (int pb = 0; pb < 4; ++pb) { f32x4 acc = {0.f, 0.f, 0.f, 0.f};
#pragma unroll
            for (int ks = 0; ks < 2; ++ks) acc = MFMA16(*(const GAS bf16x8*)(S + (size_t)(16 * pb + fr) * 64 + 32 * ks + 8 * quad), cf[ks], acc);
            const int col = head * 64 + 16 * pb + 4 * quad;
            const v2u yd = *(const GAS v2u*)(WSP(bf16, WS_YD) + row * 512 + col), zv = *(const GAS v2u*)(PROJ + row * NP + C_SSDZ + col);
            acc[0] = (acc[0] + bflo(yd.x)) * siluf_(bflo(zv.x)); acc[1] = (acc[1] + bfhi(yd.x)) * siluf_(bfhi(zv.x)); acc[2] = (acc[2] + bflo(yd.y)) * siluf_(bflo(zv.y)); acc[3] = (acc[3] + bfhi(yd.y)) * siluf_(bfhi(zv.y));
            ss += (acc[0] * acc[0] + acc[1] * acc[1]) + (acc[2] * acc[2] + acc[3] * acc[3]);
            yT[hh][pb] = acc; } }
    ss += shx(ss, 16, lane); ss += shx(ss, 32, lane);
    const float rstd = frsq(ss * (1.f / 256.f) + EPS);
#pragma unroll
    for (int hh = 0; hh < 4; ++hh)
#pragma unroll
        for (int pb = 0; pb < 4; ++pb) { const int col = (4 * g + hh) * 64 + 16 * pb + 4 * quad; const f32x4 nw = *(const GAS f32x4*)(F.ap->in[I_SSDN] + (size_t)l * 512 + col);
            v2u ov; ov.x = pk2(yT[hh][pb][0] * rstd * nw.x, yT[hh][pb][1] * rstd * nw.y); ov.y = pk2(yT[hh][pb][2] * rstd * nw.z, yT[hh][pb][3] * rstd * nw.w);
            *(GAS v2u*)(WSP(bf16, WS_Y) + (size_t)2 * TT * 512 + row * 512 + col) = ov; }
}
template <bool DRY> __device__ __forceinline__ void p_scan(Frame& F) {
    if (F.wave < 4) {
        const int gt = F.vcu * 256 + F.tid;
        if (gt < 65536) {
        const int bh = gt >> 13, pr = gt & 8191, k = (2 * pr) & 127;
        unsigned* S = (unsigned*)(WSP(bf16, WS_HGS) + (size_t)bh * 128 * 16384) + pr; const float* D = WSP(float, WS_DCH) + (size_t)bh * 128 * 128 + k;
        float r0 = 0.f, r1 = 0.f;
        unsigned xa[16], xb[16]; f32x2 da[16], db[16];
#define SC_LD(X_, D_, c0) do { _Pragma("unroll") for (int i = 0; i < 16; ++i) { X_[i] = __builtin_nontemporal_load((const GAS unsigned*)(S + (size_t)((c0) + i) * 8192)); D_[i] = *(const GAS f32x2*)(D + (size_t)((c0) + i) * 128); } } while (0)
#define SC_PROC(X_, D_, c0) do { _Pragma("unroll") for (int i = 0; i < 16; ++i) { const unsigned pv = pk2(r0, r1); if constexpr (!DRY) *(GAS unsigned*)(S + (size_t)((c0) + i) * 8192) = pv; else asm volatile("" :: "v"(pv)); r0 = r0 * D_[i].x + bflo(X_[i]); r1 = r1 * D_[i].y + bfhi(X_[i]); } } while (0)
        SC_LD(xa, da, 0);
        for (int c0 = 0; c0 < 128; c0 += 32) { SC_LD(xb, db, c0 + 16); SC_PROC(xa, da, c0); if (c0 + 32 < 128) SC_LD(xa, da, c0 + 32); SC_PROC(xb, db, c0 + 16); }
#undef SC_LD
#undef SC_PROC
        }
    } else if (F.wave < 6) {
        const int e = F.vcu * 128 + (F.tid - 256);
        if (e < 32768) {
        const int bh = e >> 11, pr = e & 2047, b = bh >> 3, h = bh & 7;
        unsigned* S = (unsigned*)(WSP(bf16, WS_SSDS) + ((size_t)b * 64 * 8 + h) * 4096) + pr; const float* A = WSP(float, WS_ATOT) + (size_t)b * 64 * 8 + h;
        float r0 = 0.f, r1 = 0.f;
        unsigned xa[16], xb[16]; float da[16], db[16];
#define SC_LD(X_, D_, c0) do { _Pragma("unroll") for (int i = 0; i < 16; ++i) { X_[i] = __builtin_nontemporal_load((const GAS unsigned*)(S + (size_t)((c0) + i) * 8 * 2048)); D_[i] = A[(size_t)((c0) + i) * 8]; } } while (0)
#define SC_PROC(X_, D_, c0) do { _Pragma("unroll") for (int i = 0; i < 16; ++i) { const unsigned pv = pk2(r0, r1); if constexpr (!DRY) *(GAS unsigned*)(S + (size_t)((c0) + i) * 8 * 2048) = pv; else asm volatile("" :: "v"(pv)); const float dd = fexp(D_[i]); r0 = r0 * dd + bflo(X_[i]); r1 = r1 * dd + bfhi(X_[i]); } } while (0)
        SC_LD(xa, da, 0);
        for (int c0 = 0; c0 < 64; c0 += 32) { SC_LD(xb, db, c0 + 16); SC_PROC(xa, da, c0); if (c0 + 32 < 64) SC_LD(xa, da, c0 + 32); SC_PROC(xb, db, c0 + 16); }
#undef SC_LD
#undef SC_PROC
        }
    }
}
#ifndef MK_X0
#define MK_X0 xcc_id()
#endif
#ifndef MK_UNEW_OUT
#define MK_UNEW_OUT WS_W2
#endif

typedef __bf16 bf16x2_t __attribute__((ext_vector_type(2)));
__device__ __forceinline__ float dot2bf(unsigned a, unsigned b, float c) { return __builtin_amdgcn_fdot2_f32_bf16(__builtin_bit_cast(bf16x2_t, a), __builtin_bit_cast(bf16x2_t, b), c, false); }
__device__ __forceinline__ void ins16(float (&top)[16], float x) {
#pragma unroll
    for (int i = 0; i < 16; ++i) { const float hi = __builtin_fmaxf(top[i], x); x = __builtin_fminf(top[i], x); top[i] = hi; }
}
#define CEX(a, b) do { const float hi_ = __builtin_fmaxf(a, b), lo_ = __builtin_fminf(a, b); a = hi_; b = lo_; } while (0)
__device__ __forceinline__ void sort16_desc(float (&v)[16]) {
#define S2(a, b) CEX(v[a], v[b])
    S2(0,13); S2(1,12); S2(2,15); S2(3,14); S2(4,8); S2(5,6); S2(7,11); S2(9,10);
    S2(0,5); S2(1,7); S2(2,9); S2(3,4); S2(6,13); S2(8,14); S2(10,15); S2(11,12);
    S2(0,1); S2(2,3); S2(4,5); S2(6,8); S2(7,9); S2(10,11); S2(12,13); S2(14,15);
    S2(0,2); S2(1,3); S2(4,10); S2(5,11); S2(6,7); S2(8,9); S2(12,14); S2(13,15);
    S2(1,2); S2(3,12); S2(4,6); S2(5,7); S2(8,10); S2(9,11); S2(13,14);
    S2(1,4); S2(2,6); S2(5,8); S2(7,10); S2(9,13); S2(11,14);
    S2(2,4); S2(3,6); S2(9,12); S2(11,13);
    S2(3,5); S2(6,8); S2(7,9); S2(10,12);
    S2(3,4); S2(5,6); S2(7,8); S2(9,10); S2(11,12);
    S2(6,7); S2(8,9);
#undef S2
}
__device__ __forceinline__ void merge16_desc(float (&a)[16], const float (&b)[16]) {
#pragma unroll
    for (int i = 0; i < 16; ++i) a[i] = __builtin_fmaxf(a[i], b[15 - i]);
#pragma unroll
    for (int j = 8; j > 0; j >>= 1)
#pragma unroll
        for (int i = 0; i < 16; ++i) { const int l = i ^ j; if (l > i) CEX(a[i], a[l]); }
}
__device__ __forceinline__ void top16_half(float (&top)[16], const _Float16* base) {
#pragma unroll 1
    for (int g0 = 0; g0 < 8; ++g0) { float x[16];
#pragma unroll
        for (int i = 0; i < 16; ++i) x[i] = (float)__builtin_nontemporal_load((const GAS _Float16*)(base + (size_t)(16 * g0 + i) * TT));
#pragma unroll
        for (int i = 0; i < 16; ++i) x[i] = __builtin_bit_cast(float, (__builtin_bit_cast(unsigned, x[i]) & ~127u) | (unsigned)(16 * g0 + i));
        sort16_desc(x);
        if (g0 == 0) {
#pragma unroll
            for (int i = 0; i < 16; ++i) top[i] = x[i];
        } else merge16_desc(top, x);
    }
}
__device__ __forceinline__ float mkc(float a, float b, unsigned code) { return __builtin_bit_cast(float, (__builtin_bit_cast(unsigned, a + b) & ~255u) | code); }
constexpr int PL_SELB = 0, PL_IDX = 16384, PL_GATE = 32768;
constexpr int CW_PEER = 8192;
__device__ __forceinline__ unsigned xcc_id() { return (unsigned)__builtin_amdgcn_s_getreg((3 << 11) | 20) & 7u; }
__device__ __forceinline__ float row_rstd(const float* ssq, size_t tok) { const f32x4 a = *(const GAS f32x4*)(ssq + tok * 16), b = *(const GAS f32x4*)(ssq + tok * 16 + 4), c = *(const GAS f32x4*)(ssq + tok * 16 + 8), d = *(const GAS f32x4*)(ssq + tok * 16 + 12);
    const f32x4 s = (a + b) + (c + d); return frsq(((s.x + s.y) + (s.z + s.w)) * (1.f / DM) + EPS); }
__device__ __forceinline__ void p_select(Frame& F, int l) {
    LAS unsigned* selb = (LAS unsigned*)(F.lds + PL_SELB); LAS unsigned short* idxl = (LAS unsigned short*)(F.lds + PL_IDX); LAS float* gatel = (LAS float*)(F.lds + PL_GATE);
    const int lane = F.lane, w = F.wave;
    for (int st_ = 0; st_ < 2; ++st_) { const bool enc_ = (st_ == 0) == (MK_PAR_SEL ? (F.vcu & 1) != 0 : false); asm volatile("" ::: "memory");
    if (enc_) { if (!(MK_U8_EARLY && MK_UCOL) || l == 0) for (int q_ = 0; q_ < (MK_REPEAT_SP == 13 ? 2 : 1); ++q_) tables_items<false>(F, l, (size_t)F.vcu * 512 + F.tid, (size_t)F.G * 512);
                if (!MK_V8_IN_U) tables_items<true>(F, l, (size_t)F.vcu * 512 + F.tid, (size_t)F.G * 512); }
    else for (int q2_ = 0; q2_ < (MK_REPEAT_SP == 15 ? 2 : 1); ++q2_) for (int blk = F.vcu; blk < TT / 64; blk += F.G) {
        const int t0 = blk * 64;
        __syncthreads();
        {
            float t1[16], t2[16], fin[16];
            const _Float16* sb = WSP(_Float16, WS_ST) + (size_t)(w * 256) * TT + t0 + lane;
            top16_half(t1, sb); top16_half(t2, sb + (size_t)128 * TT);
            LAS unsigned* mys = selb + (w * 64 + lane) * 8;
#pragma unroll
            for (int q = 0; q < 4; ++q) { unsigned a = 0, b = 0;
#pragma unroll
                for (int i = 0; i < 4; ++i) { a |= (__builtin_bit_cast(unsigned, t1[4 * q + i]) & 127u) << (8 * i); b |= (__builtin_bit_cast(unsigned, t2[4 * q + i]) & 127u) << (8 * i); }
                mys[q] = a; mys[4 + q] = b; }
#pragma unroll
            for (int j = 0; j < 16; ++j) fin[j] = mkc(t1[0], t2[j], (unsigned)j);
#pragma unroll
            for (int i = 1; i < 16; ++i)
#pragma unroll
                for (int j = 0; j < 16; ++j) if ((i + 1) * (j + 1) <= 16) ins16(fin, mkc(t1[i], t2[j], (unsigned)(i * 16 + j)));
            float m = fin[0];
#pragma unroll
            for (int r = 1; r < 16; ++r) m = __builtin_fmaxf(m, fin[r]);
            float ex[16], sum = 0.f;
            const float rs_ = row_rstd(WSP(float, WS_SSQ), (size_t)t0 + lane);
#pragma unroll
            for (int r = 0; r < 16; ++r) { ex[r] = fexp((fin[r] - m) * rs_); sum += ex[r]; }
            if (w == 0) WSP(float, WS_RSTD)[t0 + lane] = rs_;
            const float inv = frcp(sum);
            LDS_WAIT();
            const LAS unsigned char* myb = (const LAS unsigned char*)mys;
#pragma unroll
            for (int r = 0; r < 16; ++r) { const unsigned code = __builtin_bit_cast(unsigned, fin[r]) & 255u; const unsigned i1 = myb[code >> 4], i2 = myb[16 + (code & 15u)];
                idxl[lane * 128 + w * 16 + r] = (unsigned short)(i1 * 128u + i2); gatel[lane * 128 + w * 16 + r] = ex[r] * inv; }
        }
        __syncthreads();
        for (int e = F.tid; e < 1024; e += 512) *(GAS v4u*)(WSP(unsigned char, WS_IDX) + (size_t)t0 * 256 + e * 16) = *(const LAS v4u*)((const LAS unsigned char*)idxl + e * 16);
        for (int e = F.tid; e < 2048; e += 512) *(GAS v4u*)(WSP(unsigned char, WS_W) + (size_t)t0 * 512 + e * 16) = *(const LAS v4u*)((const LAS unsigned char*)gatel + e * 16);
    }
    __syncthreads(); }
}
__device__ __forceinline__ void cvt16(v4u p, float* v) {
    const unsigned wds[4] = {p.x, p.y, p.z, p.w};
#pragma unroll
    for (int q = 0; q < 4; ++q) { const f32x2 lo = __builtin_amdgcn_cvt_pk_f32_fp8((int)wds[q], false), hi = __builtin_amdgcn_cvt_pk_f32_fp8((int)wds[q], true); v[4 * q] = lo.x; v[4 * q + 1] = lo.y; v[4 * q + 2] = hi.x; v[4 * q + 3] = hi.y; }
}
__device__ __forceinline__ unsigned peer_ticket(Frame& F, int cw, unsigned x) { unsigned t = 0; if (F.lane == 0) t = __hip_atomic_fetch_add((gu32*)(F.ap->ws + WS_CTL) + cw + x * 64, 1u, RLX_AGENT); return t; }
typedef __bf16 bf16x2v __attribute__((ext_vector_type(2)));
template <bool DRY> __device__ __forceinline__ void p_peer_u2(Frame& F, int l, int cset = 0) {
    constexpr int TPT = 8, NTASK = TT / TPT;
    LAS unsigned char* wl = F.lds + F.wave * 6144;
    LAS unsigned short* idxT = (LAS unsigned short*)wl;
    LAS unsigned char* hT = wl + 2048;
    const int lane = F.lane, g = lane >> 3, c = lane & 7;
    const unsigned char* U8 = (const unsigned char*)F.ap->ws + ((MK_U8_EARLY && l == 1) ? WS_WIN : WS_U8);
    const unsigned x0 = MK_X0; const int cw = CW_PEER + ((DRY ? 4 : cset) + l * 2 + 0) * 8 * 64;
    const int wdst = ((2 * lane) & 7) * 16 + (lane >> 2);
    if constexpr (!DRY && MK_V8_IN_U) { if (F.wave >= NWAVES - 2) tables_items<true>(F, l, ((size_t)F.vcu * 2 + (F.wave - (NWAVES - 2))) * 64 + lane, (size_t)F.G * 2 * 64); }
    for (unsigned so = 0; so < 8; ++so) { const unsigned x = (x0 + so) & 7u;
      unsigned cur = (unsigned)__builtin_amdgcn_readfirstlane((int)peer_ticket(F, cw, x));
      while (cur < (unsigned)NTASK) {
        const unsigned nxtv = peer_ticket(F, cw, x);
        const size_t tk0 = (size_t)cur * TPT;
        { unsigned pr[TPT];
#pragma unroll
          for (int k = 0; k < TPT; ++k) pr[k] = *(const GAS unsigned*)(WSP(unsigned, WS_IDX) + (tk0 + k) * 64 + lane);
          const bf16* hp = WSP(bf16, WS_XW) + (tk0 + g) * DM + 128 * (int)x + 16 * c;
          const v4u h0 = *(const GAS v4u*)hp, h1 = *(const GAS v4u*)(hp + 8);
#pragma unroll
          for (int k = 0; k < TPT; ++k) { idxT[k * 128 + wdst] = (unsigned short)(pr[k] & 0xffffu); idxT[k * 128 + wdst + 16] = (unsigned short)(pr[k] >> 16); }
          *(LAS v4u*)(hT + lane * 32) = h0; *(LAS v4u*)(hT + lane * 32 + 16) = h1; }
        LDS_WAIT();
        v4u rA[8], rB[8];
        float* pbase = WSP(float, WS_UP) + (tk0 * 8 + x) * 128 + 2 * lane;
        const unsigned char* ubase = U8 + (size_t)x * (16384 * 128) + 16 * c;
#define PU2_ISSUE(R, k, ih) do { const v4u iq = *(const LAS v4u*)(idxT + (k) * 128 + g * 16 + 8 * (ih)); const unsigned iw[4] = {iq.x, iq.y, iq.z, iq.w}; \
            _Pragma("unroll") for (int i = 0; i < 8; ++i) { const unsigned e = (i & 1) ? (iw[i >> 1] >> 16) : (iw[i >> 1] & 0xffffu); R[i] = *(const GAS v4u*)(ubase + (size_t)e * 128); } } while (0)
#define PU2_DOT(R, ih) do { _Pragma("unroll") for (int i = 0; i < 8; ++i) { const unsigned rq[4] = {R[i].x, R[i].y, R[i].z, R[i].w}; f32x2 a2 = {0.f, 0.f}; \
                _Pragma("unroll") for (int q = 0; q < 4; ++q) { a2 = __builtin_elementwise_fma(__builtin_amdgcn_cvt_pk_f32_fp8((int)rq[q], false), h2[2 * q], a2); a2 = __builtin_elementwise_fma(__builtin_amdgcn_cvt_pk_f32_fp8((int)rq[q], true), h2[2 * q + 1], a2); } \
                s[8 * (ih) + i] = a2[0] + a2[1]; } } while (0)
        PU2_ISSUE(rA, 0, 0);
#pragma unroll 1
        for (int k = 0; k < TPT; ++k) {
            PU2_ISSUE(rB, k, 1);
            f32x2 h2[8];
            { const v4u h0 = *(const LAS v4u*)(hT + (k * 8 + c) * 32), h1 = *(const LAS v4u*)(hT + (k * 8 + c) * 32 + 16); const unsigned hw[8] = {h0.x, h0.y, h0.z, h0.w, h1.x, h1.y, h1.z, h1.w};
#pragma unroll
              for (int q = 0; q < 8; ++q) h2[q] = (f32x2){bflo(hw[q]), bfhi(hw[q])}; }
            float s[16];
            PU2_DOT(rA, 0);
            if (k + 1 < TPT) PU2_ISSUE(rA, k + 1, 0);
            PU2_DOT(rB, 1);
#pragma unroll
            for (int i = 0; i < 8; ++i) s[i] = hsum4(s[i], s[i + 8], (lane & 4) != 0);
#pragma unroll
            for (int i = 0; i < 4; ++i) s[i] = hsum2(s[i], s[i + 4], (lane & 2) != 0);
#pragma unroll
            for (int i = 0; i < 2; ++i) s[i] = hsum1(s[i], s[i + 2], (lane & 1) != 0);
            const unsigned long long po = (unsigned long long)__builtin_bit_cast(unsigned, s[0]) | ((unsigned long long)__builtin_bit_cast(unsigned, s[1]) << 32);
            if constexpr (!DRY) *(GAS unsigned long long*)(pbase + (size_t)k * 1024) = po; else asm volatile("" :: "v"(po));
        }
#undef PU2_ISSUE
#undef PU2_DOT
        LDS_WAIT();
        cur = (unsigned)__builtin_amdgcn_readfirstlane((int)nxtv);
      } }
}
template <bool DRY> __device__ __forceinline__ void p_reduce_u(Frame& F) {
    const int gw = F.vcu * NWAVES + F.wave, NGW = F.G * NWAVES, lane = F.lane;
    const int p0 = 2 * lane, j0 = 8 * (p0 & 15) + (p0 >> 4), j1 = j0 + 8;
    for (int tb = gw * 4; tb < TT; tb += NGW * 4) {
        f32x2 v[4][8]; float g0[4], g1[4], rs[4];
#pragma unroll
        for (int q = 0; q < 4; ++q) { const size_t t = (size_t)tb + q;
#pragma unroll
            for (int x = 0; x < 8; ++x) v[q][x] = *(const GAS f32x2*)(WSP(float, WS_UP) + (t * 8 + x) * 128 + p0);
            g0[q] = WSP(float, WS_W)[t * 128 + j0]; g1[q] = WSP(float, WS_W)[t * 128 + j1]; rs[q] = WSP(float, WS_RSTD)[t]; }
#pragma unroll
        for (int q = 0; q < 4; ++q) { const size_t t = (size_t)tb + q;
            const f32x2 sm = ((v[q][0] + v[q][1]) + (v[q][2] + v[q][3])) + ((v[q][4] + v[q][5]) + (v[q][6] + v[q][7]));
            const float sc = rs[q] * (1.0f / 256.0f); const float w0 = g0[q] * geluf_(sm[0] * sc), w1 = g1[q] * geluf_(sm[1] * sc);
            const unsigned long long wo = (unsigned long long)__builtin_bit_cast(unsigned, w0) | ((unsigned long long)__builtin_bit_cast(unsigned, w1) << 32);
            if constexpr (!DRY) *(GAS unsigned long long*)(WSP(float, WS_W2) + t * 128 + p0) = wo; else asm volatile("" :: "v"(wo)); }
    }
}
template <bool DRY> __device__ __forceinline__ void p_peer_v(Frame& F, int l) {
    constexpr int TPT = 8, NTASK = TT / TPT;
    LAS unsigned char* wl = F.lds + F.wave * 6144;
    LAS unsigned short* idxT = (LAS unsigned short*)wl;
    LAS float* wT = (LAS float*)(wl + 2048);
    const int lane = F.lane, g = lane >> 3, c = lane & 7;
    const unsigned char* V8 = WSP(unsigned char, WS_V8);
    const unsigned x0 = MK_X0; const int cw = CW_PEER + ((DRY ? 4 : 0) + l * 2 + 1) * 8 * 64;
    const int colo = 16 * c + ((lane >> 5) & 1) * 8 + ((lane >> 4) & 1) * 4 + ((lane >> 3) & 1) * 2;
    const int wdst = ((2 * lane) & 7) * 16 + (lane >> 2);
    if constexpr (!DRY && MK_U8_EARLY && MK_UCOL) { if (l == 0 && F.wave >= NWAVES - 2) tables_items<false>(F, 1, ((size_t)F.vcu * 2 + (F.wave - (NWAVES - 2))) * 64 + lane, (size_t)F.G * 2 * 64, WS_WIN); }
    if constexpr (!DRY && MK_W1_LATE) { if (l == 0 && F.wave >= NWAVES - 2) { LAS float* scr = (LAS float*)(F.lds + 65536 + (F.wave - (NWAVES - 2)) * 16640);
        for (int it = F.vcu * 2 + (F.wave - (NWAVES - 2)); it < WT_PER_LAYER; it += F.G * 2) wt_item(F, 1, it, scr); } }
    for (unsigned so = 0; so < 8; ++so) { const unsigned x = (x0 + so) & 7u;
      unsigned cur = (unsigned)__builtin_amdgcn_readfirstlane((int)peer_ticket(F, cw, x));
      while (cur < (unsigned)NTASK) {
        const unsigned nxtv = peer_ticket(F, cw, x);
        const size_t tk0 = (size_t)cur * TPT;
        { unsigned pr[TPT]; unsigned long long wv[TPT];
#pragma unroll
          for (int k = 0; k < TPT; ++k) { pr[k] = *(const GAS unsigned*)(WSP(unsigned, WS_IDX) + (tk0 + k) * 64 + lane); wv[k] = *(const GAS unsigned long long*)(WSP(float, WS_W2) + (tk0 + k) * 128 + 2 * lane); }
#pragma unroll
          for (int k = 0; k < TPT; ++k) { idxT[k * 128 + wdst] = (unsigned short)(pr[k] & 0xffffu); idxT[k * 128 + wdst + 16] = (unsigned short)(pr[k] >> 16);
              if (MK_UCOL) *(LAS unsigned long long*)(wT + k * 128 + 2 * lane) = wv[k];
              else { wT[k * 128 + wdst] = __builtin_bit_cast(float, (unsigned)wv[k]); wT[k * 128 + wdst + 16] = __builtin_bit_cast(float, (unsigned)(wv[k] >> 32)); } } }
        LDS_WAIT();
        v4u rA[8], rB[8]; unsigned xv; f32x2 acc2[8];
        bf16* xbase = WSP(bf16, WS_XB) + tk0 * DM + 128 * (int)x + colo;
        float w1a = 0.f, w1b = 0.f; if (l == 0) { const float* wp_ = F.ap->in[I_N1] + DM + 128 * (int)x + colo; w1a = wp_[0]; w1b = wp_[1]; }
        const unsigned char* vbase = V8 + (size_t)x * (16384 * 128) + 16 * c;
#define PV_ISSUE(R, k, ih) do { const v4u iq = *(const LAS v4u*)(idxT + (k) * 128 + g * 16 + 8 * (ih)); const unsigned iw[4] = {iq.x, iq.y, iq.z, iq.w}; \
            _Pragma("unroll") for (int i = 0; i < 8; ++i) { const unsigned e = (i & 1) ? (iw[i >> 1] >> 16) : (iw[i >> 1] & 0xffffu); R[i] = *(const GAS v4u*)(vbase + (size_t)e * 128); } } while (0)
#define PV_ACC(R, k, ih) do { const f32x4 wq0 = *(const LAS f32x4*)(wT + (k) * 128 + g * 16 + 8 * (ih)), wq1 = *(const LAS f32x4*)(wT + (k) * 128 + g * 16 + 8 * (ih) + 4); \
            const float wa[8] = {wq0.x, wq0.y, wq0.z, wq0.w, wq1.x, wq1.y, wq1.z, wq1.w}; \
            _Pragma("unroll") for (int i = 0; i < 8; ++i) { const f32x2 w2 = {wa[i], wa[i]}; const unsigned rq[4] = {R[i].x, R[i].y, R[i].z, R[i].w}; \
                _Pragma("unroll") for (int q = 0; q < 4; ++q) { acc2[2 * q] = __builtin_elementwise_fma(__builtin_amdgcn_cvt_pk_f32_fp8((int)rq[q], false), w2, acc2[2 * q]); \
                                                               acc2[2 * q + 1] = __builtin_elementwise_fma(__builtin_amdgcn_cvt_pk_f32_fp8((int)rq[q], true), w2, acc2[2 * q + 1]); } } } while (0)
        PV_ISSUE(rA, 0, 0);
#pragma unroll 1
        for (int k = 0; k < TPT; ++k) {
            PV_ISSUE(rB, k, 1); xv = *(const GAS unsigned*)(xbase + (size_t)k * DM);
#pragma unroll
            for (int q = 0; q < 8; ++q) acc2[q] = (f32x2){0.f, 0.f};
            PV_ACC(rA, k, 0);
            if (k + 1 < TPT) PV_ISSUE(rA, k + 1, 0);
            PV_ACC(rB, k, 1);
            float acc[16];
#pragma unroll
            for (int q = 0; q < 8; ++q) { acc[2 * q] = acc2[q][0]; acc[2 * q + 1] = acc2[q][1]; }
#pragma unroll
            for (int i = 0; i < 8; ++i) acc[i] = hsum32(acc[i], acc[i + 8]);
#pragma unroll
            for (int i = 0; i < 4; ++i) acc[i] = hsum16(acc[i], acc[i + 4]);
#pragma unroll
            for (int i = 0; i < 2; ++i) acc[i] = hsum8(acc[i], acc[i + 2], (lane & 8) != 0);
            const float o0 = bflo(xv) + acc[0] * (1.0f / 32.0f), o1 = bfhi(xv) + acc[1] * (1.0f / 32.0f);
            const unsigned xo = pk2(o0, o1);
            if constexpr (!DRY) *(GAS unsigned*)(xbase + (size_t)k * DM) = xo; else asm volatile("" :: "v"(xo));
            if (l == 0) { const unsigned yw = pk2(o0 * w1a, o1 * w1b); const float ss = wave_sum(o0 * o0 + o1 * o1, lane);
                if constexpr (!DRY) { *(GAS unsigned*)(XNP + (tk0 + k) * DM + 128 * (int)x + colo) = yw; if (lane == 0) WSP(float, WS_SSQ1)[(tk0 + k) * 8 + x] = ss; } else asm volatile("" :: "v"(yw), "v"(ss)); }
        }
#undef PV_ISSUE
#undef PV_ACC
        LDS_WAIT();
        cur = (unsigned)__builtin_amdgcn_readfirstlane((int)nxtv);
      } }
}
template <bool DRY> __device__ __forceinline__ void p_rownorm(Frame& F, int l, bool last) {
    const int gw = F.vcu * NWAVES + F.wave, NGW = F.G * NWAVES;
    const bf16* X = WSP(bf16, WS_XB);
    v2u nx[4];
    { const GAS v2u* x0 = (const GAS v2u*)(X + (size_t)gw * DM) + F.lane;
#pragma unroll
      for (int j = 0; j < 4; ++j) nx[j] = x0[64 * j]; }
    for (int m = gw; m < TT; m += NGW) {
        GAS f32x4* xr = (GAS f32x4*)(F.ap->out + (size_t)m * DM) + F.lane;
        f32x4 v[4];
#pragma unroll
        for (int j = 0; j < 4; ++j) v[j] = (f32x4){bflo(nx[j].x), bfhi(nx[j].x), bflo(nx[j].y), bfhi(nx[j].y)};
        if (m + NGW < TT) { const GAS v2u* xn_ = (const GAS v2u*)(X + (size_t)(m + NGW) * DM) + F.lane;
#pragma unroll
            for (int j = 0; j < 4; ++j) nx[j] = xn_[64 * j]; }
        float s = 0.f;
#pragma unroll
        for (int j = 0; j < 4; ++j) s += (v[j].x * v[j].x + v[j].y * v[j].y) + (v[j].z * v[j].z + v[j].w * v[j].w);
        const float rstd = frsq(wave_sum(s, F.lane) * (1.f / DM) + EPS);
#pragma unroll
        for (int j = 0; j < 4; ++j) { const f32x4 wv = *(const GAS f32x4*)(F.ap->in[I_FN] + 4 * F.lane + 256 * j); const f32x4 ov = v[j] * rstd * wv; if constexpr (!DRY) xr[64 * j] = ov; else asm volatile("" :: "v"(ov)); }
    }
    __syncthreads();
}

#ifndef MK_PHASE_MASK
#define MK_PHASE_MASK 0x3ff
#endif
#ifndef MK_DBLBAR
#define MK_DBLBAR 0
#endif
#ifndef MK_SP2
#define MK_SP2 true
#endif
#ifndef MK_REPEAT_SP
#define MK_REPEAT_SP -1
#endif
#ifndef MK_MIX_SUB
#define MK_MIX_SUB 7
#endif
#define MIXS(k) ((MK_MIX_SUB >> (k)) & 1)
#define REP(k) (MK_REPEAT_SP == (k))
#define PHM(k) ((MK_PHASE_MASK >> (k)) & 1)
#ifndef MK_STOP_PHASE
#define MK_STOP_PHASE (22 + 2 * MK_UCOL)
#endif
constexpr int N_PHASES = MK_STOP_PHASE;
#define MK_LAUNDER() do { { KArgs ap = (KArgs)__builtin_amdgcn_kernarg_segment_ptr(); asm volatile("" : "+s"(ap)); F.ap = ap; } { int w0 = wave0; asm volatile("" : "+s"(w0)); int ln; asm volatile("v_mbcnt_lo_u32_b32 %0, -1, 0\n\tv_mbcnt_hi_u32_b32 %0, -1, %0" : "=v"(ln)); F.wave = w0; F.lane = ln; F.tid = w0 * 64 + ln; } { int G = gridDim.x, bx = blockIdx.x; asm volatile("" : "+s"(G), "+s"(bx)); F.G = G; F.vcu = (G % 8 == 0) ? (bx % 8) * (G / 8) + bx / 8 : bx; F.bx = bx; } { LAS unsigned char* lp = (LAS unsigned char*)lds; asm volatile("" : "+s"(lp)); F.lds = lp; } } while (0)
__global__ void __launch_bounds__(NWAVES * 64, 2) fwd_kernel(Args args) {
    extern __shared__ __attribute__((aligned(16))) unsigned char lds[];
    Frame F;
#if MK_BARRIER == 1
    { LAS unsigned* z = (LAS unsigned*)((LAS unsigned char*)lds + LDSCTL_OFF); for (int u = threadIdx.x; u < (LDS_BYTES - LDSCTL_OFF) / 4; u += NWAVES * 64) z[u] = 0u; }
    __syncthreads();
    const int wave0 = __builtin_amdgcn_readfirstlane((int)threadIdx.x >> 6);
    (void)xcd_barrier_post((unsigned*)(args.ws + WS_CTL) + CW_BAR, (volatile LAS unsigned*)((LAS unsigned char*)lds + MISC_OFF) + 8, (int)threadIdx.x);
#endif
    int rep_ph = -1;
    for (int ph = args.ph_lo; ph < args.ph_hi; ++ph) {
        MK_LAUNDER();
        {
        if (ph == 0) { if (PHM(0)) for (int r_ = 0; r_ < (REP(12) ? 2 : 1); ++r_) p0_prologue(F); }
        else {
            constexpr int NS0 = 10 + MK_UCOL;
            const int l = (ph - 1) >= NS0 ? 1 : 0; int sp = (ph - 1) - NS0 * l; if (sp >= 6) ++sp;
            if (MK_UCOL) { if (sp == 10) sp = 12; else if (sp > 10) --sp; }
            if (sp == 0) { if (PHM(1)) {
                LAS float* rsl = (LAS float*)(F.lds + RING_BYTES); const int xg = F.bx & 7;
                for (int r = F.tid; r < 2048; r += 512) { float v = 1.f;
                    if (l > 0) { const float* pp = WSP(float, WS_SSQ1) + ((size_t)xg * 2048 + r) * 8; const f32x4 a = *(const GAS f32x4*)pp, b = *(const GAS f32x4*)(pp + 4); v = frsq((((a.x + a.y) + (a.z + a.w)) + ((b.x + b.y) + (b.z + b.w))) * (1.f / DM) + EPS); }
                    rsl[r] = v; }
                __syncthreads();
                pg8::Gemm g{XNP, WSP(bf16, WS_WIN + (size_t)l * 16 * MiB), TT, NP + 256, DM}; pg8::StaticOrder S; S.init(TT, NP + 256, F.G, F.bx);
                pg8::EpiProj E{WSP(bf16, WS_PROJ), NP, WSP(float, WS_DT), rsl, (F.G % 8 == 0) ? xg : -1, WSP(float, WS_SSQ1), l > 0};
                pg8::gemm_phase<pg8::EpiProj, pg8::StaticOrder, true, MK_SP2>(F.lds, g, S, E, F.tid);
            } } else if (sp == 1) { if (PHM(2)) {
                for (int r_ = 0; r_ < (REP(1) ? 2 : 1); ++r_)
                { const bool odd_ = MK_PAR_MIX1 && (F.vcu & 1) != 0;
                  if (odd_) { for (int q_ = 0; q_ < (MK_REPEAT_SP == 22 ? 2 : 1); ++q_) p_sb_attn(F); __syncthreads(); }
                  MK_LAUNDER();
                  for (int q_ = 0; q_ < (MK_REPEAT_SP == 20 ? 2 : 1); ++q_) for (int u = F.vcu; u < 1024; u += F.G) hg_local_unit(F, l, u >> 9, (u >> 7) & 3, u & 127);
                  for (int q_ = 0; q_ < (MK_REPEAT_SP == 21 ? 2 : 1); ++q_) for (int u = F.vcu; u < 256; u += F.G) ssd_local_unit(F, l, u >> 7, (u >> 1) & 63, u & 1);
                  MK_LAUNDER();
                  if (!odd_) { __syncthreads(); for (int q_ = 0; q_ < (MK_REPEAT_SP == 22 ? 2 : 1); ++q_) p_sb_attn(F); } }
            } } else if (sp == 2) { if (PHM(3)) {
                if (REP(2)) p_scan<true>(F);
                p_scan<false>(F);
            } } else if (sp == 3) { if (PHM(4)) {
                for (int r_ = 0; r_ < (REP(3) ? 2 : 1); ++r_) {
                hg_out_units(F, l, F.vcu, F.G);
                for (int u = F.vcu; u < 256; u += F.G) ssd_out_unit(F, l, u >> 7, (u >> 1) & 63, u & 1); }
            } } else if (sp == 4) { if (PHM(5)) {
                pg8::Gemm g{WSP(bf16, WS_Y), WSP(bf16, WS_WBR + (size_t)l * 3 * MiB), 3 * TT, 3 * DM, 512}; pg8::MergeOrder S{F.vcu, F.G};
                pg8::EpiMerge2 E{WSP(bf16, WS_PROJ) + C_GATE, NP, XNP, DM};
                pg8::gemm_phase<pg8::EpiMerge2, pg8::MergeOrder, true, MK_SP2>(F.lds, g, S, E, F.tid);
            } } else if (sp == 5) { if (PHM(6)) {
                pg8::Gemm g{XNP, WSP(bf16, WS_WOUT + (size_t)l * 2 * MiB), TT, DM, DM}; pg8::StaticOrder S; S.init(TT, DM, F.G, F.bx);
                if (l == 0) { pg8::EpiResNorm<true> E{F.ap->in[I_X], WSP(bf16, WS_XB), DM, F.ap->in[I_N2] + (size_t)l * DM, WSP(bf16, WS_XW), WSP(float, WS_SSQ)};
                    pg8::gemm_phase<pg8::EpiResNorm<true>, pg8::StaticOrder, true, MK_SP2>(F.lds, g, S, E, F.tid); }
                else { pg8::EpiResNorm<false> E{WSP(bf16, WS_XB), WSP(bf16, WS_XB), DM, F.ap->in[I_N2] + (size_t)l * DM, WSP(bf16, WS_XW), WSP(float, WS_SSQ)};
                    pg8::gemm_phase<pg8::EpiResNorm<false>, pg8::StaticOrder, true, MK_SP2>(F.lds, g, S, E, F.tid); }
            } } else if (sp == 7) { if (PHM(8)) {
                pg8::Gemm g{WSP(bf16, WS_WEFF + (size_t)l * 4 * MiB), WSP(bf16, WS_XW), 2048, TT, DM}; pg8::StaticOrder S; S.init(2048, TT, F.G, F.bx);
                pg8::EpiF16 E{WSP(_Float16, WS_ST), TT};
                pg8::gemm_phase<pg8::EpiF16, pg8::StaticOrder, true, MK_SP2>(F.lds, g, S, E, F.tid);
            } } else if (sp == 8) { if (PHM(9)) for (int r_ = 0; r_ < (REP(8) ? 2 : 1); ++r_) p_select(F, l);
            } else if (sp == 12) { if (PHM(9)) { if (REP(14)) p_reduce_u<true>(F); p_reduce_u<false>(F); }
            } else if (sp == 9 && MK_UCOL) { if (PHM(9) && MIXS(0)) { if (REP(9)) p_peer_u2<true>(F, l); if (REP(16)) p_peer_u2<false>(F, l, 4); p_peer_u2<false>(F, l); }
            } else if (sp == 10) { if (PHM(9) && MIXS(1)) { if (REP(10)) p_peer_v<true>(F, l); p_peer_v<false>(F, l); }
            } else { if (PHM(9)) { if (REP(11)) p_rownorm<true>(F, l, true); p_rownorm<false>(F, l, true); }
            }
        }
        }
        if ((MK_REPEAT_SP == 0 || MK_REPEAT_SP == 4 || MK_REPEAT_SP == 7) && ph > 0 && (((ph - 1) >= 10 + MK_UCOL ? ph - 11 - MK_UCOL : ph - 1) + ((((ph - 1) >= 10 + MK_UCOL ? ph - 11 - MK_UCOL : ph - 1)) >= 6 ? 1 : 0)) == MK_REPEAT_SP && rep_ph != ph) { rep_ph = ph; --ph; __syncthreads(); continue; }
#if MK_BARRIER == 1
        if (ph + 1 < args.ph_hi) { if (args.ph_hi - args.ph_lo == 2) cg::this_grid().sync();
            else { XcdBarrier bar; bar.bar = (unsigned*)(F.ap->ws + WS_CTL) + CW_BAR; bar.x = xb_xcc_id(); bar.st = (volatile LAS unsigned*)((LAS unsigned char*)lds + MISC_OFF) + 8; xcd_barrier(bar, F.tid); if (MK_DBLBAR) xcd_barrier(bar, F.tid); } }
#else
        if (ph + 1 < args.ph_hi) cg::this_grid().sync();
#endif
    }
}

extern "C" void kernel_launch(void* const* d_in, const int* in_sizes, int n_in, void* d_out, int out_size, void* d_ws, size_t ws_size, hipStream_t stream) {
    static int grid = 0;
    if (grid == 0) {
        if (n_in != 21 || out_size != TT * DM || ws_size < WS_END) { fprintf(stderr, "kernel_launch: unexpected shapes (n_in %d out %d ws %zu)\n", n_in, out_size, ws_size); grid = -1; return; }
        int dev = 0, cus = 0, per_cu = 0;
        if (hipGetDevice(&dev) != hipSuccess || hipDeviceGetAttribute(&cus, hipDeviceAttributeMultiprocessorCount, dev) != hipSuccess) { grid = -1; return; }
        if (hipFuncSetAttribute((const void*)fwd_kernel, hipFuncAttributeMaxDynamicSharedMemorySize, LDS_BYTES) != hipSuccess) { fprintf(stderr, "kernel_launch: hipFuncSetAttribute failed\n"); grid = -1; return; }
        if (hipOccupancyMaxActiveBlocksPerMultiprocessor(&per_cu, (const void*)fwd_kernel, NWAVES * 64, LDS_BYTES) != hipSuccess || per_cu < 1) { fprintf(stderr, "kernel_launch: occupancy query says %d\n", per_cu); (void)hipGetLastError(); per_cu = 1; }
        grid = cus;
        if (grid > 256) grid = 256;
    }
    if (grid < 0) return;
#if MK_BARRIER == 1
    if (hipMemsetAsync((char*)d_ws + WS_CTL, 0, CTL_ZERO_BYTES, stream) != hipSuccess) { fprintf(stderr, "kernel_launch: memset failed\n"); return; }
#endif
    Args a{};
    for (int i = 0; i < 21; ++i) a.in[i] = (const float*)d_in[i];
    a.out = (float*)d_out; a.ws = (unsigned char*)d_ws;
#if MK_N_LAUNCHES == 1
    a.ph_lo = 0; a.ph_hi = N_PHASES;
    void* kargs[] = {&a};
    hipError_t e = hipLaunchCooperativeKernel((const void*)fwd_kernel, dim3(grid), dim3(NWAVES * 64), kargs, LDS_BYTES, stream);
    if (e != hipSuccess) fprintf(stderr, "kernel_launch: cooperative launch failed: %s (grid %d)\n", hipGetErrorString(e), grid);
#else
    for (int ph = 0; ph < N_PHASES; ++ph) { a.ph_lo = ph; a.ph_hi = ph + 1;
        hipLaunchKernelGGL(fwd_kernel, dim3(grid), dim3(NWAVES * 64), LDS_BYTES, stream, a); }
#ifdef MK_DIAG
    a.ph_lo = MK_DIAG; a.ph_hi = MK_DIAG + 1; hipLaunchKernelGGL(fwd_kernel, dim3(grid), dim3(NWAVES * 64), LDS_BYTES, stream, a);
#endif
#endif
}
```

```cpp
#include <hip/hip_runtime.h>
#include <hip/hip_cooperative_groups.h>
#include <cstdio>
#include <cstdint>
#include <type_traits>
namespace cg = cooperative_groups;

#ifndef MK_N_LAUNCHES
#define MK_N_LAUNCHES 1
#ifndef MK_REPEAT_SP
#define MK_REPEAT_SP -1
#endif
#endif
#ifndef MK_PAR_MIX1
#define MK_PAR_MIX1 0
#endif
#ifndef MK_PAR_SEL
#define MK_PAR_SEL 0
#endif
#ifndef MK_V8_IN_U
#define MK_V8_IN_U 1
#endif
#ifndef MK_UCOL
#define MK_UCOL 1
#endif
#ifndef MK_U8_EARLY
#define MK_U8_EARLY 0
#endif
#ifndef MK_W1_LATE
#define MK_W1_LATE 0
#endif
#ifndef MK_FP8_INPROJ0
#define MK_FP8_INPROJ0 0
#endif
#ifndef MK_FP8_INPROJ1
#define MK_FP8_INPROJ1 1
#endif
#ifndef MK_FP8_PEERQ1
#define MK_FP8_PEERQ0 1
#define MK_FP8_PEERQ1 1
#endif
#ifndef MK_I8_INPROJ0
#define MK_I8_INPROJ0 1
#endif
#ifndef MK_WT_STORES
#define MK_WT_STORES 1
#endif
#ifndef MK_BARRIER
#define MK_BARRIER 1
#endif

constexpr int TT = 16384;
constexpr int SEQ = 8192;
constexpr int DM = 1024;
constexpr int NP = 7936;
constexpr int C_SBQ = 0, C_SBK = 512, C_SBV = 1024, C_HGF = 1536, C_HGQ = 2048, C_HGI = 2560, C_HGG = 3072, C_SSDZ = 3584, C_XBC = 4096, C_GATE = 4864;
constexpr int W_IN_COLS = 7944, W_DT_COL = 4864, W_GATE_COL = 4872;
constexpr float EPS = 1e-6f;

constexpr size_t MiB = 1u << 20;
constexpr size_t WS_CTL = 0, CTL_ZERO_BYTES = 1 * MiB;
constexpr size_t WS_WIN = 2 * MiB;
constexpr size_t WS_WBR = 34 * MiB;
constexpr size_t WS_WOUT = 40 * MiB;
constexpr size_t WS_WEFF = 44 * MiB;
constexpr size_t WS_XB = 64 * MiB;
#define XNP ((bf16*)F.ap->out)
constexpr size_t WS_PROJ = 96 * MiB;
constexpr size_t WS_ST = 96 * MiB;
constexpr size_t WS_U8 = 224 * MiB, WS_V8 = 240 * MiB;
constexpr size_t WS_IDX = 52 * MiB;
constexpr size_t WS_W = 56 * MiB;
constexpr size_t WS_Y = 344 * MiB;
constexpr size_t WS_QT = 392 * MiB;
constexpr size_t WS_OI = 408 * MiB;
constexpr size_t WS_HGS = 424 * MiB;
constexpr size_t WS_CE = 456 * MiB;
constexpr size_t WS_YD = 472 * MiB;
constexpr size_t WS_SSDS = 488 * MiB;
constexpr size_t WS_DT = 496 * MiB;
constexpr size_t WS_DCH = 497 * MiB;
constexpr size_t WS_ATOT = 498 * MiB;
constexpr size_t WS_SSQ = 499 * MiB;
constexpr size_t WS_XW = 160 * MiB;
constexpr size_t WS_RSTD = 498 * MiB + 512 * 1024;
constexpr size_t WS_SSQ1 = 497 * MiB + 512 * 1024;
constexpr size_t WS_UP = 344 * MiB;
constexpr int CW_CMAX = 32768;
constexpr size_t WS_XW8 = 192 * MiB;
constexpr size_t WS_W2 = 500 * MiB;
constexpr size_t WS_END = 508 * MiB;

constexpr int RING_BYTES = 131072;
constexpr int LDSCTL_OFF = 143360, MISC_OFF = LDSCTL_OFF + 320;
constexpr int LDS_BYTES = 147456;
constexpr int NWAVES = 8;

#define GAS __attribute__((address_space(1)))
#define LAS __attribute__((address_space(3)))
typedef unsigned short bf16;
typedef unsigned v4u __attribute__((ext_vector_type(4)));
typedef unsigned v2u __attribute__((ext_vector_type(2)));
typedef float f32x4 __attribute__((ext_vector_type(4)));
typedef float f32x2 __attribute__((ext_vector_type(2)));
typedef float f32x16 __attribute__((ext_vector_type(16)));
typedef short bf16x8 __attribute__((ext_vector_type(8)));
typedef short bf16x4 __attribute__((ext_vector_type(4)));
typedef GAS unsigned gu32;
typedef GAS unsigned long long gu64;
#define RLX_AGENT __ATOMIC_RELAXED, __HIP_MEMORY_SCOPE_AGENT
#define LDS_WAIT() asm volatile("s_waitcnt lgkmcnt(0)" ::: "memory")
#define VM_WAIT() asm volatile("s_waitcnt vmcnt(0)" ::: "memory")
__device__ __forceinline__ void st16wt(void* p, v4u v) { asm volatile("global_store_dwordx4 %0, %1, off sc1\n\ts_nop 1" :: "v"(p), "v"(v) : "memory"); }
__device__ __forceinline__ void st8wt(void* p, v2u v) { asm volatile("global_store_dwordx2 %0, %1, off sc1\n\ts_nop 1" :: "v"(p), "v"(v) : "memory"); }
__device__ __forceinline__ unsigned f2bf(float f) { unsigned u = __builtin_bit_cast(unsigned, f); return (u + 0x7fffu + ((u >> 16) & 1u)) >> 16; }
__device__ __forceinline__ unsigned pk2(float lo, float hi) { return f2bf(lo) | (f2bf(hi) << 16); }
__device__ __forceinline__ float bf2f(unsigned short v) { return __builtin_bit_cast(float, (unsigned)v << 16); }
__device__ __forceinline__ float bflo(unsigned w) { return __builtin_bit_cast(float, w << 16); }
__device__ __forceinline__ float bfhi(unsigned w) { return __builtin_bit_cast(float, w & 0xffff0000u); }
__device__ __forceinline__ float fexp(float x) { return __builtin_amdgcn_exp2f(x * 1.4426950408889634f); }
__device__ __forceinline__ float frcp(float x) { return __builtin_amdgcn_rcpf(x); }
__device__ __forceinline__ float frsq(float x) { return __builtin_amdgcn_rsqf(x); }
__device__ __forceinline__ float geluf_(float v) { const float t = frcp(fabsf(v) * 0.2316418882f + 1.0f);
    float q = t * 0.5307027145f - 0.7265760135f; q = q * t + 0.7107068705f; q = q * t - 0.142248368f; q = q * t + 0.127414796f; q = q * t;
    const float m = v * (q * __builtin_amdgcn_exp2f(v * v * -0.72134752044f)); return v < 0.f ? m : v - m; }
__device__ __forceinline__ float sigmoidf_(float x) { const float e = fexp(-fabsf(x)), r = frcp(1.f + e); return x >= 0.f ? r : e * r; }
__device__ __forceinline__ float siluf_(float x) { return x * sigmoidf_(x); }
__device__ __forceinline__ bf16x8 pack8(const float* v) { v4u w; w.x = pk2(v[0], v[1]); w.y = pk2(v[2], v[3]); w.z = pk2(v[4], v[5]); w.w = pk2(v[6], v[7]); return __builtin_bit_cast(bf16x8, w); }
__device__ __forceinline__ void unpack8(v4u w, float* v) { v[0] = bflo(w.x); v[1] = bfhi(w.x); v[2] = bflo(w.y); v[3] = bfhi(w.y); v[4] = bflo(w.z); v[5] = bfhi(w.z); v[6] = bflo(w.w); v[7] = bfhi(w.w); }
__device__ __forceinline__ float shx(float v, int m, int lane) { return __builtin_bit_cast(float, __builtin_amdgcn_ds_bpermute((lane ^ m) << 2, __builtin_bit_cast(int, v))); }
__device__ __forceinline__ float shi(float v, int src) { return __builtin_bit_cast(float, __builtin_amdgcn_ds_bpermute(src << 2, __builtin_bit_cast(int, v))); }
__device__ __forceinline__ float wave_sum(float v, int lane) {
#pragma unroll
    for (int o = 1; o < 64; o <<= 1) v += shx(v, o, lane);
    return v;
}
__device__ __forceinline__ float wave_max(float v, int lane) {
#pragma unroll
    for (int o = 1; o < 64; o <<= 1) v = __builtin_fmaxf(v, shx(v, o, lane));
    return v;
}
__device__ __forceinline__ float hsum32(float a, float b) { auto r = __builtin_amdgcn_permlane32_swap(__builtin_bit_cast(unsigned, a), __builtin_bit_cast(unsigned, b), false, false); const unsigned r0 = r[0], r1 = r[1]; return __builtin_bit_cast(float, r0) + __builtin_bit_cast(float, r1); }
__device__ __forceinline__ float hsum16(float a, float b) { auto r = __builtin_amdgcn_permlane16_swap(__builtin_bit_cast(unsigned, a), __builtin_bit_cast(unsigned, b), false, false); const unsigned r0 = r[0], r1 = r[1]; return __builtin_bit_cast(float, r0) + __builtin_bit_cast(float, r1); }
__device__ __forceinline__ float hsum8(float a, float b, bool up) { asm volatile("" : "+v"(a), "+v"(b)); const float send = up ? a : b, keep = up ? b : a; return keep + __builtin_bit_cast(float, __builtin_amdgcn_update_dpp(0, __builtin_bit_cast(int, send), 0x128, 0xf, 0xf, false)); }
__device__ __forceinline__ float hsum4(float a, float b, bool up) { asm volatile("" : "+v"(a), "+v"(b)); const float send = up ? a : b, keep = up ? b : a;
    int t = __builtin_amdgcn_update_dpp(0, __builtin_bit_cast(int, send), 0x141, 0xf, 0xf, false); t = __builtin_amdgcn_update_dpp(0, t, 0x1b, 0xf, 0xf, false); return keep + __builtin_bit_cast(float, t); }
__device__ __forceinline__ float hsum2(float a, float b, bool up) { asm volatile("" : "+v"(a), "+v"(b)); const float send = up ? a : b, keep = up ? b : a; return keep + __builtin_bit_cast(float, __builtin_amdgcn_update_dpp(0, __builtin_bit_cast(int, send), 0x4e, 0xf, 0xf, false)); }
__device__ __forceinline__ float hsum1(float a, float b, bool up) { asm volatile("" : "+v"(a), "+v"(b)); const float send = up ? a : b, keep = up ? b : a; return keep + __builtin_bit_cast(float, __builtin_amdgcn_update_dpp(0, __builtin_bit_cast(int, send), 0xb1, 0xf, 0xf, false)); }
__device__ __forceinline__ unsigned pk4f8(float a, float b, float c, float d) { int p = 0; p = __builtin_amdgcn_cvt_pk_fp8_f32(a, b, p, false); p = __builtin_amdgcn_cvt_pk_fp8_f32(c, d, p, true); return (unsigned)p; }
__device__ __forceinline__ unsigned pk4i8(float a, float b, float c, float d) {
    const int qa = (int)__builtin_rintf(a), qb = (int)__builtin_rintf(b), qc = (int)__builtin_rintf(c), qd = (int)__builtin_rintf(d);
    return ((unsigned)qa & 0xffu) | (((unsigned)qb & 0xffu) << 8) | (((unsigned)qc & 0xffu) << 16) | ((unsigned)qd << 24); }
__device__ __forceinline__ float sum8lanes(float a) {
    a += __builtin_bit_cast(float, __builtin_amdgcn_update_dpp(0, __builtin_bit_cast(int, a), 0x141, 0xf, 0xf, false));
    a += __builtin_bit_cast(float, __builtin_amdgcn_update_dpp(0, __builtin_bit_cast(int, a), 0x1b, 0xf, 0xf, false));
    a += __builtin_bit_cast(float, __builtin_amdgcn_update_dpp(0, __builtin_bit_cast(int, a), 0xb1, 0xf, 0xf, false));
    return a; }
#define MFMA16(a, b, c) __builtin_amdgcn_mfma_f32_16x16x32_bf16((a), (b), (c), 0, 0, 0)
#define MFMA32(a, b, c) __builtin_amdgcn_mfma_f32_32x32x16_bf16((a), (b), (c), 0, 0, 0)
namespace pg8 {
#define PG8_LAS __attribute__((address_space(3)))
typedef unsigned short bf16_t;
typedef short bf16x8 __attribute__((ext_vector_type(8)));
typedef float f32x4 __attribute__((ext_vector_type(4)));
typedef unsigned u32x4 __attribute__((ext_vector_type(4)));
typedef int i32x4_t __attribute__((ext_vector_type(4)));
typedef int i32x8_t __attribute__((ext_vector_type(8)));
constexpr int BM = 256, BK = 64, HALF = 128, HTB = HALF * BK * 2  , STAGE_BYTES = 8 * HTB, NXCD = 8, WGM = 8;

__host__ __device__ __forceinline__ int lds_byte(int r, int c) { const int st = (r >> 4) * 2 + (c >> 5), rr = r & 15, cc = c & 31, ob = rr * 64 + cc * 2; return st * 1024 + (ob ^ (((ob >> 9) & 1) << 5)); }
__host__ __device__ __forceinline__ void stage_rc(int b, int& R, int& C) { const int st = b / 1024, sb = b % 1024, swz = sb ^ (((sb >> 9) & 1) << 5); R = (st >> 1) * 16 + swz / 64; C = (st & 1) * 32 + (swz % 64) / 2; }
__host__ __device__ __forceinline__ int perm32(int rho) { const int n = rho >> 4, i = rho & 15; return 8 * (i >> 2) + 4 * n + (i & 3); }

struct Unit { int pm, pn; };
struct Gemm { const bf16_t* A; const bf16_t* Bt; int M, N, K; };

struct StaticOrder {
    int nM, nN, nwg, G, c;
    __host__ __device__ void init(int M, int N, int G_, int c_) { nM = M / BM; nN = N / BM; nwg = nM * nN; G = G_; c = c_; }
    __host__ __device__ bool next(int i, Unit& u) const {
        const long L = (long)i * G + c; if (L >= nwg) return false;
        int wgid = (int)L; { const int q = nwg / NXCD, r = nwg % NXCD, xcd = wgid % NXCD, off = wgid / NXCD; wgid = (xcd < r ? xcd * (q + 1) : r * (q + 1) + (xcd - r) * q) + off; }
        const int nig = WGM * nN, gid = wgid / nig, fm = gid * WGM, gsz = (nM - fm) < WGM ? (nM - fm) : WGM;
        u.pm = fm + ((wgid % nig) % gsz); u.pn = (wgid % nig) / gsz; return true;
    }
    __device__ __forceinline__ void a_ready(const Unit&) const {}
    __device__ __forceinline__ void done(const Unit&) const {}
};

__device__ __forceinline__ unsigned cvt_pk_bf16(float lo, float hi) { unsigned r; asm volatile("v_cvt_pk_bf16_f32 %0, %1, %2" : "=v"(r) : "v"(lo), "v"(hi)); return r; }
typedef float f32x2 __attribute__((ext_vector_type(2)));
typedef unsigned u32x2 __attribute__((ext_vector_type(2)));
__device__ __forceinline__ void st16_wt(void* p, u32x4 v) {
#if MK_WT_STORES
    asm volatile("global_store_dwordx4 %0, %1, off sc1\n\ts_nop 1" :: "v"(p), "v"(v) : "memory");
#else
    *(u32x4*)p = v;
#endif
}
constexpr int GATE_TILE0 = 19, GATE_COL0 = 4864;
__device__ __forceinline__ u32x2 pk8_fp8(f32x4 a, f32x4 b) { int p0 = 0, p1 = 0; p0 = __builtin_amdgcn_cvt_pk_fp8_f32(a[0], a[1], p0, false); p0 = __builtin_amdgcn_cvt_pk_fp8_f32(a[2], a[3], p0, true);
    p1 = __builtin_amdgcn_cvt_pk_fp8_f32(b[0], b[1], p1, false); p1 = __builtin_amdgcn_cvt_pk_fp8_f32(b[2], b[3], p1, true); u32x2 r; r.x = (unsigned)p0; r.y = (unsigned)p1; return r; }
struct EpiBf16 {
    static constexpr bool PERM = true, AFTER_DRAIN = false;
    bf16_t* O; int ldc;
    __device__ __forceinline__ void operator()(const f32x4 (&acc)[2][2][4][2], const Unit& u, int wr, int wc, int fr, int fq) const {
        const int row0 = u.pm * BM + wr * 64 + fr; const int col0 = u.pn * BM + wc * 32 + 8 * fq;
#pragma unroll
        for (int ai = 0; ai < 2; ++ai)
#pragma unroll
            for (int m = 0; m < 4; ++m) { bf16_t* rowp = O + (size_t)(row0 + ai * HALF + m * 16) * ldc + col0;
#pragma unroll
                for (int bj = 0; bj < 2; ++bj) { const f32x4 v0 = acc[ai][bj][m][0], v1 = acc[ai][bj][m][1];
                    u32x4 w; w.x = cvt_pk_bf16(v0[0], v0[1]); w.y = cvt_pk_bf16(v0[2], v0[3]); w.z = cvt_pk_bf16(v1[0], v1[1]); w.w = cvt_pk_bf16(v1[2], v1[3]);
                    st16_wt(rowp + bj * HALF, w); } }
    }
};
struct EpiProj {
    static constexpr bool PERM = true, AFTER_DRAIN = false;
    bf16_t* O; int ldc; float* dt; const PG8_LAS float* rsl; int xg; const float* ssq8; bool scale;
    __device__ __forceinline__ void operator()(const f32x4 (&acc)[2][2][4][2], const Unit& u, int wr, int wc, int fr, int fq) const {
        const int rl0 = wr * 64 + fr, row0 = u.pm * BM + rl0; const int col0 = u.pn * BM + wc * 32 + 8 * fq;
        float sc[2][4];
        if ((u.pm >> 3) == xg) {
#pragma unroll
            for (int ai = 0; ai < 2; ++ai)
#pragma unroll
                for (int m = 0; m < 4; ++m) sc[ai][m] = rsl[(u.pm & 7) * BM + rl0 + ai * HALF + m * 16];
        } else {
#pragma unroll
            for (int ai = 0; ai < 2; ++ai)
#pragma unroll
                for (int m = 0; m < 4; ++m) { sc[ai][m] = 1.f; if (scale) { const float* pp = ssq8 + (size_t)(row0 + ai * HALF + m * 16) * 8; const f32x4 a = *(const f32x4*)pp, b = *(const f32x4*)(pp + 4);
                    sc[ai][m] = __builtin_amdgcn_rsqf((((a[0] + a[1]) + (a[2] + a[3])) + ((b[0] + b[1]) + (b[2] + b[3]))) * (1.f / 1024.f) + 1e-6f); } }
        }
        if (u.pn == 31) {
            if (wc == 0 && fq == 0) {
#pragma unroll
                for (int ai = 0; ai < 2; ++ai)
#pragma unroll
                    for (int m = 0; m < 4; ++m) { float* dp = dt + (size_t)(row0 + ai * HALF + m * 16) * 8; *(f32x4*)dp = acc[ai][0][m][0] * sc[ai][m]; *(f32x4*)(dp + 4) = acc[ai][0][m][1] * sc[ai][m]; }
            }
            return;
        }
#pragma unroll
        for (int ai = 0; ai < 2; ++ai)
#pragma unroll
            for (int m = 0; m < 4; ++m) { bf16_t* rowp = O + (size_t)(row0 + ai * HALF + m * 16) * ldc + col0;
                if (u.pn >= GATE_TILE0) { const u32x2 q0 = pk8_fp8((acc[ai][0][m][0] * sc[ai][m]), (acc[ai][0][m][1] * sc[ai][m])), q1 = pk8_fp8((acc[ai][1][m][0] * sc[ai][m]), (acc[ai][1][m][1] * sc[ai][m]));
                    u32x4 w; w.x = q0.x; w.y = q0.y; w.z = q1.x; w.w = q1.y; st16_wt((unsigned char*)(rowp - col0) + 2 * GATE_COL0 + (u.pn - GATE_TILE0) * 256 + (wc * 4 + fq) * 16, w); continue; }
#pragma unroll
                for (int bj = 0; bj < 2; ++bj) { const f32x4 v0 = acc[ai][bj][m][0] * sc[ai][m], v1 = acc[ai][bj][m][1] * sc[ai][m];
                    u32x4 w; w.x = cvt_pk_bf16(v0[0], v0[1]); w.y = cvt_pk_bf16(v0[2], v0[3]); w.z = cvt_pk_bf16(v1[0], v1[1]); w.w = cvt_pk_bf16(v1[2], v1[3]);
                    st16_wt(rowp + bj * HALF, w); } }
    }
};
struct EpiProjI8 {
    static constexpr bool PERM = true, AFTER_DRAIN = false;
    bf16_t* O; int ldc; float* dt; const PG8_LAS float* rsl; const float* colmax; int xg; const float* rowf;
    __device__ __forceinline__ void operator()(const f32x4 (&acc)[2][2][4][2], const Unit& u, int wr, int wc, int fr, int fq) const {
        const int rl0 = wr * 64 + fr, row0 = u.pm * BM + rl0; const int col0 = u.pn * BM + wc * 32 + 8 * fq;
        float sc[2][4];
#pragma unroll
        for (int ai = 0; ai < 2; ++ai)
#pragma unroll
            for (int m = 0; m < 4; ++m) sc[ai][m] = (u.pm >> 3) == xg ? rsl[(u.pm & 7) * BM + rl0 + ai * HALF + m * 16] : rowf[row0 + ai * HALF + m * 16];
        f32x4 cf[2][2];
#pragma unroll
        for (int bj = 0; bj < 2; ++bj)
#pragma unroll
            for (int n = 0; n < 2; ++n) cf[bj][n] = *(const f32x4*)(colmax + col0 + bj * HALF + 4 * n) * (1.0f / 127.0f);
        if (u.pn == 31) {
            if (wc == 0 && fq == 0) {
#pragma unroll
                for (int ai = 0; ai < 2; ++ai)
#pragma unroll
                    for (int m = 0; m < 4; ++m) { float* dp = dt + (size_t)(row0 + ai * HALF + m * 16) * 8; *(f32x4*)dp = acc[ai][0][m][0] * cf[0][0] * sc[ai][m]; *(f32x4*)(dp + 4) = acc[ai][0][m][1] * cf[0][1] * sc[ai][m]; }
            }
            return;
        }
#pragma unroll
        for (int ai = 0; ai < 2; ++ai)
#pragma unroll
            for (int m = 0; m < 4; ++m) { bf16_t* rowp = O + (size_t)(row0 + ai * HALF + m * 16) * ldc + col0;
                if (u.pn >= GATE_TILE0) { const u32x2 q0 = pk8_fp8((acc[ai][0][m][0] * cf[0][0] * sc[ai][m]), (acc[ai][0][m][1] * cf[0][1] * sc[ai][m])), q1 = pk8_fp8((acc[ai][1][m][0] * cf[1][0] * sc[ai][m]), (acc[ai][1][m][1] * cf[1][1] * sc[ai][m]));
                    u32x4 w; w.x = q0.x; w.y = q0.y; w.z = q1.x; w.w = q1.y; st16_wt((unsigned char*)(rowp - col0) + 2 * GATE_COL0 + (u.pn - GATE_TILE0) * 256 + (wc * 4 + fq) * 16, w); continue; }
#pragma unroll
                for (int bj = 0; bj < 2; ++bj) { const f32x4 v0 = acc[ai][bj][m][0] * cf[bj][0] * sc[ai][m], v1 = acc[ai][bj][m][1] * cf[bj][1] * sc[ai][m];
                    u32x4 w; w.x = cvt_pk_bf16(v0[0], v0[1]); w.y = cvt_pk_bf16(v0[2], v0[3]); w.z = cvt_pk_bf16(v1[0], v1[1]); w.w = cvt_pk_bf16(v1[2], v1[3]);
                    st16_wt(rowp + bj * HALF, w); } }
    }
};
struct EpiProj0 {
    static constexpr bool PERM = true, AFTER_DRAIN = false;
    bf16_t* O; int ldc; float* dt;
    __device__ __forceinline__ void operator()(const f32x4 (&acc)[2][2][4][2], const Unit& u, int wr, int wc, int fr, int fq) const {
        const int row0 = u.pm * BM + wr * 64 + fr; const int col0 = u.pn * BM + wc * 32 + 8 * fq;
        if (u.pn == 31) {
            if (wc == 0 && fq == 0) {
#pragma unroll
                for (int ai = 0; ai < 2; ++ai)
#pragma unroll
                    for (int m = 0; m < 4; ++m) { float* dp = dt + (size_t)(row0 + ai * HALF + m * 16) * 8; *(f32x4*)dp = acc[ai][0][m][0]; *(f32x4*)(dp + 4) = acc[ai][0][m][1]; }
            }
            return;
        }
#pragma unroll
        for (int ai = 0; ai < 2; ++ai)
#pragma unroll
            for (int m = 0; m < 4; ++m) { bf16_t* rowp = O + (size_t)(row0 + ai * HALF + m * 16) * ldc + col0;
#pragma unroll
                for (int bj = 0; bj < 2; ++bj) { const f32x4 v0 = acc[ai][bj][m][0], v1 = acc[ai][bj][m][1];
                    u32x4 w; w.x = cvt_pk_bf16(v0[0], v0[1]); w.y = cvt_pk_bf16(v0[2], v0[3]); w.z = cvt_pk_bf16(v1[0], v1[1]); w.w = cvt_pk_bf16(v1[2], v1[3]);
                    st16_wt(rowp + bj * HALF, w); } }
    }
};
struct EpiF32 {
    static constexpr bool PERM = false, AFTER_DRAIN = false;
    float* C; int ldc;
    __device__ __forceinline__ void operator()(const f32x4 (&acc)[2][2][4][2], const Unit& u, int wr, int wc, int fr, int fq) const {
        const int row0 = u.pm * BM + wr * 64 + fr, col0 = u.pn * BM + wc * 32 + 4 * fq;
#pragma unroll
        for (int ai = 0; ai < 2; ++ai)
#pragma unroll
            for (int m = 0; m < 4; ++m) { float* rowp = C + (size_t)(row0 + ai * HALF + m * 16) * ldc + col0;
#pragma unroll
                for (int bj = 0; bj < 2; ++bj)
#pragma unroll
                    for (int n = 0; n < 2; ++n) st16_wt(rowp + bj * HALF + n * 16, __builtin_bit_cast(u32x4, acc[ai][bj][m][n])); }
    }
};
struct EpiF16 {
    static constexpr bool PERM = true, AFTER_DRAIN = false;
    _Float16* C; int ldc;
    __device__ __forceinline__ void operator()(const f32x4 (&acc)[2][2][4][2], const Unit& u, int wr, int wc, int fr, int fq) const {
        typedef _Float16 h2 __attribute__((ext_vector_type(2)));
        const int row0 = u.pm * BM + wr * 64 + fr; const int col0 = u.pn * BM + wc * 32 + 8 * fq;
#pragma unroll
        for (int ai = 0; ai < 2; ++ai)
#pragma unroll
            for (int m = 0; m < 4; ++m) { _Float16* rowp = C + (size_t)(row0 + ai * HALF + m * 16) * ldc + col0;
#pragma unroll
                for (int bj = 0; bj < 2; ++bj) { const f32x4 v0 = acc[ai][bj][m][0], v1 = acc[ai][bj][m][1];
                    const h2 a = {(_Float16)v0[0], (_Float16)v0[1]}, b = {(_Float16)v0[2], (_Float16)v0[3]}, c = {(_Float16)v1[0], (_Float16)v1[1]}, d = {(_Float16)v1[2], (_Float16)v1[3]};
                    u32x4 w; w.x = __builtin_bit_cast(unsigned, a); w.y = __builtin_bit_cast(unsigned, b); w.z = __builtin_bit_cast(unsigned, c); w.w = __builtin_bit_cast(unsigned, d);
                    st16_wt(rowp + bj * HALF, w); } }
    }
};
template <bool DRY> struct EpiResF32 {
    static constexpr bool PERM = false, AFTER_DRAIN = false;
    float* C; int ldc;
    __device__ __forceinline__ void operator()(const f32x4 (&acc)[2][2][4][2], const Unit& u, int wr, int wc, int fr, int fq) const {
        const int row0 = u.pm * BM + wr * 64 + fr, col0 = u.pn * BM + wc * 32 + 4 * fq;
#pragma unroll
        for (int ai = 0; ai < 2; ++ai)
#pragma unroll
            for (int m = 0; m < 4; ++m) { float* rowp = C + (size_t)(row0 + ai * HALF + m * 16) * ldc + col0;
                f32x4 old[2][2];
#pragma unroll
                for (int bj = 0; bj < 2; ++bj)
#pragma unroll
                    for (int n = 0; n < 2; ++n) old[bj][n] = *(const f32x4*)(rowp + bj * HALF + n * 16);
#pragma unroll
                for (int bj = 0; bj < 2; ++bj)
#pragma unroll
                    for (int n = 0; n < 2; ++n) { const f32x4 r = old[bj][n] + acc[ai][bj][m][n]; if constexpr (!DRY) *(f32x4*)(rowp + bj * HALF + n * 16) = r; else asm volatile("" :: "v"(r)); } }
    }
};
template <bool CIN_F32> struct EpiResNorm {
    static constexpr bool PERM = true, AFTER_DRAIN = false;
    const void* Cin; bf16_t* C; int ldc; const float* w; bf16_t* XW; float* ssq; unsigned char* XW8;
    __device__ __forceinline__ void operator()(const f32x4 (&acc)[2][2][4][2], const Unit& u, int wr, int wc, int fr, int fq) const {
        const int row0 = u.pm * BM + wr * 64 + fr, col0 = u.pn * BM + wc * 32 + 8 * fq;
        f32x4 xf[3][2][2]; u32x4 xh[3][2];
#define ERN_LD(i, s) do { const size_t ro_ = (size_t)(row0 + ((i) >> 2) * HALF + ((i) & 3) * 16) * ldc + col0; \
            if constexpr (CIN_F32) { _Pragma("unroll") for (int bj = 0; bj < 2; ++bj) _Pragma("unroll") for (int n = 0; n < 2; ++n) xf[s][bj][n] = *(const f32x4*)((const float*)Cin + ro_ + bj * HALF + 4 * n); } \
            else { _Pragma("unroll") for (int bj = 0; bj < 2; ++bj) xh[s][bj] = *(const u32x4*)((const bf16_t*)Cin + ro_ + bj * HALF); } } while (0)
#define ERN_COMP(i, s) do { constexpr int ai = (i) >> 2, m = (i) & 3; const size_t row = (size_t)(row0 + ai * HALF + m * 16); float ss = 0.f; \
            _Pragma("unroll") for (int bj = 0; bj < 2; ++bj) { f32x4 xx[2]; \
                if constexpr (CIN_F32) { xx[0] = xf[s][bj][0]; xx[1] = xf[s][bj][1]; } \
                else { const u32x4 q_ = xh[s][bj]; xx[0] = (f32x4){__builtin_bit_cast(float, q_.x << 16), __builtin_bit_cast(float, q_.x & 0xffff0000u), __builtin_bit_cast(float, q_.y << 16), __builtin_bit_cast(float, q_.y & 0xffff0000u)}; \
                       xx[1] = (f32x4){__builtin_bit_cast(float, q_.z << 16), __builtin_bit_cast(float, q_.z & 0xffff0000u), __builtin_bit_cast(float, q_.w << 16), __builtin_bit_cast(float, q_.w & 0xffff0000u)}; } \
                _Pragma("unroll") for (int n = 0; n < 2; ++n) { xx[n] = xx[n] + acc[ai][bj][m][n]; \
                    ss += (xx[n][0] * xx[n][0] + xx[n][1] * xx[n][1]) + (xx[n][2] * xx[n][2] + xx[n][3] * xx[n][3]); } \
                u32x4 xo; xo.x = cvt_pk_bf16(xx[0][0], xx[0][1]); xo.y = cvt_pk_bf16(xx[0][2], xx[0][3]); xo.z = cvt_pk_bf16(xx[1][0], xx[1][1]); xo.w = cvt_pk_bf16(xx[1][2], xx[1][3]); \
                *(u32x4*)(C + row * ldc + col0 + bj * HALF) = xo; \
                const f32x4 y0 = xx[0], y1 = xx[1]; \
                if (XW8) { int q0_ = 0, q1_ = 0; q0_ = __builtin_amdgcn_cvt_pk_fp8_f32(y0[0], y0[1], q0_, false); q0_ = __builtin_amdgcn_cvt_pk_fp8_f32(y0[2], y0[3], q0_, true); q1_ = __builtin_amdgcn_cvt_pk_fp8_f32(y1[0], y1[1], q1_, false); q1_ = __builtin_amdgcn_cvt_pk_fp8_f32(y1[2], y1[3], q1_, true); \
                    *(unsigned long long*)(XW8 + row * ldc + col0 + bj * HALF) = (unsigned long long)(unsigned)q0_ | ((unsigned long long)(unsigned)q1_ << 32); } } \
              \
            { auto r1 = __builtin_amdgcn_permlane16_swap(__builtin_bit_cast(unsigned, ss), __builtin_bit_cast(unsigned, ss), false, false); const unsigned a1 = r1[0], b1 = r1[1]; ss = __builtin_bit_cast(float, a1) + __builtin_bit_cast(float, b1); \
              auto r2 = __builtin_amdgcn_permlane32_swap(__builtin_bit_cast(unsigned, ss), __builtin_bit_cast(unsigned, ss), false, false); const unsigned a2 = r2[0], b2 = r2[1]; ss = __builtin_bit_cast(float, a2) + __builtin_bit_cast(float, b2); } \
            if (fq == 0) ssq[row * 16 + 4 * u.pn + wc] = ss; } while (0)
        ERN_LD(0, 0); ERN_LD(1, 1); ERN_LD(2, 2);
        ERN_COMP(0, 0); ERN_LD(3, 0); ERN_COMP(1, 1); ERN_LD(4, 1); ERN_COMP(2, 2); ERN_LD(5, 2); ERN_COMP(3, 0); ERN_LD(6, 0); ERN_COMP(4, 1); ERN_LD(7, 1); ERN_COMP(5, 2); ERN_COMP(6, 0); ERN_COMP(7, 1);
#undef ERN_LD
#undef ERN_COMP
    }
};
struct EpiMerge {
    static constexpr bool PERM = true, AFTER_DRAIN = false;
    const bf16_t* gate; int ldg;
    bf16_t* O; int ldc;
    __device__ __forceinline__ void operator()(const f32x4 (&acc)[2][2][4][2], const Unit& u, int wr, int wc, int fr, int fq) const {
        const int br = u.pm >> 6, pm = u.pm & 63, pn = u.pn & 3;
        const int row0 = pm * BM + wr * 64 + fr, col0 = pn * BM + wc * 32 + 8 * fq;
        const bf16_t* gbase = gate + (size_t)row0 * ldg + br * 1024 + col0; bf16_t* obase = O + (size_t)row0 * ldc + col0;
        u32x4 gq[2][4], oq[2][4];
#define EMG_LD(b, s) do { _Pragma("unroll") for (int mm = 0; mm < 2; ++mm) _Pragma("unroll") for (int bj = 0; bj < 2; ++bj) { const size_t r = (size_t)(((b) >> 1) * HALF + (2 * ((b) & 1) + mm) * 16); \
            gq[s][mm * 2 + bj] = *(const u32x4*)(gbase + r * ldg + bj * HALF); oq[s][mm * 2 + bj] = *(const u32x4*)(obase + r * ldc + bj * HALF); } } while (0)
#define EMG_COMP(b, s) do { _Pragma("unroll") for (int mm = 0; mm < 2; ++mm) _Pragma("unroll") for (int bj = 0; bj < 2; ++bj) { constexpr int ai = (b) >> 1; const int m = 2 * ((b) & 1) + mm; const size_t r = (size_t)(ai * HALF + m * 16); \
            const u32x4 gw = gq[s][mm * 2 + bj]; \
            float v[8] = {acc[ai][bj][m][0][0], acc[ai][bj][m][0][1], acc[ai][bj][m][0][2], acc[ai][bj][m][0][3], acc[ai][bj][m][1][0], acc[ai][bj][m][1][1], acc[ai][bj][m][1][2], acc[ai][bj][m][1][3]}; \
            float g[8]; { g[0] = __builtin_bit_cast(float, gw.x << 16); g[1] = __builtin_bit_cast(float, gw.x & 0xffff0000u); g[2] = __builtin_bit_cast(float, gw.y << 16); g[3] = __builtin_bit_cast(float, gw.y & 0xffff0000u); \
                          g[4] = __builtin_bit_cast(float, gw.z << 16); g[5] = __builtin_bit_cast(float, gw.z & 0xffff0000u); g[6] = __builtin_bit_cast(float, gw.w << 16); g[7] = __builtin_bit_cast(float, gw.w & 0xffff0000u); } \
            _Pragma("unroll") for (int j = 0; j < 8; ++j) {   v[j] *= __builtin_amdgcn_rcpf(1.f + __builtin_amdgcn_exp2f(g[j] * -1.4426950408889634f)); } \
            if (br != 0) { const u32x4 ow = oq[s][mm * 2 + bj]; \
                v[0] += __builtin_bit_cast(float, ow.x << 16); v[1] += __builtin_bit_cast(float, ow.x & 0xffff0000u); v[2] += __builtin_bit_cast(float, ow.y << 16); v[3] += __builtin_bit_cast(float, ow.y & 0xffff0000u); \
                v[4] += __builtin_bit_cast(float, ow.z << 16); v[5] += __builtin_bit_cast(float, ow.z & 0xffff0000u); v[6] += __builtin_bit_cast(float, ow.w << 16); v[7] += __builtin_bit_cast(float, ow.w & 0xffff0000u); } \
            u32x4 wq; wq.x = cvt_pk_bf16(v[0], v[1]); wq.y = cvt_pk_bf16(v[2], v[3]); wq.z = cvt_pk_bf16(v[4], v[5]); wq.w = cvt_pk_bf16(v[6], v[7]); \
            *(u32x4*)(obase + r * ldc + bj * HALF) = wq; } } while (0)
        EMG_LD(0, 0); EMG_LD(1, 1); EMG_COMP(0, 0); EMG_LD(2, 0); EMG_COMP(1, 1); EMG_LD(3, 1); EMG_COMP(2, 0); EMG_COMP(3, 1);
#undef EMG_LD
#undef EMG_COMP
    }
};
struct EpiMerge2 {
    static constexpr bool PERM = true, AFTER_DRAIN = false;
    const bf16_t* gate; int ldg;
    bf16_t* O; int ldc;
    __device__ __forceinline__ void operator()(f32x4 (&acc)[2][2][4][2], const Unit& u, int wr, int wc, int fr, int fq) const {
        const int br = u.pm >> 6, pm = u.pm & 63, pn = u.pn & 3;
        const int row0 = pm * BM + wr * 64 + fr, col0 = pn * BM + wc * 32 + 8 * fq;
        const unsigned char* gbase = (const unsigned char*)gate + (size_t)row0 * ldg * 2 + (br * 4 + pn) * 256 + (wc * 4 + fq) * 16; bf16_t* obase = O + (size_t)row0 * ldc + col0;
        const int nxo = br < 2 ? 1024 : 0;
        u32x4 gq[2][2], hq[2][2];
#define EM2_LD(b, s) do { _Pragma("unroll") for (int mm = 0; mm < 2; ++mm) { const size_t r = (size_t)(((b) >> 1) * HALF + (2 * ((b) & 1) + mm) * 16); \
            gq[s][mm] = *(const u32x4*)(gbase + r * ldg * 2); hq[s][mm] = *(const u32x4*)(gbase + r * ldg * 2 + nxo); } } while (0)
#define EM2_E(x) __builtin_amdgcn_exp2f(__builtin_amdgcn_fmed3f((x), -30.f, 30.f) * -1.4426950408889634f)
#define EM2_COMP(b, s) do { _Pragma("unroll") for (int mm = 0; mm < 2; ++mm) _Pragma("unroll") for (int bj = 0; bj < 2; ++bj) { constexpr int ai = (b) >> 1; const int m = 2 * ((b) & 1) + mm; const size_t r = (size_t)(ai * HALF + m * 16); \
            const unsigned gx_ = bj ? gq[s][mm].z : gq[s][mm].x, gy_ = bj ? gq[s][mm].w : gq[s][mm].y, hx_ = bj ? hq[s][mm].z : hq[s][mm].x, hy_ = bj ? hq[s][mm].w : hq[s][mm].y; \
            const f32x2 ga = __builtin_amdgcn_cvt_pk_f32_fp8((int)gx_, false), gb = __builtin_amdgcn_cvt_pk_f32_fp8((int)gx_, true), gc = __builtin_amdgcn_cvt_pk_f32_fp8((int)gy_, false), gd = __builtin_amdgcn_cvt_pk_f32_fp8((int)gy_, true); \
            const f32x2 ha = __builtin_amdgcn_cvt_pk_f32_fp8((int)hx_, false), hb = __builtin_amdgcn_cvt_pk_f32_fp8((int)hx_, true), hc = __builtin_amdgcn_cvt_pk_f32_fp8((int)hy_, false), hd = __builtin_amdgcn_cvt_pk_f32_fp8((int)hy_, true); \
            const float g[8] = {ga[0], ga[1], gb[0], gb[1], gc[0], gc[1], gd[0], gd[1]}; const float hh[8] = {ha[0], ha[1], hb[0], hb[1], hc[0], hc[1], hd[0], hd[1]}; \
            float f[8]; \
            if (br < 2) { _Pragma("unroll") for (int j = 0; j < 8; ++j) f[j] = (1.f + EM2_E(hh[j])) * __builtin_amdgcn_rcpf(1.f + EM2_E(g[j])); } \
            else        { _Pragma("unroll") for (int j = 0; j < 8; ++j) f[j] = __builtin_amdgcn_rcpf(1.f + EM2_E(g[j])); } \
            _Pragma("unroll") for (int j = 0; j < 8; ++j) acc[ai][bj][m][j >> 2][j & 3] *= f[j]; \
            if (br == 2) { u32x4 wq; wq.x = cvt_pk_bf16(acc[ai][bj][m][0][0], acc[ai][bj][m][0][1]); wq.y = cvt_pk_bf16(acc[ai][bj][m][0][2], acc[ai][bj][m][0][3]); \
                wq.z = cvt_pk_bf16(acc[ai][bj][m][1][0], acc[ai][bj][m][1][1]); wq.w = cvt_pk_bf16(acc[ai][bj][m][1][2], acc[ai][bj][m][1][3]); \
                *(u32x4*)(obase + r * ldc + bj * HALF) = wq; } } } while (0)
        EM2_LD(0, 0); EM2_LD(1, 1); EM2_COMP(0, 0); EM2_LD(2, 0); EM2_COMP(1, 1); EM2_LD(3, 1); EM2_COMP(2, 0); EM2_COMP(3, 1);
#undef EM2_LD
#undef EM2_E
#undef EM2_COMP
    }
};
template <class Epi> __device__ __forceinline__ bool epi_keep(const Epi&, const Unit&) { return false; }
__device__ __forceinline__ bool epi_keep(const EpiMerge2&, const Unit& u) { return (u.pm >> 6) < 2; }
struct MergeOrder {
    int v, G;
    __device__ __forceinline__ bool next(int i, Unit& u) const { const int bi = i / 3, br = i - bi * 3; const long L = (long)bi * G + v; if (L >= 256) return false;
        u.pm = br * 64 + (int)(L >> 2); u.pn = br * 4 + (int)(L & 3); return true; }
    __device__ __forceinline__ void a_ready(const Unit&) const {}
    __device__ __forceinline__ void done(const Unit&) const {}
};
template <bool FP8> __device__ __forceinline__ auto ld_frag(const PG8_LAS unsigned char* p) {
    if constexpr (FP8) { typedef int i32x8_a16 __attribute__((ext_vector_type(8), aligned(16))); const i32x8_t r = *(const PG8_LAS i32x8_a16*)p; return r; }
    else return *(const PG8_LAS bf16x8*)p;
}
template <class Epi, class Sched, bool ALIGN_EPI = false, bool SP2 = false, bool FP8 = false, int FP8_BEXP = 0, bool I8 = false>
__device__ __forceinline__ void gemm_phase(PG8_LAS unsigned char* lds, const Gemm g, const Sched& S, const Epi& E, int tid_) {
    const int tid = tid_, wid = __builtin_amdgcn_readfirstlane(tid >> 6), lane = tid & 63, wr = wid >> 2, wc = wid & 3, fr = lane & 15, fq = lane >> 4;
    const int K = g.K, nt = K / BK;
    unsigned voffA[2], voffB[2];
#pragma unroll
    for (int i = 0; i < 2; ++i) { int R, C; stage_rc(tid * 16 + i * 8192, R, C); const int Rb = Epi::PERM ? ((R & ~31) + perm32(R & 31)) : R;
        voffA[i] = (unsigned)(R * K + C) * 2u; voffB[i] = (unsigned)(Rb * K + C) * 2u; }
    const size_t kstep = (size_t)(BK * 2);
    const size_t hstep = (size_t)HALF * K * 2;
    const size_t tstep = 2 * hstep;
    const unsigned ldsw = (unsigned)wid * 1024u;
    const int aoff = lds_byte(wr * 64 + fr, FP8 ? fq * 16 : fq * 8), boff = lds_byte(wc * 32 + fr, FP8 ? fq * 16 : fq * 8);
    constexpr int NKF = FP8 ? 1 : 2;
    using frag_t = std::conditional_t<FP8, i32x8_t, bf16x8>;
    const int fp8sc = (int)(0x7f7f7f00u | (unsigned)(127 + FP8_BEXP));
#define PG8_SA(b, h) (((b) * 2 + (h)) * HTB)
#define PG8_SB(b, h) ((4 + (b) * 2 + (h)) * HTB)
#define PG8_STAGE(bufoff, gbase, voff) do { const unsigned long long gb_ = (unsigned long long)(const char*)(gbase); const unsigned gl_ = (unsigned)gb_, gh_ = (unsigned)(gb_ >> 32); \
        _Pragma("unroll") for (int _i = 0; _i < 2; ++_i) { const unsigned lo_ = gl_ + (voff)[_i]; const unsigned hi_ = gh_ + (lo_ < gl_ ? 1u : 0u);        \
        __builtin_amdgcn_global_load_lds((const unsigned*)(((unsigned long long)hi_ << 32) | lo_), (PG8_LAS unsigned*)(lds + (bufoff) + ldsw + _i * 8192), 16, 0, 0); } } while (0)
#define PG8_LD1(p) ld_frag<FP8>(p)
#define PG8_LDA(dst, b, h) do { _Pragma("unroll") for (int m = 0; m < 4; ++m) _Pragma("unroll") for (int k = 0; k < NKF; ++k) dst[m][k] = PG8_LD1(lds + PG8_SA(b, h) + aoff + m * 2048 + k * 1024); } while (0)
#define PG8_LDB(dst, b, h) do { _Pragma("unroll") for (int n = 0; n < 2; ++n) _Pragma("unroll") for (int k = 0; k < NKF; ++k) dst[n][k] = PG8_LD1(lds + PG8_SB(b, h) + boff + n * 2048 + k * 1024); } while (0)
#define PG8_MMA(ai, bj, At, Bt) do { __builtin_amdgcn_s_setprio(1); \
        if constexpr (FP8) { _Pragma("unroll") for (int m = 0; m < 4; ++m) _Pragma("unroll") for (int n = 0; n < 2; ++n) \
            acc[ai][bj][m][n] = __builtin_amdgcn_mfma_scale_f32_16x16x128_f8f6f4(Bt[n][0], At[m][0], acc[ai][bj][m][n], 0, 0, 0, fp8sc, 1, fp8sc); }        \
        else if constexpr (I8) { _Pragma("unroll") for (int m = 0; m < 4; ++m) _Pragma("unroll") for (int n = 0; n < 2; ++n) _Pragma("unroll") for (int k = 0; k < 2; ++k) \
            acc[ai][bj][m][n] = __builtin_bit_cast(f32x4, __builtin_amdgcn_mfma_i32_16x16x64_i8(__builtin_bit_cast(i32x4_t, Bt[n][k]), __builtin_bit_cast(i32x4_t, At[m][k]), __builtin_bit_cast(i32x4_t, acc[ai][bj][m][n]), 0, 0, 0)); } \
        else { _Pragma("unroll") for (int m = 0; m < 4; ++m) _Pragma("unroll") for (int n = 0; n < 2; ++n) _Pragma("unroll") for (int k = 0; k < 2; ++k) \
            acc[ai][bj][m][n] = __builtin_amdgcn_mfma_f32_16x16x32_bf16(Bt[n][k], At[m][k], acc[ai][bj][m][n], 0, 0, 0); } \
        __builtin_amdgcn_s_setprio(0); } while (0)
#define PG8_WAIT_V(n) asm volatile("s_waitcnt vmcnt(" #n ")" ::: "memory")
#define PG8_WAIT_L(n) asm volatile("s_waitcnt lgkmcnt(" #n ")" ::: "memory")
#define PG8_BAR __builtin_amdgcn_s_barrier()
#define PG8_SCHED __builtin_amdgcn_sched_barrier(0)
    Unit cur, nxt; int ui = 0;
    if (!S.next(0, cur)) return;
    f32x4 acc[2][2][4][2];
#pragma unroll
    for (int a = 0; a < 2; ++a)
#pragma unroll
        for (int b = 0; b < 2; ++b)
#pragma unroll
            for (int m = 0; m < 4; ++m)
#pragma unroll
                for (int n = 0; n < 2; ++n) acc[a][b][m][n] = (f32x4){0.f, 0.f, 0.f, 0.f};
    frag_t At[4][NKF], B0[2][NKF], B1[2][NKF];
    const char* cA = (const char*)g.A + (size_t)cur.pm * tstep; const char* cB = (const char*)g.Bt + (size_t)cur.pn * tstep;
    S.a_ready(cur);
    if constexpr (SP2) {
        PG8_STAGE(PG8_SB(0, 0), cB, voffB); PG8_STAGE(PG8_SB(0, 1), cB + hstep, voffB); PG8_STAGE(PG8_SA(0, 0), cA, voffA); PG8_STAGE(PG8_SA(0, 1), cA + hstep, voffA);
        if (wr == 1) PG8_BAR;
        PG8_WAIT_V(2); PG8_BAR;
        PG8_STAGE(PG8_SB(1, 0), cB + kstep, voffB); PG8_STAGE(PG8_SA(1, 0), cA + kstep, voffA); PG8_STAGE(PG8_SB(1, 1), cB + hstep + kstep, voffB);
        PG8_WAIT_V(6); PG8_BAR;
    } else {
        PG8_STAGE(PG8_SB(0, 0), cB, voffB); PG8_STAGE(PG8_SA(0, 0), cA, voffA); PG8_STAGE(PG8_SB(0, 1), cB + hstep, voffB); PG8_STAGE(PG8_SA(0, 1), cA + hstep, voffA);
        if (wr == 1) PG8_BAR;
        PG8_WAIT_V(4); PG8_BAR;
        PG8_STAGE(PG8_SB(1, 0), cB + kstep, voffB); PG8_STAGE(PG8_SA(1, 0), cA + kstep, voffA); PG8_STAGE(PG8_SB(1, 1), cB + hstep + kstep, voffB);
        PG8_WAIT_V(6); PG8_BAR;
    }
    for (;;) {
        const bool has_next = S.next(ui + 1, nxt);
        const char* nA = has_next ? (const char*)g.A + (size_t)nxt.pm * tstep : cA; const char* nB = has_next ? (const char*)g.Bt + (size_t)nxt.pn * tstep : cB;
#pragma unroll 1
        for (int t = 0; t < nt; t += 2) {
            const bool last = (t == nt - 2);
            const char* a1 = cA + (size_t)(t + 1) * kstep;
            const char* a2 = last ? nA : cA + (size_t)(t + 2) * kstep; const char* b2 = last ? nB : cB + (size_t)(t + 2) * kstep;
            const char* a3 = a2 + kstep; const char* b3 = b2 + kstep;
            if (last && has_next) S.a_ready(nxt);
            if constexpr (SP2) {
            PG8_LDB(B0, 0, 0); PG8_LDB(B1, 0, 1); PG8_SCHED; PG8_LDA(At, 0, 0); PG8_STAGE(PG8_SA(1, 1), a1 + hstep, voffA);
            PG8_WAIT_V(8); PG8_WAIT_L(0); PG8_BAR; PG8_MMA(0, 0, At, B0); PG8_MMA(0, 1, At, B1); PG8_BAR; PG8_SCHED;
            PG8_LDA(At, 0, 1); PG8_STAGE(PG8_SB(0, 0), b2, voffB); PG8_STAGE(PG8_SB(0, 1), b2 + hstep, voffB); PG8_STAGE(PG8_SA(0, 0), a2, voffA);
            PG8_WAIT_V(8); PG8_WAIT_L(0); PG8_BAR; PG8_MMA(1, 0, At, B0); PG8_MMA(1, 1, At, B1); PG8_BAR; PG8_SCHED;
            PG8_LDB(B0, 1, 0); PG8_LDB(B1, 1, 1); PG8_SCHED; PG8_LDA(At, 1, 0); PG8_STAGE(PG8_SA(0, 1), a2 + hstep, voffA);
            PG8_WAIT_V(8); PG8_WAIT_L(0); PG8_BAR; PG8_MMA(0, 0, At, B0); PG8_MMA(0, 1, At, B1); PG8_BAR; PG8_SCHED;
            PG8_LDA(At, 1, 1); PG8_STAGE(PG8_SB(1, 0), b3, voffB); PG8_STAGE(PG8_SB(1, 1), b3 + hstep, voffB); PG8_STAGE(PG8_SA(1, 0), a3, voffA);
            PG8_WAIT_V(8); PG8_WAIT_L(0); PG8_BAR; PG8_MMA(1, 0, At, B0); PG8_MMA(1, 1, At, B1); PG8_BAR; PG8_SCHED;
            } else {
            PG8_LDB(B0, 0, 0); PG8_SCHED; PG8_LDA(At, 0, 0); PG8_STAGE(PG8_SA(1, 1), a1 + hstep, voffA);
            PG8_WAIT_L(8); PG8_BAR; PG8_WAIT_L(0); PG8_MMA(0, 0, At, B0); PG8_BAR; PG8_SCHED;
            PG8_LDB(B1, 0, 1); PG8_STAGE(PG8_SB(0, 0), b2, voffB);
            PG8_BAR; PG8_WAIT_L(0); PG8_MMA(0, 1, At, B1); PG8_BAR;
            PG8_LDA(At, 0, 1); PG8_STAGE(PG8_SA(0, 0), a2, voffA);
            PG8_BAR; PG8_WAIT_L(0); PG8_MMA(1, 0, At, B0); PG8_BAR; PG8_SCHED;
            PG8_STAGE(PG8_SB(0, 1), b2 + hstep, voffB);
            PG8_WAIT_V(6); PG8_BAR; PG8_MMA(1, 1, At, B1); PG8_BAR;
            PG8_LDB(B0, 1, 0); PG8_SCHED; PG8_LDA(At, 1, 0); PG8_STAGE(PG8_SA(0, 1), a2 + hstep, voffA);
            PG8_WAIT_L(8); PG8_BAR; PG8_WAIT_L(0); PG8_MMA(0, 0, At, B0); PG8_BAR; PG8_SCHED;
            PG8_LDB(B1, 1, 1); PG8_STAGE(PG8_SB(1, 0), b3, voffB);
            PG8_BAR; PG8_WAIT_L(0); PG8_MMA(0, 1, At, B1); PG8_BAR;
            PG8_LDA(At, 1, 1); PG8_STAGE(PG8_SA(1, 0), a3, voffA);
            PG8_BAR; PG8_WAIT_L(0); PG8_MMA(1, 0, At, B0); PG8_BAR; PG8_SCHED;
            PG8_STAGE(PG8_SB(1, 1), b3 + hstep, voffB);
            PG8_WAIT_V(6); PG8_BAR; PG8_MMA(1, 1, At, B1); PG8_BAR;
            }
        }
        if constexpr (ALIGN_EPI) { if (wr == 0) PG8_BAR; }
        if constexpr (I8) {
            _Pragma("unroll") for (int a = 0; a < 2; ++a) _Pragma("unroll") for (int bq = 0; bq < 2; ++bq) _Pragma("unroll") for (int m = 0; m < 4; ++m) _Pragma("unroll") for (int n = 0; n < 2; ++n) { const i32x4_t iv = __builtin_bit_cast(i32x4_t, acc[a][bq][m][n]);
                acc[a][bq][m][n] = (f32x4){(float)iv[0], (float)iv[1], (float)iv[2], (float)iv[3]}; } }
        if constexpr (!Epi::AFTER_DRAIN) { int fr_ = fr, fq_ = fq; asm volatile("" : "+v"(fr_), "+v"(fq_));
            E(acc, cur, wr, wc, fr_, fq_); S.done(cur); }
        if (!has_next) break;
        if (!epi_keep(E, cur)) {
#pragma unroll
        for (int a = 0; a < 2; ++a)
#pragma unroll
            for (int b = 0; b < 2; ++b)
#pragma unroll
                for (int m = 0; m < 4; ++m)
#pragma unroll
                    for (int n = 0; n < 2; ++n) acc[a][b][m][n] = (f32x4){0.f, 0.f, 0.f, 0.f}; }
        cur = nxt; cA = nA; cB = nB; ++ui;
        if constexpr (ALIGN_EPI) { if (wr == 1) PG8_BAR; }
    }
    PG8_WAIT_V(0);
    if constexpr (!ALIGN_EPI) { if (wr == 0) PG8_BAR; }
    PG8_BAR;
    if constexpr (Epi::AFTER_DRAIN) { E.fused(acc, cur, wr, wc, fr, fq, lds, wid, lane); S.done(cur); }
#undef PG8_SA
#undef PG8_SB
#undef PG8_STAGE
#undef PG8_LDA
#undef PG8_LDB
#undef PG8_MMA
#undef PG8_LD1
#undef PG8_WAIT_V
#undef PG8_WAIT_L
#undef PG8_BAR
#undef PG8_SCHED
}
}
constexpr int CW_BAR = 4096;
__device__ __forceinline__ unsigned long long rt() { return __builtin_amdgcn_s_memrealtime(); }
#define XB_TMO      128
#define XB_XCNT(j)  (256  + 64 * (j))
#define XB_XSUB(j)  (1280 + 64 * (j))
#define XB_XGEN(j)  (2304 + 64 * (j))
#define XB_TOP      3328
#define XB_TOPGEN   3392
#define XCD_BAR_WORDS 3456
#define XB_SPIN_CAP (1u << 18)

__device__ __forceinline__ unsigned xb_ld(unsigned* p)              { return __hip_atomic_load(p, __ATOMIC_RELAXED, __HIP_MEMORY_SCOPE_AGENT); }
__device__ __forceinline__ unsigned xb_add(unsigned* p, unsigned v) { return __hip_atomic_fetch_add(p, v, __ATOMIC_RELAXED, __HIP_MEMORY_SCOPE_AGENT); }
__device__ __forceinline__ unsigned xb_xcc_id() { return (unsigned)__builtin_amdgcn_s_getreg((3 << 11) | 20) & 0xFu; }
#define XB_SPIN(cond, bar) do { unsigned _sp = 0; while (cond) { __builtin_amdgcn_s_sleep(1); \
    if ((++_sp & 255u) == 0u) { if (xb_ld(&(bar)[XB_TMO])) break; if (_sp > XB_SPIN_CAP) { atomicAdd(&(bar)[XB_TMO], 1u); break; } } } } while (0)

struct XcdBarrier {
    unsigned* bar; unsigned x;
    volatile LAS unsigned* st;
};

__device__ __forceinline__ XcdBarrier xcd_barrier_post(unsigned* bar, volatile LAS unsigned* st, int tid) {
    XcdBarrier b; b.bar = bar; b.x = xb_xcc_id(); b.st = st;
    if (tid == 0) (void)xb_add(&bar[XB_XCNT(b.x)], 1u);
    return b;
}
__device__ __forceinline__ void xcd_barrier_complete(unsigned* bar, unsigned x, unsigned& nloc, unsigned& nx) {
    const unsigned G = gridDim.x * gridDim.y * gridDim.z;
    unsigned sum, cnt, mine, sp = 0u;
    for (;;) {
        sum = 0u; cnt = 0u; mine = 0u;
#pragma unroll
        for (unsigned j = 0; j < 16; ++j) { const unsigned c = xb_ld(&bar[XB_XCNT(j)]); sum += c; cnt += (c > 0u) ? 1u : 0u; mine = (j == x) ? c : mine; }
        if (sum == G) break;
        __builtin_amdgcn_s_sleep(1);
        if ((++sp & 255u) == 0u) { if (xb_ld(&bar[XB_TMO])) break; if (sp > XB_SPIN_CAP) { atomicAdd(&bar[XB_TMO], 1u); break; } }
    }
    nloc = mine > 0u ? mine : 1u; nx = cnt > 0u ? cnt : 1u;
}

__device__ __forceinline__ void xcd_barrier(const XcdBarrier& b, int tid) {
    asm volatile("s_waitcnt vmcnt(0)" ::: "memory");
    __syncthreads();
    if (tid == 0) {
        unsigned* bar = b.bar;
        __builtin_amdgcn_s_waitcnt(0);
        unsigned nloc = b.st[0], nx = b.st[1];
        if (nloc == 0u) { xcd_barrier_complete(bar, b.x, nloc, nx); b.st[0] = nloc; b.st[1] = nx; }
        const unsigned old = xb_add(&bar[XB_XSUB(b.x)], 1u);
        const unsigned gen = old / nloc;
        if (old + 1u == (gen + 1u) * nloc) {
            __builtin_amdgcn_fence(__ATOMIC_RELEASE, "agent");
            asm volatile("s_waitcnt vmcnt(0)" ::: "memory");
            const unsigned og = xb_add(&bar[XB_TOP], 1u);
            const unsigned tg = og / nx;
            if (og + 1u == (tg + 1u) * nx) xb_add(&bar[XB_TOPGEN], 1u);
            else XB_SPIN(xb_ld(&bar[XB_TOPGEN]) == tg, bar);
            __builtin_amdgcn_fence(__ATOMIC_ACQUIRE, "agent");
            xb_add(&bar[XB_XGEN(b.x)], 1u);
            asm volatile("s_waitcnt vmcnt(0)" ::: "memory");
        } else {
            XB_SPIN(xb_ld(&bar[XB_XGEN(b.x)]) == gen, bar);
            __builtin_amdgcn_fence(__ATOMIC_ACQUIRE, "agent");
            asm volatile("s_waitcnt vmcnt(0)" ::: "memory");
        }
    }
    __syncthreads();
}

struct Args { const float* in[21]; float* out; unsigned char* ws; int ph_lo, ph_hi; };
enum { I_X = 0, I_N1 = 1, I_WIN = 2, I_LB = 3, I_HGN = 4, I_CW = 5, I_CB = 6, I_DTB = 7, I_ALOG = 8, I_DSK = 9, I_SSDN = 10, I_WSB = 11, I_WHG = 12, I_WSSD = 13, I_WOUT = 14,
       I_N2 = 15, I_WQ = 16, I_SK = 17, I_U = 18, I_V = 19, I_FN = 20 };
typedef const __attribute__((address_space(4))) Args* KArgs;
struct Frame {
    LAS unsigned char* lds;
    int tid, lane, wave, vcu, G, bx;
    KArgs ap;
};
#define WSP(T, off) ((T*)(F.ap->ws + (off)))

template <bool F8 = false> __device__ __forceinline__ void transpose_item(const float* W, int ldw, bf16* WT, int ldt, int nblk, LAS float* scr, int item, int lane) {
    const int kb = item / nblk, nb = item % nblk, k0 = 64 * kb, n0 = 64 * nb;
    f32x4 v[16];
#pragma unroll
    for (int i = 0; i < 16; ++i) v[i] = __builtin_nontemporal_load((const GAS f32x4*)(W + (size_t)(k0 + 4 * i + (lane >> 4)) * ldw + n0 + 4 * (lane & 15)));
#pragma unroll
    for (int i = 0; i < 16; ++i) { LAS float* d = scr + (4 * i + (lane >> 4)) * 65 + 4 * (lane & 15); d[0] = v[i].x; d[1] = v[i].y; d[2] = v[i].z; d[3] = v[i].w; }
    LDS_WAIT(); asm volatile("" ::: "memory");
    const int c = lane & 7;
#pragma unroll
    for (int j = 0; j < 8; ++j) { const int n = (lane >> 3) + 8 * j; const LAS float* s = scr + (8 * c) * 65 + n;
        if constexpr (F8) { v2u o; o.x = pk4f8(s[0 * 65] * 64.f, s[1 * 65] * 64.f, s[2 * 65] * 64.f, s[3 * 65] * 64.f); o.y = pk4f8(s[4 * 65] * 64.f, s[5 * 65] * 64.f, s[6 * 65] * 64.f, s[7 * 65] * 64.f);
            *(GAS v2u*)((unsigned char*)WT + (size_t)(n0 + n) * ldt + k0 + 8 * c) = o; }
        else { v4u o; o.x = pk2(s[0 * 65], s[1 * 65]); o.y = pk2(s[2 * 65], s[3 * 65]); o.z = pk2(s[4 * 65], s[5 * 65]); o.w = pk2(s[6 * 65], s[7 * 65]);
        *(GAS v4u*)(WT + (size_t)(n0 + n) * ldt + k0 + 8 * c) = o; } }
    LDS_WAIT(); asm volatile("" ::: "memory");
}
__device__ __forceinline__ void weff_item(Frame& F, const float* wq, const float* sk, bf16* WeffT, int item, bool f8, const float* w2) {
    LAS float* skT = (LAS float*)F.lds;
    LAS float* wqT = (LAS float*)(F.lds + 128 * 132 * 4);
    const int g = item >> 4, d0 = (item & 15) * 64;
    for (int e = F.tid; e < 128 * 32; e += 512) { const int key = e >> 5, i4 = (e & 31) * 4; const f32x4 v = *(const GAS f32x4*)(sk + ((size_t)g * 128 + key) * 128 + i4);
        skT[(i4 + 0) * 132 + key] = v.x; skT[(i4 + 1) * 132 + key] = v.y; skT[(i4 + 2) * 132 + key] = v.z; skT[(i4 + 3) * 132 + key] = v.w; }
    for (int e = F.tid; e < 64 * 32; e += 512) { const int dl = e >> 5, i4 = (e & 31) * 4; const f32x4 v = *(const GAS f32x4*)(wq + (size_t)(d0 + dl) * 2048 + g * 128 + i4);
        wqT[(i4 + 0) * 68 + dl] = v.x; wqT[(i4 + 1) * 68 + dl] = v.y; wqT[(i4 + 2) * 68 + dl] = v.z; wqT[(i4 + 3) * 68 + dl] = v.w; }
    __syncthreads();
    const int ty = F.tid >> 4, tx = F.tid & 15;
    float acc[4][4];
#pragma unroll
    for (int a = 0; a < 4; ++a)
#pragma unroll
        for (int b = 0; b < 4; ++b) acc[a][b] = 0.f;
    const f32x4 w2v = *(const GAS f32x4*)(w2 + d0 + 4 * tx);
#pragma unroll 4
    for (int i = 0; i < 128; ++i) { const f32x4 a = *(const LAS f32x4*)(skT + i * 132 + 4 * ty), b = *(const LAS f32x4*)(wqT + i * 68 + 4 * tx);
#pragma unroll
        for (int p = 0; p < 4; ++p)
#pragma unroll
            for (int q = 0; q < 4; ++q) acc[p][q] += a[p] * b[q]; }
#pragma unroll
    for (int p = 0; p < 4; ++p) {
#pragma unroll
        for (int q = 0; q < 4; ++q) acc[p][q] *= w2v[q];
        if (f8) { *(GAS unsigned*)((unsigned char*)WeffT + (size_t)(g * 128 + 4 * ty + p) * 1024 + d0 + 4 * tx) = pk4f8(acc[p][0] * 64.f, acc[p][1] * 64.f, acc[p][2] * 64.f, acc[p][3] * 64.f); continue; }
        v2u o; o.x = pk2(acc[p][0], acc[p][1]); o.y = pk2(acc[p][2], acc[p][3]);
        *(GAS v2u*)(WeffT + (size_t)(g * 128 + 4 * ty + p) * 1024 + d0 + 4 * tx) = o; }
    __syncthreads();
}
__device__ __forceinline__ void load_wdt(Frame& F, const float* w_in_l, LAS float* wdt) {
    for (int e = F.tid; e < 2048; e += 512) { const int d = e >> 1, hf = (e & 1) * 4; *(LAS f32x4*)(wdt + d * 8 + hf) = *(const GAS f32x4*)(w_in_l + (size_t)d * W_IN_COLS + W_DT_COL + hf); }
}
template <bool DO_DT, bool F8 = false, bool I8 = false> __device__ __forceinline__ void norm_row_from_regs(const f32x4 (&v)[4], const float* nw, bf16* xnrow, const LAS float* wdt, float* dtrow, int lane) {
    float s = 0.f;
#pragma unroll
    for (int j = 0; j < 4; ++j) s += (v[j].x * v[j].x + v[j].y * v[j].y) + (v[j].z * v[j].z + v[j].w * v[j].w);
    const float rstd = frsq(wave_sum(s, lane) * (1.f / DM) + EPS);
    f32x4 h[4];
#pragma unroll
    for (int j = 0; j < 4; ++j) { const f32x4 w = *(const GAS f32x4*)(nw + 4 * lane + 256 * j); h[j] = v[j] * rstd * w; }
    if constexpr (I8) { float am = 0.f;
#pragma unroll
        for (int j = 0; j < 4; ++j) am = __builtin_fmaxf(am, __builtin_fmaxf(__builtin_fmaxf(fabsf(h[j].x), fabsf(h[j].y)), __builtin_fmaxf(fabsf(h[j].z), fabsf(h[j].w))));
        am = wave_max(am, lane); const float inv = am > 0.f ? 127.f / am : 0.f; GAS unsigned* o4 = (GAS unsigned*)xnrow + lane;
#pragma unroll
        for (int j = 0; j < 4; ++j) o4[64 * j] = pk4i8(h[j].x * inv, h[j].y * inv, h[j].z * inv, h[j].w * inv);
        if (lane == 0) dtrow[0] = am * (1.f / 127.f); }
    else if constexpr (F8) { GAS unsigned* o4 = (GAS unsigned*)xnrow + lane;
#pragma unroll
        for (int j = 0; j < 4; ++j) o4[64 * j] = pk4f8(h[j].x, h[j].y, h[j].z, h[j].w); }
    else { GAS unsigned long long* o8 = (GAS unsigned long long*)xnrow + lane;
#pragma unroll
    for (int j = 0; j < 4; ++j) o8[64 * j] = (unsigned long long)pk2(h[j].x, h[j].y) | ((unsigned long long)pk2(h[j].z, h[j].w) << 32); }
    if constexpr (DO_DT) {
        float d[8];
#pragma unroll
        for (int q = 0; q < 8; ++q) d[q] = 0.f;
#pragma unroll
        for (int j = 0; j < 4; ++j)
#pragma unroll
            for (int e = 0; e < 4; ++e) { const float hv = __builtin_bit_cast(float, f2bf(h[j][e]) << 16);
                const LAS float* wp = wdt + (4 * lane + 256 * j + e) * 8; const f32x4 w0 = *(const LAS f32x4*)wp, w1 = *(const LAS f32x4*)(wp + 4);
                d[0] += hv * w0.x; d[1] += hv * w0.y; d[2] += hv * w0.z; d[3] += hv * w0.w; d[4] += hv * w1.x; d[5] += hv * w1.y; d[6] += hv * w1.z; d[7] += hv * w1.w; }
#pragma unroll
        for (int q = 0; q < 8; ++q) d[q] = wave_sum(d[q], lane);
        if (lane == 0) { *(GAS f32x4*)dtrow = (f32x4){d[0], d[1], d[2], d[3]}; *(GAS f32x4*)(dtrow + 4) = (f32x4){d[4], d[5], d[6], d[7]}; }
    }
}
constexpr int WT_NB_A = 4864 / 64, WT_NB_G = 3072 / 64;
constexpr int WT_I_A = 16 * WT_NB_A, WT_I_G = 16 * WT_NB_G, WT_I_BR = 8 * 16, WT_I_O = 16 * 16;
constexpr int WT_PER_LAYER = WT_I_A + WT_I_G + 3 * WT_I_BR + WT_I_O;
__device__ __forceinline__ void wt_item(Frame& F, int l, int r, LAS float* scr) {
    const float* win = F.ap->in[I_WIN] + (size_t)l * DM * W_IN_COLS; bf16* WinT = WSP(bf16, WS_WIN + (size_t)l * 16 * MiB);
    if ((MK_FP8_INPROJ0 && l == 0) || (MK_FP8_INPROJ1 && l == 1)) {
        if (r < WT_I_A) { transpose_item<true>(win, W_IN_COLS, WinT, DM, WT_NB_A, scr, r, F.lane); return; }
        if (r < WT_I_A + WT_I_G) { transpose_item<true>(win + W_GATE_COL, W_IN_COLS, (bf16*)((unsigned char*)WinT + (size_t)C_GATE * DM), DM, WT_NB_G, scr, r - WT_I_A, F.lane); return; } }
    if (r < WT_I_A) { transpose_item(win, W_IN_COLS, WinT, DM, WT_NB_A, scr, r, F.lane); return; } r -= WT_I_A;
    if (r < WT_I_G) { transpose_item(win + W_GATE_COL, W_IN_COLS, WinT + (size_t)C_GATE * DM, DM, WT_NB_G, scr, r, F.lane); return; } r -= WT_I_G;
    bf16* WbrT = WSP(bf16, WS_WBR + (size_t)l * 3 * MiB);
    if (r < WT_I_BR) { transpose_item(F.ap->in[I_WSB] + (size_t)l * 512 * DM, DM, WbrT, 512, 16, scr, r, F.lane); return; } r -= WT_I_BR;
    if (r < WT_I_BR) { transpose_item(F.ap->in[I_WHG] + (size_t)l * 512 * DM, DM, WbrT + (size_t)1024 * 512, 512, 16, scr, r, F.lane); return; } r -= WT_I_BR;
    if (r < WT_I_BR) { transpose_item(F.ap->in[I_WSSD] + (size_t)l * 512 * DM, DM, WbrT + (size_t)2048 * 512, 512, 16, scr, r, F.lane); return; } r -= WT_I_BR;
    transpose_item(F.ap->in[I_WOUT] + (size_t)l * DM * DM, DM, WSP(bf16, WS_WOUT + (size_t)l * 2 * MiB), DM, 16, scr, r, F.lane);
}
struct Win0 { const float* W; int nrow0, k0, n0; };
__device__ __forceinline__ Win0 win0_desc(Frame& F, int r) {
    const float* win = F.ap->in[I_WIN]; Win0 d;
    if (r < WT_I_A) { d.W = win; d.nrow0 = 0; d.k0 = 64 * (r / WT_NB_A); d.n0 = 64 * (r % WT_NB_A); }
    else { r -= WT_I_A; d.W = win + W_GATE_COL; d.nrow0 = C_GATE; d.k0 = 64 * (r / WT_NB_G); d.n0 = 64 * (r % WT_NB_G); }
    return d;
}
__device__ __forceinline__ void win0_fetch(Frame& F, int r, f32x4 (&v)[16]) { const Win0 d = win0_desc(F, r);
#pragma unroll
    for (int i = 0; i < 16; ++i) v[i] = __builtin_nontemporal_load((const GAS f32x4*)(d.W + (size_t)(d.k0 + 4 * i + (F.lane >> 4)) * W_IN_COLS + d.n0 + 4 * (F.lane & 15)));
}
__device__ __forceinline__ void win0_fetch_max(Frame& F, int r, f32x4 (&v)[16]) { const Win0 d = win0_desc(F, r); win0_fetch(F, r, v);
    float m[4] = {0.f, 0.f, 0.f, 0.f};
#pragma unroll
    for (int i = 0; i < 16; ++i) { m[0] = __builtin_fmaxf(m[0], fabsf(v[i].x)); m[1] = __builtin_fmaxf(m[1], fabsf(v[i].y)); m[2] = __builtin_fmaxf(m[2], fabsf(v[i].z)); m[3] = __builtin_fmaxf(m[3], fabsf(v[i].w)); }
#pragma unroll
    for (int e = 0; e < 4; ++e) { m[e] = __builtin_fmaxf(m[e], shx(m[e], 16, F.lane)); m[e] = __builtin_fmaxf(m[e], shx(m[e], 32, F.lane)); }
    if (F.lane < 16) { gu32* cm = (gu32*)(F.ap->ws + WS_CTL) + CW_CMAX + d.nrow0 + d.n0 + 4 * F.lane;
#pragma unroll
        for (int e = 0; e < 4; ++e) (void)__hip_atomic_fetch_max(cm + e, __builtin_bit_cast(unsigned, m[e]), RLX_AGENT); }
}
__device__ __forceinline__ void win0_quant(Frame& F, int r, const f32x4 (&v)[16], LAS float* scr) { const Win0 d = win0_desc(F, r); const int lane = F.lane;
#pragma unroll
    for (int i = 0; i < 16; ++i) { LAS float* p = scr + (4 * i + (lane >> 4)) * 65 + 4 * (lane & 15); p[0] = v[i].x; p[1] = v[i].y; p[2] = v[i].z; p[3] = v[i].w; }
    LDS_WAIT(); asm volatile("" ::: "memory");
    const int c = lane & 7; unsigned char* WT8 = (unsigned char*)WSP(bf16, WS_WIN);
#pragma unroll
    for (int j = 0; j < 8; ++j) { const int n = (lane >> 3) + 8 * j; const LAS float* s = scr + (8 * c) * 65 + n;
        const float cmx = __builtin_bit_cast(float, __hip_atomic_load((gu32*)(F.ap->ws + WS_CTL) + CW_CMAX + d.nrow0 + d.n0 + n, RLX_AGENT)); const float inv = cmx > 0.f ? 127.f / cmx : 0.f;
        v2u o; o.x = pk4i8(s[0 * 65] * inv, s[1 * 65] * inv, s[2 * 65] * inv, s[3 * 65] * inv); o.y = pk4i8(s[4 * 65] * inv, s[5 * 65] * inv, s[6 * 65] * inv, s[7 * 65] * inv);
        *(GAS v2u*)(WT8 + (size_t)(d.nrow0 + d.n0 + n) * DM + d.k0 + 8 * c) = o; }
    LDS_WAIT(); asm volatile("" ::: "memory");
}
__device__ __forceinline__ void p0_prologue(Frame& F) {
    const int gw = F.vcu * NWAVES + F.wave, NGW = F.G * NWAVES;
    constexpr int N_WIN0 = WT_I_A + WT_I_G;
    f32x4 hold[16]; const bool holds = MK_I8_INPROJ0 && gw < N_WIN0;
    {
        LAS float* scr = (LAS float*)(F.lds + F.wave * 16640);
        for (int it = gw; it < (MK_W1_LATE ? 1 : 2) * WT_PER_LAYER; it += NGW) { const int l = it / WT_PER_LAYER;
            if (MK_I8_INPROJ0 && it < N_WIN0) { f32x4 tv[16]; win0_fetch_max(F, it, tv); if (it == gw) {
#pragma unroll
                for (int i = 0; i < 16; ++i) hold[i] = tv[i]; } }
            else wt_item(F, l, it - l * WT_PER_LAYER, scr); }
    }
    if (gw < 16) { const int l = gw >> 3, q = gw & 7; const float* win = F.ap->in[I_WIN] + (size_t)l * DM * W_IN_COLS + W_DT_COL + q; bf16* dst = WSP(bf16, WS_WIN + (size_t)l * 16 * MiB) + (size_t)(NP + q) * DM;
        if (MK_I8_INPROJ0 && l == 0) { unsigned char* d8 = (unsigned char*)WSP(bf16, WS_WIN) + (size_t)(NP + q) * DM; float wv_[16], am = 0.f;
#pragma unroll
            for (int i = 0; i < 16; ++i) { wv_[i] = win[(size_t)(F.lane + 64 * i) * W_IN_COLS]; am = __builtin_fmaxf(am, fabsf(wv_[i])); }
            am = wave_max(am, F.lane); const float inv = am > 0.f ? 127.f / am : 0.f; if (F.lane == 0) ((float*)(F.ap->ws + WS_CTL))[CW_CMAX + NP + q] = am;
#pragma unroll
            for (int i = 0; i < 16; ++i) d8[F.lane + 64 * i] = (unsigned char)((int)__builtin_rintf(wv_[i] * inv) & 0xff); }
        else if ((MK_FP8_INPROJ0 && l == 0) || (MK_FP8_INPROJ1 && l == 1)) { unsigned char* d8 = (unsigned char*)WSP(bf16, WS_WIN + (size_t)l * 16 * MiB) + (size_t)(NP + q) * DM; for (int d = F.lane; d < DM; d += 64) d8[d] = (unsigned char)(pk4f8(win[(size_t)d * W_IN_COLS] * 64.f, 0.f, 0.f, 0.f) & 0xffu); }
        else for (int d = F.lane; d < DM; d += 64) dst[d] = (bf16)f2bf(win[(size_t)d * W_IN_COLS]); }
    __syncthreads();
    for (int it = F.vcu; it < 512; it += F.G) { const int l = it >> 8;
        weff_item(F, F.ap->in[I_WQ] + (size_t)l * DM * 2048, F.ap->in[I_SK] + (size_t)l * 16 * 128 * 128, WSP(bf16, WS_WEFF + (size_t)l * 4 * MiB), it & 255, l == 1 ? (MK_FP8_PEERQ1 != 0) : (MK_FP8_PEERQ0 != 0), F.ap->in[I_N2] + (size_t)l * DM); }
    __syncthreads();
    if (MK_I8_INPROJ0) {
        { XcdBarrier bar; bar.bar = (unsigned*)(F.ap->ws + WS_CTL) + CW_BAR; bar.x = xb_xcc_id(); bar.st = (volatile LAS unsigned*)((LAS unsigned char*)F.lds + MISC_OFF) + 8; xcd_barrier(bar, F.tid); }
        LAS float* scr = (LAS float*)(F.lds + F.wave * 16640);
        if (holds) win0_quant(F, gw, hold, scr);
        for (int it = gw + NGW; it < N_WIN0; it += NGW) { f32x4 tv[16]; win0_fetch(F, it, tv); win0_quant(F, it, tv, scr); }
        __syncthreads(); }
    { f32x4 nx[4];
      { const GAS f32x4* xr = (const GAS f32x4*)(F.ap->in[I_X] + (size_t)gw * DM) + F.lane;
#pragma unroll
        for (int j = 0; j < 4; ++j) nx[j] = xr[64 * j]; }
      for (int m = gw; m < TT; m += NGW) {
        f32x4 v[4];
#pragma unroll
        for (int j = 0; j < 4; ++j) v[j] = nx[j];
        if (m + NGW < TT) { const GAS f32x4* xr = (const GAS f32x4*)(F.ap->in[I_X] + (size_t)(m + NGW) * DM) + F.lane;
#pragma unroll
            for (int j = 0; j < 4; ++j) nx[j] = xr[64 * j]; }
        if (MK_I8_INPROJ0) norm_row_from_regs<false, false, true>(v, F.ap->in[I_N1], (bf16*)((unsigned char*)XNP + (size_t)m * DM), (const LAS float*)F.lds, WSP(float, WS_SSQ1) + m, F.lane);
        else norm_row_from_regs<false, MK_FP8_INPROJ0 != 0>(v, F.ap->in[I_N1], MK_FP8_INPROJ0 ? (bf16*)((unsigned char*)XNP + (size_t)m * DM) : XNP + (size_t)m * DM, (const LAS float*)F.lds, (float*)nullptr, F.lane);
      } }
    __syncthreads();
}
template <bool ISV> __device__ __forceinline__ void tables_items(Frame& F, int l, size_t i0, size_t step, size_t dstoff = (ISV ? WS_V8 : WS_U8)) {
    constexpr size_t N16 = (size_t)16384 * 1024 / 16;
    const float* T = F.ap->in[ISV ? I_V : I_U] + (size_t)l * 16384 * 1024; constexpr float sc = ISV ? 32.0f : 256.0f;
    for (size_t ib = i0; ib < N16; ib += 4 * step) {
        f32x4 a[4][4];
#pragma unroll
        for (int r = 0; r < 4; ++r) { const size_t j = ib + r * step; if (j < N16) {
#pragma unroll
            for (int q = 0; q < 4; ++q) a[r][q] = __builtin_nontemporal_load((const GAS f32x4*)(T + j * 16) + q); } }
#pragma unroll
        for (int r = 0; r < 4; ++r) { const size_t j = ib + r * step; if (j < N16) {
            v4u o;
            if constexpr (!ISV) {
#pragma unroll
                for (int q = 0; q < 4; ++q) a[r][q] = a[r][q] * *(const GAS f32x4*)(F.ap->in[I_N2] + (size_t)l * DM + (j & 63) * 16 + q * 4); }
#pragma unroll
            for (int q = 0; q < 4; ++q) { int p = 0; p = __builtin_amdgcn_cvt_pk_fp8_f32(a[r][q].x * sc, a[r][q].y * sc, p, false); p = __builtin_amdgcn_cvt_pk_fp8_f32(a[r][q].z * sc, a[r][q].w * sc, p, true); o[q] = (unsigned)p; }
            const size_t dst = (ISV || MK_UCOL) ? ((j & 63) >> 3) * (size_t)(16384 * 128) + (j >> 6) * 128 + (j & 7) * 16 : j * 16;
            *(GAS v4u*)(F.ap->ws + dstoff + dst) = o; } }
    }
}

__device__ __forceinline__ int crow(int r, int hi) { return (r & 3) + 8 * (r >> 2) + 4 * hi; }
__device__ __forceinline__ void sb_block(const f32x16& p, int kb  , int qi, float& R, float (&a)[16], int lane) {
    float beta[16], suf[16], tot[4], ptot[4];
#pragma unroll
    for (int g = 0; g < 4; ++g) {
        float omb[4];
#pragma unroll
        for (int i = 0; i < 4; ++i) { const int r = 4 * g + i; const float z = p[r] * 0.125f;
            const float e = __builtin_amdgcn_exp2f(-fabsf(z) * 1.4426950408889634f), rc = frcp(1.f + e), sm = e * rc;
            const bool pos = z >= 0.f, valid = (kb + i + 8 * g) < qi;
            beta[r] = valid ? (pos ? rc : sm) : 0.f; omb[i] = valid ? (pos ? sm : rc) : 1.f; }
        suf[4 * g + 3] = 1.f; suf[4 * g + 2] = omb[3]; suf[4 * g + 1] = omb[3] * omb[2]; suf[4 * g] = suf[4 * g + 1] * omb[1]; tot[g] = suf[4 * g] * omb[0];
    }
#pragma unroll
    for (int g = 0; g < 4; ++g) ptot[g] = shx(tot[g], 32, lane);
    const bool lo = lane < 32;
    float sp[4]; sp[3] = 1.f; sp[2] = tot[3] * ptot[3]; sp[1] = sp[2] * (tot[2] * ptot[2]); sp[0] = sp[1] * (tot[1] * ptot[1]);
    const float total = sp[0] * (tot[0] * ptot[0]);
#pragma unroll
    for (int g = 0; g < 4; ++g) { const float af = R * sp[g] * (lo ? ptot[g] : 1.f);
#pragma unroll
        for (int i = 0; i < 4; ++i) a[4 * g + i] = beta[4 * g + i] * af * suf[4 * g + i]; }
    R *= total;
}
__device__ __forceinline__ void sb_attn_wave(const bf16* PROJ, bf16* Y0, int b, int h, int qblk, LAS bf16* vt  , int lane) {
    const int r32 = lane & 31, hi = lane >> 5;
    const size_t rowbase = (size_t)b * SEQ;
    const int qw = qblk * 32, qi = qw + r32;
    bf16x8 qf[4];
    { const bf16* qp = PROJ + (rowbase + qi) * NP + C_SBQ + h * 64 + hi * 8;
#pragma unroll
      for (int d0 = 0; d0 < 4; ++d0) qf[d0] = *(const GAS bf16x8*)(qp + d0 * 16); }
    f32x16 o0 = {}, o1 = {};
    float R = 1.0f;
    for (int kt = (qw + 30) >> 6; kt >= 0; --kt) {
        const bf16* kp = PROJ + (rowbase + (size_t)kt * 64 + r32) * NP + C_SBK + h * 64 + hi * 8;
        bf16x8 kf0[4], kf1[4];
#pragma unroll
        for (int d0 = 0; d0 < 4; ++d0) { kf0[d0] = *(const GAS bf16x8*)(kp + d0 * 16); kf1[d0] = *(const GAS bf16x8*)(kp + (size_t)32 * NP + d0 * 16); }
        { const bf16* vp = PROJ + (rowbase + (size_t)kt * 64 + (lane >> 3)) * NP + C_SBV + h * 64 + (lane & 7) * 8;
          bf16x8 vv[8];
#pragma unroll
          for (int i = 0; i < 8; ++i) vv[i] = *(const GAS bf16x8*)(vp + (size_t)(8 * i) * NP);
#pragma unroll
          for (int i = 0; i < 8; ++i)
#pragma unroll
              for (int e = 0; e < 8; ++e) vt[((lane & 7) * 8 + e) * 72 + (lane >> 3) + 8 * i] = (bf16)vv[i][e]; }
        f32x16 p0 = {}, p1 = {};
#pragma unroll
        for (int d0 = 0; d0 < 4; ++d0) { p0 = MFMA32(kf0[d0], qf[d0], p0); p1 = MFMA32(kf1[d0], qf[d0], p1); }
        float a1[16], a0[16];
        sb_block(p1, kt * 64 + 32 + 4 * hi, qi, R, a1, lane);
        sb_block(p0, kt * 64 + 4 * hi, qi, R, a0, lane);
        bf16x8 pa[4]; pa[0] = pack8(a0); pa[1] = pack8(a0 + 8); pa[2] = pack8(a1); pa[3] = pack8(a1 + 8);
        LDS_WAIT();
#pragma unroll
        for (int s = 0; s < 4; ++s) {
            const LAS bf16* v0p = vt + r32 * 72 + 16 * s + 4 * hi; const LAS bf16* v1p = vt + (32 + r32) * 72 + 16 * s + 4 * hi;
            const v2u x0 = *(const LAS v2u*)v0p, x1 = *(const LAS v2u*)(v0p + 8), y0 = *(const LAS v2u*)v1p, y1 = *(const LAS v2u*)(v1p + 8);
            const bf16x8 vb0 = __builtin_bit_cast(bf16x8, (v4u){x0.x, x0.y, x1.x, x1.y}), vb1 = __builtin_bit_cast(bf16x8, (v4u){y0.x, y0.y, y1.x, y1.y});
            o0 = MFMA32(pa[s], vb0, o0); o1 = MFMA32(pa[s], vb1, o1);
        }
        LDS_WAIT();
        if (__all(R < 1e-37f)) break;
    }
    bf16* yp = Y0 + (rowbase + qw) * 512 + h * 64 + r32;
#pragma unroll
    for (int r = 0; r < 16; ++r) { const int q = crow(r, hi); yp[(size_t)q * 512] = (bf16)f2bf(o0[r]); yp[(size_t)q * 512 + 32] = (bf16)f2bf(o1[r]); }
}
__device__ __forceinline__ void p_sb_attn(Frame& F) {
    LAS bf16* vt = (LAS bf16*)(F.lds + F.wave * 9216);
    const int gw = F.vcu * NWAVES + F.wave, NGW = F.G * NWAVES;
    for (int u = gw, it_ = 0; u < 4096; u += NGW, ++it_) sb_attn_wave(WSP(bf16, WS_PROJ), WSP(bf16, WS_Y), u >> 11, (u >> 8) & 7, (it_ & 1) ? 255 - (u & 255) : (u & 255), vt, F.lane);
}

__device__ __forceinline__ float hg_lb(const float* lbl, int l, int kk) { return l == 0 ? 0.f : sigmoidf_(lbl[512 + kk] - lbl[kk]); }
__device__ __forceinline__ void ld8f(const LAS float* p, float* v) { const f32x4 a = *(const LAS f32x4*)p, b = *(const LAS f32x4*)(p + 4); v[0] = a.x; v[1] = a.y; v[2] = a.z; v[3] = a.w; v[4] = b.x; v[5] = b.y; v[6] = b.z; v[7] = b.w; }
constexpr int HG_P = 132;
__device__ __forceinline__ void hg_local_unit(Frame& F, int l, int b, int h, int c) {
    LAS float* Bc = (LAS float*)F.lds;
    LAS float* Ky = (LAS float*)(F.lds + 33792);
    LAS bf16* Vt = (LAS bf16*)(F.lds + 67584);
    LAS float* Sg = (LAS float*)(F.lds + 86016);
    const bf16* PROJ = WSP(bf16, WS_PROJ);
    const size_t row0 = (size_t)b * SEQ + (size_t)c * 64;
    const int tid = F.tid, lane = F.lane, w = F.wave, fr = lane & 15, quad = lane >> 4;
    float lbv[8];
#pragma unroll
    for (int j = 0; j < 8; ++j) lbv[j] = hg_lb(F.ap->in[I_LB], l, h * 128 + (tid & 15) * 8 + j);
    for (int e = tid; e < 64 * 16; e += 512) { const int t = e >> 4, k8 = (e & 15) * 8;
        float fv[8]; unpack8(*(const GAS v4u*)(PROJ + (row0 + t) * NP + C_HGF + h * 128 + k8), fv);
#pragma unroll
        for (int j = 0; j < 8; ++j) { const float lb = lbv[j];
            const float ee = fexp(-fabsf(fv[j])), rc = frcp(1.f + ee), sm = ee * rc; const bool pos = fv[j] >= 0.f;
            const float sg = pos ? rc : sm, sgn = pos ? sm : rc;
            const float f = lb + (1.f - lb) * sg;
            Bc[t * HG_P + k8 + j] = __logf(fmaxf(f, 1e-30f)); Ky[t * HG_P + k8 + j] = (1.f - lb) * sgn; }
        const v4u iv = *(const GAS v4u*)(PROJ + (row0 + t) * NP + C_HGI + h * 128 + k8);
        Vt[(k8 + 0) * 72 + t] = (bf16)(iv.x & 0xffff); Vt[(k8 + 1) * 72 + t] = (bf16)(iv.x >> 16); Vt[(k8 + 2) * 72 + t] = (bf16)(iv.y & 0xffff); Vt[(k8 + 3) * 72 + t] = (bf16)(iv.y >> 16);
        Vt[(k8 + 4) * 72 + t] = (bf16)(iv.z & 0xffff); Vt[(k8 + 5) * 72 + t] = (bf16)(iv.z >> 16); Vt[(k8 + 6) * 72 + t] = (bf16)(iv.w & 0xffff); Vt[(k8 + 7) * 72 + t] = (bf16)(iv.w >> 16); }
    __syncthreads();
    { const int seg = tid >> 7, k = tid & 127; float run = 0.f;
#pragma unroll
      for (int i = 0; i < 16; ++i) { run += Bc[(seg * 16 + i) * HG_P + k]; Bc[(seg * 16 + i) * HG_P + k] = run; }
      Sg[seg * 128 + k] = run;
      __syncthreads();
      float off = 0.f;
#pragma unroll
      for (int s = 0; s < 3; ++s) if (s < seg) off += Sg[s * 128 + k];
      if (seg)
#pragma unroll
          for (int i = 0; i < 16; ++i) Bc[(seg * 16 + i) * HG_P + k] += off; }
    __syncthreads();
    if (tid < 128) WSP(float, WS_DCH)[(((size_t)(b * 4 + h)) * 128 + c) * 128 + tid] = fexp(Bc[63 * HG_P + tid]);
    {
        const int I = (w < 4) ? (w >> 1) : 3 - ((w - 4) >> 1), vh = w & 1;
        const int tl = 16 * I + fr;
        bf16x8 bq[4];
#pragma unroll
        for (int ks = 0; ks < 4; ++ks) { const int k0 = 32 * ks + 8 * quad;
            float qv[8], bt[8], rf[8], o[8], oq[8];
            unpack8(*(const GAS v4u*)(PROJ + (row0 + tl) * NP + C_HGQ + h * 128 + k0), qv);
            ld8f(Bc + tl * HG_P + k0, bt);
            if (I > 0) ld8f(Bc + (16 * I - 1) * HG_P + k0, rf); else {
#pragma unroll
                for (int j = 0; j < 8; ++j) rf[j] = 0.f; }
#pragma unroll
            for (int j = 0; j < 8; ++j) { const float qs = siluf_(qv[j]) * 0.08838834764831845f; o[j] = qs * fexp(bt[j] - rf[j]); oq[j] = qs * fexp(bt[j]); }
            bq[ks] = pack8(o);
            if (vh == 0) *(GAS bf16x8*)(WSP(bf16, WS_QT) + (row0 + tl) * 512 + h * 128 + k0) = pack8(oq);
        }
        f32x4 sT[4];
#pragma unroll
        for (int J = 0; J < 4; ++J) { sT[J] = (f32x4){0.f, 0.f, 0.f, 0.f};
            if (J <= I) { const int sl = 16 * J + fr;
#pragma unroll
                for (int ks = 0; ks < 4; ++ks) { const int k0 = 32 * ks + 8 * quad; float kv[8], bs[8], rf[8], o[8];
                    ld8f(Ky + sl * HG_P + k0, kv); ld8f(Bc + sl * HG_P + k0, bs);
                    if (I > 0) ld8f(Bc + (16 * I - 1) * HG_P + k0, rf); else {
#pragma unroll
                        for (int j = 0; j < 8; ++j) rf[j] = 0.f; }
#pragma unroll
                    for (int j = 0; j < 8; ++j) o[j] = kv[j] * fexp(fminf(rf[j] - bs[j], 80.f));
                    sT[J] = MFMA16(pack8(o), bq[ks], sT[J]); }
                if (J == I) {
#pragma unroll
                    for (int r = 0; r < 4; ++r) if (4 * quad + r > fr) sT[J][r] = 0.f; }
            } }
        bf16x8 bs0, bs1;
        { float t0[8] = {sT[0][0], sT[0][1], sT[0][2], sT[0][3], sT[1][0], sT[1][1], sT[1][2], sT[1][3]}; bs0 = pack8(t0);
          float t1[8] = {sT[2][0], sT[2][1], sT[2][2], sT[2][3], sT[3][0], sT[3][1], sT[3][2], sT[3][3]}; bs1 = pack8(t1); }
#pragma unroll
        for (int vi = 0; vi < 4; ++vi) { const int vb = vh * 4 + vi; const LAS bf16* vp = Vt + (16 * vb + fr) * 72 + 4 * quad;
            f32x4 acc = {0.f, 0.f, 0.f, 0.f};
            { const v2u x0 = *(const LAS v2u*)vp, x1 = *(const LAS v2u*)(vp + 16); acc = MFMA16(__builtin_bit_cast(bf16x8, (v4u){x0.x, x0.y, x1.x, x1.y}), bs0, acc); }
            if (I >= 2) { const v2u x0 = *(const LAS v2u*)(vp + 32), x1 = *(const LAS v2u*)(vp + 48); acc = MFMA16(__builtin_bit_cast(bf16x8, (v4u){x0.x, x0.y, x1.x, x1.y}), bs1, acc); }
            v2u o; o.x = pk2(acc[0], acc[1]); o.y = pk2(acc[2], acc[3]);
            *(GAS v2u*)(WSP(bf16, WS_OI) + (row0 + tl) * 512 + h * 128 + 16 * vb + 4 * quad) = o; }
    }
    {
        const int k = 16 * w + fr; const float bl = Bc[63 * HG_P + k];
        bf16x8 bk[2];
#pragma unroll
        for (int ks = 0; ks < 2; ++ks) { float o[8];
#pragma unroll
            for (int j = 0; j < 8; ++j) { const int s = 32 * ks + 8 * quad + j; o[j] = Ky[s * HG_P + k] * fexp(bl - Bc[s * HG_P + k]); }
            bk[ks] = pack8(o); }
        bf16* S = WSP(bf16, WS_HGS) + (((size_t)(b * 4 + h)) * 128 + c) * 16384;
#pragma unroll
        for (int vb = 0; vb < 8; ++vb) { f32x4 acc = {0.f, 0.f, 0.f, 0.f};
#pragma unroll
            for (int ks = 0; ks < 2; ++ks) acc = MFMA16(*(const LAS bf16x8*)(Vt + (16 * vb + fr) * 72 + 32 * ks + 8 * quad), bk[ks], acc);
#pragma unroll
            for (int r = 0; r < 4; ++r) S[(size_t)(16 * vb + 4 * quad + r) * 128 + k] = (bf16)f2bf(acc[r]); }
    }
    __syncthreads();
}
struct HgOutRegs { v4u qv[2]; bf16x8 af[4]; v2u oiv[4], gvv[4]; };
__device__ __forceinline__ void hg_out_load(Frame& F, int b, int h, int c, HgOutRegs& R) {
    const bf16* PROJ = WSP(bf16, WS_PROJ);
    const size_t row0 = (size_t)b * SEQ + (size_t)c * 64;
    const int lane = F.lane, w = F.wave, fr = lane & 15, quad = lane >> 4;
    const bf16* S = WSP(bf16, WS_HGS) + (((size_t)(b * 4 + h)) * 128 + c) * 16384;
#pragma unroll
    for (int it = 0; it < 2; ++it) { const int e = F.tid + 512 * it; R.qv[it] = *(const GAS v4u*)(WSP(bf16, WS_QT) + (row0 + (e >> 4)) * 512 + h * 128 + (e & 15) * 8); }
#pragma unroll
    for (int ks = 0; ks < 4; ++ks) R.af[ks] = *(const GAS bf16x8*)(S + (size_t)(16 * w + fr) * 128 + 32 * ks + 8 * quad);
#pragma unroll
    for (int tb = 0; tb < 4; ++tb) { R.oiv[tb] = *(const GAS v2u*)(WSP(bf16, WS_OI) + (row0 + 16 * tb + fr) * 512 + h * 128 + 16 * w + 4 * quad); R.gvv[tb] = *(const GAS v2u*)(PROJ + (row0 + 16 * tb + fr) * NP + C_HGG + h * 128 + 16 * w + 4 * quad); }
}
__device__ __forceinline__ void hg_out_compute(Frame& F, int l, int b, int h, int c, const HgOutRegs& R) {
    LAS float* SS = (LAS float*)F.lds;
    const size_t row0 = (size_t)b * SEQ + (size_t)c * 64;
    const int lane = F.lane, w = F.wave, fr = lane & 15, quad = lane >> 4;
    LAS bf16* Qs = (LAS bf16*)(F.lds + 2048);
    const f32x4 nw = *(const GAS f32x4*)(F.ap->in[I_HGN] + (size_t)l * 128 + 16 * w + 4 * quad);
#pragma unroll
    for (int it = 0; it < 2; ++it) { const int e = F.tid + 512 * it; *(LAS v4u*)(Qs + (e >> 4) * 136 + (e & 15) * 8) = R.qv[it]; }
    __syncthreads();
    f32x4 o[4];
#pragma unroll
    for (int tb = 0; tb < 4; ++tb) { o[tb] = (f32x4){0.f, 0.f, 0.f, 0.f};
#pragma unroll
        for (int ks = 0; ks < 4; ++ks) o[tb] = MFMA16(R.af[ks], *(const LAS bf16x8*)(Qs + (16 * tb + fr) * 136 + 32 * ks + 8 * quad), o[tb]);
        const v2u oi = R.oiv[tb];
        o[tb][0] += bflo(oi.x); o[tb][1] += bfhi(oi.x); o[tb][2] += bflo(oi.y); o[tb][3] += bfhi(oi.y);
        float ss = (o[tb][0] * o[tb][0] + o[tb][1] * o[tb][1]) + (o[tb][2] * o[tb][2] + o[tb][3] * o[tb][3]);
        ss += shx(ss, 16, lane); ss += shx(ss, 32, lane);
        if (quad == 0) SS[w * 64 + 16 * tb + fr] = ss; }
    __syncthreads();
#pragma unroll
    for (int tb = 0; tb < 4; ++tb) { const int t = 16 * tb + fr; float tot = 0.f;
#pragma unroll
        for (int ww = 0; ww < 8; ++ww) tot += SS[ww * 64 + t];
        const float rstd = frsq(tot * (1.f / 128.f) + EPS);
        const v2u gv = R.gvv[tb];
        const float y0 = o[tb][0] * rstd * nw.x * siluf_(bflo(gv.x)), y1 = o[tb][1] * rstd * nw.y * siluf_(bfhi(gv.x)), y2 = o[tb][2] * rstd * nw.z * siluf_(bflo(gv.y)), y3 = o[tb][3] * rstd * nw.w * siluf_(bfhi(gv.y));
        v2u ov; ov.x = pk2(y0, y1); ov.y = pk2(y2, y3);
        *(GAS v2u*)(WSP(bf16, WS_Y) + (size_t)TT * 512 + (row0 + t) * 512 + h * 128 + 16 * w + 4 * quad) = ov; }
    __syncthreads();
}
__device__ __forceinline__ void hg_out_units(Frame& F, int l, int first, int stride) {
    if (first >= 1024) return;
    HgOutRegs Ra, Rb;
#define HGO_B(u) ((u) >> 9)
#define HGO_H(u) (((u) >> 7) & 3)
#define HGO_C(u) ((u) & 127)
    hg_out_load(F, HGO_B(first), HGO_H(first), HGO_C(first), Ra);
    for (int u = first; u < 1024; u += 2 * stride) {
        const int u1 = u + stride, u2 = u + 2 * stride;
        { const int un = u1 < 1024 ? u1 : u; hg_out_load(F, HGO_B(un), HGO_H(un), HGO_C(un), Rb); }
        hg_out_compute(F, l, HGO_B(u), HGO_H(u), HGO_C(u), Ra);
        if (u1 >= 1024) break;
        { const int un = u2 < 1024 ? u2 : u1; hg_out_load(F, HGO_B(un), HGO_H(un), HGO_C(un), Ra); }
        hg_out_compute(F, l, HGO_B(u1), HGO_H(u1), HGO_C(u1), Rb);
    }
#undef HGO_B
#undef HGO_H
#undef HGO_C
}

constexpr int SL_CM = 0, SL_BM = 18432, SL_BT = 36864, SL_XT = 54272, SL_AC = 123904, SL_DT = 125952;
#define SL_SWZ(row) ((((row) >> 3) & 15) << 3)
__device__ __forceinline__ void ssd_local_unit(Frame& F, int l, int b, int c, int g) {
    LAS bf16* Cm = (LAS bf16*)(F.lds + SL_CM); LAS bf16* Bm = (LAS bf16*)(F.lds + SL_BM); LAS bf16* Bt = (LAS bf16*)(F.lds + SL_BT); LAS bf16* Xt = (LAS bf16*)(F.lds + SL_XT);
    LAS float* AC = (LAS float*)(F.lds + SL_AC); LAS float* DT = (LAS float*)(F.lds + SL_DT);
    const bf16* PROJ = WSP(bf16, WS_PROJ);
    const size_t row0 = (size_t)b * SEQ + (size_t)c * 128;
    const int tid = F.tid, lane = F.lane, w = F.wave, fr = lane & 15, quad = lane >> 4;
    if (w < 4) { const int head = 4 * g + w; const float bias = F.ap->in[I_DTB][l * 8 + head], A = -fexp(F.ap->in[I_ALOG][l * 8 + head]);
        float dt[2], a[2];
#pragma unroll
        for (int i = 0; i < 2; ++i) { const float x = WSP(float, WS_DT)[(row0 + 2 * lane + i) * 8 + head] + bias; dt[i] = x > 20.f ? x : __logf(1.f + fexp(x)); a[i] = A * dt[i]; }
        float v = a[0] + a[1], inc = v;
#pragma unroll
        for (int o = 1; o < 64; o <<= 1) { const float t = shi(inc, lane >= o ? lane - o : lane); if (lane >= o) inc += t; }
        const float ex = inc - v;
        AC[w * 128 + 2 * lane] = ex + a[0]; AC[w * 128 + 2 * lane + 1] = ex + v; DT[w * 128 + 2 * lane] = dt[0]; DT[w * 128 + 2 * lane + 1] = dt[1]; }
    if (tid < 384) { const float* cw = F.ap->in[I_CW] + (size_t)l * 4 * 768; const float* cb = F.ap->in[I_CB] + (size_t)l * 768;
        const int cgp = tid % 48, rb = tid / 48;
        const int ch = cgp < 32 ? 256 * g + 8 * cgp : (cgp < 40 ? 512 + 64 * g + 8 * (cgp - 32) : 640 + 64 * g + 8 * (cgp - 40));
        f32x4 wk[4][2];
#pragma unroll
        for (int k = 0; k < 4; ++k) { wk[k][0] = *(const GAS f32x4*)(cw + k * 768 + ch); wk[k][1] = *(const GAS f32x4*)(cw + k * 768 + ch + 4); }
        const f32x4 b0 = *(const GAS f32x4*)(cb + ch), b1 = *(const GAS f32x4*)(cb + ch + 4);
#pragma unroll 1
        for (int hf = 0; hf < 2; ++hf) {
        v4u xr[11];
#pragma unroll
        for (int i = 0; i < 11; ++i) { const int lt = 16 * rb + 8 * hf - 3 + i; const bool ok = c > 0 || lt >= 0;
            xr[i] = *(const GAS v4u*)(PROJ + (size_t)((long)row0 + (ok ? lt : 0)) * NP + C_XBC + ch); if (!ok) xr[i] = (v4u){0u, 0u, 0u, 0u}; }
#pragma unroll
        for (int j = 0; j < 8; ++j) { const int lr = 16 * rb + 8 * hf + j;
            float acc[8] = {b0.x, b0.y, b0.z, b0.w, b1.x, b1.y, b1.z, b1.w};
#pragma unroll
            for (int k = 0; k < 4; ++k) { float xv[8]; unpack8(xr[j + k], xv);
                acc[0] += wk[k][0].x * xv[0]; acc[1] += wk[k][0].y * xv[1]; acc[2] += wk[k][0].z * xv[2]; acc[3] += wk[k][0].w * xv[3]; acc[4] += wk[k][1].x * xv[4]; acc[5] += wk[k][1].y * xv[5]; acc[6] += wk[k][1].z * xv[6]; acc[7] += wk[k][1].w * xv[7]; }
#pragma unroll
            for (int q = 0; q < 8; ++q) acc[q] = siluf_(acc[q]);
            if (cgp < 32) {
#pragma unroll
                for (int q = 0; q < 8; ++q) Xt[(8 * cgp + q) * 136 + (lr ^ SL_SWZ(8 * cgp + q))] = (bf16)f2bf(acc[q]);
            } else if (cgp < 40) { const int n0 = 8 * (cgp - 32); *(LAS bf16x8*)(Bm + lr * 72 + n0) = pack8(acc);
#pragma unroll
                for (int q = 0; q < 8; ++q) Bt[(n0 + q) * 136 + (lr ^ SL_SWZ(n0 + q))] = (bf16)f2bf(acc[q]);
            } else { const int n0 = 8 * (cgp - 40); *(LAS bf16x8*)(Cm + lr * 72 + n0) = pack8(acc); } } } }
    __syncthreads();
    for (int e = tid; e < 128 * 32; e += 512) { const int lr = e >> 5, hh = (e >> 3) & 3, n8 = (e & 7) * 8; float cv[8]; unpack8(*(const LAS v4u*)(Cm + lr * 72 + n8), cv);
        const float ea = fexp(AC[hh * 128 + lr]);
#pragma unroll
        for (int j = 0; j < 8; ++j) cv[j] *= ea;
        *(GAS bf16x8*)(WSP(bf16, WS_CE) + (row0 + lr) * 512 + (4 * g + hh) * 64 + n8) = pack8(cv); }
    if (tid < 4) WSP(float, WS_ATOT)[((size_t)b * 64 + c) * 8 + 4 * g + tid] = AC[tid * 128 + 127];
    for (int ps_ = 0; ps_ < 2; ++ps_) { const int wq = ps_ ? 7 - w : w;
        const int ll = 16 * wq + fr;
        bf16x8 cf[2];
#pragma unroll
        for (int ks = 0; ks < 2; ++ks) cf[ks] = *(const LAS bf16x8*)(Cm + ll * 72 + 32 * ks + 8 * quad);
        f32x4 gT[8];
#pragma unroll
        for (int sb = 0; sb < 8; ++sb) { gT[sb] = (f32x4){0.f, 0.f, 0.f, 0.f};
            if (sb <= wq) {
#pragma unroll
                for (int ks = 0; ks < 2; ++ks) gT[sb] = MFMA16(*(const LAS bf16x8*)(Bm + (16 * sb + fr) * 72 + 32 * ks + 8 * quad), cf[ks], gT[sb]); } }
#pragma unroll 1
        for (int hh = 2 * ps_; hh < 2 * ps_ + 2; ++hh) { const int head = 4 * g + hh; const float al = AC[hh * 128 + ll], dsk = F.ap->in[I_DSK][l * 8 + head];
            f32x4 yT[4];
#pragma unroll
            for (int pb = 0; pb < 4; ++pb) yT[pb] = (f32x4){0.f, 0.f, 0.f, 0.f};
#pragma unroll
            for (int pj = 0; pj < 4; ++pj) if (2 * pj <= wq) {
                float o[8];
#pragma unroll
                for (int j = 0; j < 8; ++j) { const int sb = 2 * pj + (j >> 2), s = 16 * sb + 4 * quad + (j & 3);
                    const float gv = (j < 4) ? gT[2 * pj][j & 3] : gT[2 * pj + 1][j & 3];
                    float v = gv * fexp(fminf(al - AC[hh * 128 + s], 0.f)) * DT[hh * 128 + s];
                    if (s == ll) v += dsk;
                    o[j] = (s <= ll) ? v : 0.f; }
                const bf16x8 bfr = pack8(o);
#pragma unroll
                for (int pb = 0; pb < 4; ++pb) { const int xr_ = hh * 64 + 16 * pb + fr; const LAS bf16* xp = Xt + xr_ * 136;
                    const v2u x0 = *(const LAS v2u*)(xp + ((32 * pj + 4 * quad) ^ SL_SWZ(xr_))), x1 = *(const LAS v2u*)(xp + ((32 * pj + 4 * quad + 16) ^ SL_SWZ(xr_)));
                    yT[pb] = MFMA16(__builtin_bit_cast(bf16x8, (v4u){x0.x, x0.y, x1.x, x1.y}), bfr, yT[pb]); } }
#pragma unroll
            for (int pb = 0; pb < 4; ++pb) { v2u ov; ov.x = pk2(yT[pb][0], yT[pb][1]); ov.y = pk2(yT[pb][2], yT[pb][3]);
                *(GAS v2u*)(WSP(bf16, WS_YD) + (row0 + ll) * 512 + head * 64 + 16 * pb + 4 * quad) = ov; } }
    }
    {
        const int hh = w >> 1, head = 4 * g + hh, pb0 = (w & 1) * 2; const float alast = AC[hh * 128 + 127];
        f32x4 st[2][4];
#pragma unroll
        for (int i = 0; i < 2; ++i)
#pragma unroll
            for (int nb = 0; nb < 4; ++nb) st[i][nb] = (f32x4){0.f, 0.f, 0.f, 0.f};
#pragma unroll
        for (int ks = 0; ks < 4; ++ks) { const int s0 = 32 * ks + 8 * quad; float wv[8];
#pragma unroll
            for (int j = 0; j < 8; ++j) wv[j] = fexp(alast - AC[hh * 128 + s0 + j]) * DT[hh * 128 + s0 + j];
            bf16x8 xa[2];
#pragma unroll
            for (int i = 0; i < 2; ++i) { const int xr_ = hh * 64 + 16 * (pb0 + i) + fr; xa[i] = *(const LAS bf16x8*)(Xt + xr_ * 136 + (s0 ^ SL_SWZ(xr_))); }
#pragma unroll
            for (int nb = 0; nb < 4; ++nb) { float bv[8]; unpack8(*(const LAS v4u*)(Bt + (16 * nb + fr) * 136 + (s0 ^ SL_SWZ(16 * nb + fr))), bv);
#pragma unroll
                for (int j = 0; j < 8; ++j) bv[j] *= wv[j];
                const bf16x8 bfr = pack8(bv);
#pragma unroll
                for (int i = 0; i < 2; ++i) st[i][nb] = MFMA16(xa[i], bfr, st[i][nb]); } }
        bf16* S = WSP(bf16, WS_SSDS) + ((((size_t)b * 64 + c) * 8 + head) * 4096);
#pragma unroll
        for (int i = 0; i < 2; ++i)
#pragma unroll
            for (int nb = 0; nb < 4; ++nb)
#pragma unroll
                for (int r = 0; r < 4; ++r) S[(size_t)(16 * (pb0 + i) + 4 * quad + r) * 64 + 16 * nb + fr] = (bf16)f2bf(st[i][nb][r]);
    }
    __syncthreads();
}
__device__ __forceinline__ void ssd_out_unit(Frame& F, int l, int b, int c, int g) {
    const bf16* PROJ = WSP(bf16, WS_PROJ);
    const size_t row0 = (size_t)b * SEQ + (size_t)c * 128;
    const int lane = F.lane, w = F.wave, fr = lane & 15, quad = lane >> 4;
    const size_t row = row0 + 16 * w + fr;
    f32x4 yT[4][4]; float ss = 0.f;
#pragma unroll
    for (int hh = 0; hh < 4; ++hh) { const int head = 4 * g + hh;
        bf16x8 cf[2];
#pragma unroll
        for (int ks = 0; ks < 2; ++ks) cf[ks] = *(const GAS bf16x8*)(WSP(bf16, WS_CE) + row * 512 + head * 64 + 32 * ks + 8 * quad);
        const bf16* S = WSP(bf16, WS_SSDS) + ((((size_t)b * 64 + c) * 8 + head) * 4096);
#pragma unroll
        for (int pb = 0; pb < 4; ++pb) { f32x4 acc = {0.f, 0.f, 0.f, 0.f};
#pragma unroll
            for (int ks = 0; ks < 2; ++ks) acc = MFMA16(*(const GAS bf16x8*)(S + (size_t)(16 * pb + fr) * 64 + 32 * ks + 8 * quad), cf[ks], acc);
            const int col = head * 64 + 16 * pb + 4 * quad;
            const v2u yd = *(const GAS v2u*)(WSP(bf16, WS_YD) + row * 512 + col), zv = *(const GAS v2u*)(PROJ + row * NP + C_SSDZ + col);
            acc[0] = (acc[0] + bflo(yd.x)) * siluf_(bflo(zv.x)); acc[1] = (acc[1] + bfhi(yd.x)) * siluf_(bfhi(zv.x)); acc[2] = (acc[2] + bflo(yd.y)) * siluf_(bflo(zv.y)); acc[3] = (acc[3] + bfhi(yd.y)) * siluf_(bfhi(zv.y));
            ss += (acc[0] * acc[0] + acc[1] * acc[1]) + (acc[2] * acc[2] + acc[3] * acc[3]);
            yT[hh][pb] = acc; } }
    ss += shx(ss, 16, lane); ss += shx(ss, 32, lane);
    const float rstd = frsq(ss * (1.f / 256.f) + EPS);
#pragma unroll
    for (int hh = 0; hh < 4; ++hh)
#pragma unroll
        for (int pb = 0; pb < 4; ++pb) { const int col = (4 * g + hh) * 64 + 16 * pb + 4 * quad; const f32x4 nw = *(const GAS f32x4*)(F.ap->in[I_SSDN] + (size_t)l * 512 + col);
            v2u ov; ov.x = pk2(yT[hh][pb][0] * rstd * nw.x, yT[hh][pb][1] * rstd * nw.y); ov.y = pk2(yT[hh][pb][2] * rstd * nw.z, yT[hh][pb][3] * rstd * nw.w);
            *(GAS v2u*)(WSP(bf16, WS_Y) + (size_t)2 * TT * 512 + row * 512 + col) = ov; }
}
template <bool DRY> __device__ __forceinline__ void p_scan(Frame& F) {
    if (F.wave < 4) {
        const int gt = F.vcu * 256 + F.tid;
        if (gt < 65536) {
        const int bh = gt >> 13, pr = gt & 8191, k = (2 * pr) & 127;
        unsigned* S = (unsigned*)(WSP(bf16, WS_HGS) + (size_t)bh * 128 * 16384) + pr; const float* D = WSP(float, WS_DCH) + (size_t)bh * 128 * 128 + k;
        float r0 = 0.f, r1 = 0.f;
        unsigned xa[16], xb[16]; f32x2 da[16], db[16];
#define SC_LD(X_, D_, c0) do { _Pragma("unroll") for (int i = 0; i < 16; ++i) { X_[i] = __builtin_nontemporal_load((const GAS unsigned*)(S + (size_t)((c0) + i) * 8192)); D_[i] = *(const GAS f32x2*)(D + (size_t)((c0) + i) * 128); } } while (0)
#define SC_PROC(X_, D_, c0) do { _Pragma("unroll") for (int i = 0; i < 16; ++i) { const unsigned pv = pk2(r0, r1); if constexpr (!DRY) *(GAS unsigned*)(S + (size_t)((c0) + i) * 8192) = pv; else asm volatile("" :: "v"(pv)); r0 = r0 * D_[i].x + bflo(X_[i]); r1 = r1 * D_[i].y + bfhi(X_[i]); } } while (0)
        SC_LD(xa, da, 0);
        for (int c0 = 0; c0 < 128; c0 += 32) { SC_LD(xb, db, c0 + 16); SC_PROC(xa, da, c0); if (c0 + 32 < 128) SC_LD(xa, da, c0 + 32); SC_PROC(xb, db, c0 + 16); }
#undef SC_LD
#undef SC_PROC
        }
    } else if (F.wave < 6) {
        const int e = F.vcu * 128 + (F.tid - 256);
        if (e < 32768) {
        const int bh = e >> 11, pr = e & 2047, b = bh >> 3, h = bh & 7;
        unsigned* S = (unsigned*)(WSP(bf16, WS_SSDS) + ((size_t)b * 64 * 8 + h) * 4096) + pr; const float* A = WSP(float, WS_ATOT) + (size_t)b * 64 * 8 + h;
        float r0 = 0.f, r1 = 0.f;
        unsigned xa[16], xb[16]; float da[16], db[16];
#define SC_LD(X_, D_, c0) do { _Pragma("unroll") for (int i = 0; i < 16; ++i) { X_[i] = __builtin_nontemporal_load((const GAS unsigned*)(S + (size_t)((c0) + i) * 8 * 2048)); D_[i] = A[(size_t)((c0) + i) * 8]; } } while (0)
#define SC_PROC(X_, D_, c0) do { _Pragma("unroll") for (int i = 0; i < 16; ++i) { const unsigned pv = pk2(r0, r1); if constexpr (!DRY) *(GAS unsigned*)(S + (size_t)((c0) + i) * 8 * 2048) = pv; else asm volatile("" :: "v"(pv)); const float dd = fexp(D_[i]); r0 = r0 * dd + bflo(X_[i]); r1 = r1 * dd + bfhi(X_[i]); } } while (0)
        SC_LD(xa, da, 0);
        for (int c0 = 0; c0 < 64; c0 += 32) { SC_LD(xb, db, c0 + 16); SC_PROC(xa, da, c0); if (c0 + 32 < 64) SC_LD(xa, da, c0 + 32); SC_PROC(xb, db, c0 + 16); }
#undef SC_LD
#undef SC_PROC
        }
    }
}
#ifndef MK_X0
#define MK_X0 xcc_id()
#endif
#ifndef MK_UNEW_OUT
#define MK_UNEW_OUT WS_W2
#endif

typedef __bf16 bf16x2_t __attribute__((ext_vector_type(2)));
__device__ __forceinline__ float dot2bf(unsigned a, unsigned b, float c) { return __builtin_amdgcn_fdot2_f32_bf16(__builtin_bit_cast(bf16x2_t, a), __builtin_bit_cast(bf16x2_t, b), c, false); }
__device__ __forceinline__ void ins16(float (&top)[16], float x) {
#pragma unroll
    for (int i = 0; i < 16; ++i) { const float hi = __builtin_fmaxf(top[i], x); x = __builtin_fminf(top[i], x); top[i] = hi; }
}
#define CEX(a, b) do { const float hi_ = __builtin_fmaxf(a, b), lo_ = __builtin_fminf(a, b); a = hi_; b = lo_; } while (0)
__device__ __forceinline__ void sort16_desc(float (&v)[16]) {
#define S2(a, b) CEX(v[a], v[b])
    S2(0,13); S2(1,12); S2(2,15); S2(3,14); S2(4,8); S2(5,6); S2(7,11); S2(9,10);
    S2(0,5); S2(1,7); S2(2,9); S2(3,4); S2(6,13); S2(8,14); S2(10,15); S2(11,12);
    S2(0,1); S2(2,3); S2(4,5); S2(6,8); S2(7,9); S2(10,11); S2(12,13); S2(14,15);
    S2(0,2); S2(1,3); S2(4,10); S2(5,11); S2(6,7); S2(8,9); S2(12,14); S2(13,15);
    S2(1,2); S2(3,12); S2(4,6); S2(5,7); S2(8,10); S2(9,11); S2(13,14);
    S2(1,4); S2(2,6); S2(5,8); S2(7,10); S2(9,13); S2(11,14);
    S2(2,4); S2(3,6); S2(9,12); S2(11,13);
    S2(3,5); S2(6,8); S2(7,9); S2(10,12);
    S2(3,4); S2(5,6); S2(7,8); S2(9,10); S2(11,12);
    S2(6,7); S2(8,9);
#undef S2
}
__device__ __forceinline__ void merge16_desc(float (&a)[16], const float (&b)[16]) {
#pragma unroll
    for (int i = 0; i < 16; ++i) a[i] = __builtin_fmaxf(a[i], b[15 - i]);
#pragma unroll
    for (int j = 8; j > 0; j >>= 1)
#pragma unroll
        for (int i = 0; i < 16; ++i) { const int l = i ^ j; if (l > i) CEX(a[i], a[l]); }
}
__device__ __forceinline__ void top16_half(float (&top)[16], const _Float16* base) {
#pragma unroll 1
    for (int g0 = 0; g0 < 8; ++g0) { float x[16];
#pragma unroll
        for (int i = 0; i < 16; ++i) x[i] = (float)__builtin_nontemporal_load((const GAS _Float16*)(base + (size_t)(16 * g0 + i) * TT));
#pragma unroll
        for (int i = 0; i < 16; ++i) x[i] = __builtin_bit_cast(float, (__builtin_bit_cast(unsigned, x[i]) & ~127u) | (unsigned)(16 * g0 + i));
        sort16_desc(x);
        if (g0 == 0) {
#pragma unroll
            for (int i = 0; i < 16; ++i) top[i] = x[i];
        } else merge16_desc(top, x);
    }
}
__device__ __forceinline__ float mkc(float a, float b, unsigned code) { return __builtin_bit_cast(float, (__builtin_bit_cast(unsigned, a + b) & ~255u) | code); }
constexpr int PL_SELB = 0, PL_IDX = 16384, PL_GATE = 32768;
constexpr int CW_PEER = 8192;
__device__ __forceinline__ unsigned xcc_id() { return (unsigned)__builtin_amdgcn_s_getreg((3 << 11) | 20) & 7u; }
__device__ __forceinline__ float row_rstd(const float* ssq, size_t tok) { const f32x4 a = *(const GAS f32x4*)(ssq + tok * 16), b = *(const GAS f32x4*)(ssq + tok * 16 + 4), c = *(const GAS f32x4*)(ssq + tok * 16 + 8), d = *(const GAS f32x4*)(ssq + tok * 16 + 12);
    const f32x4 s = (a + b) + (c + d); return frsq(((s.x + s.y) + (s.z + s.w)) * (1.f / DM) + EPS); }
__device__ __forceinline__ void p_select(Frame& F, int l) {
    LAS unsigned* selb = (LAS unsigned*)(F.lds + PL_SELB); LAS unsigned short* idxl = (LAS unsigned short*)(F.lds + PL_IDX); LAS float* gatel = (LAS float*)(F.lds + PL_GATE);
    const int lane = F.lane, w = F.wave;
    for (int st_ = 0; st_ < 2; ++st_) { const bool enc_ = (st_ == 0) == (MK_PAR_SEL ? (F.vcu & 1) != 0 : false); asm volatile("" ::: "memory");
    if (enc_) { if (!(MK_U8_EARLY && MK_UCOL) || l == 0) for (int q_ = 0; q_ < (MK_REPEAT_SP == 13 ? 2 : 1); ++q_) tables_items<false>(F, l, (size_t)F.vcu * 512 + F.tid, (size_t)F.G * 512);
                if (!MK_V8_IN_U) tables_items<true>(F, l, (size_t)F.vcu * 512 + F.tid, (size_t)F.G * 512); }
    else for (int q2_ = 0; q2_ < (MK_REPEAT_SP == 15 ? 2 : 1); ++q2_) for (int blk = F.vcu; blk < TT / 64; blk += F.G) {
        const int t0 = blk * 64;
        __syncthreads();
        {
            float t1[16], t2[16], fin[16];
            const _Float16* sb = WSP(_Float16, WS_ST) + (size_t)(w * 256) * TT + t0 + lane;
            top16_half(t1, sb); top16_half(t2, sb + (size_t)128 * TT);
            LAS unsigned* mys = selb + (w * 64 + lane) * 8;
#pragma unroll
            for (int q = 0; q < 4; ++q) { unsigned a = 0, b = 0;
#pragma unroll
                for (int i = 0; i < 4; ++i) { a |= (__builtin_bit_cast(unsigned, t1[4 * q + i]) & 127u) << (8 * i); b |= (__builtin_bit_cast(unsigned, t2[4 * q + i]) & 127u) << (8 * i); }
                mys[q] = a; mys[4 + q] = b; }
#pragma unroll
            for (int j = 0; j < 16; ++j) fin[j] = mkc(t1[0], t2[j], (unsigned)j);
#pragma unroll
            for (int i = 1; i < 16; ++i)
#pragma unroll
                for (int j = 0; j < 16; ++j) if ((i + 1) * (j + 1) <= 16) ins16(fin, mkc(t1[i], t2[j], (unsigned)(i * 16 + j)));
            float m = fin[0];
#pragma unroll
            for (int r = 1; r < 16; ++r) m = __builtin_fmaxf(m, fin[r]);
            float ex[16], sum = 0.f;
            const float rs_ = row_rstd(WSP(float, WS_SSQ), (size_t)t0 + lane);
#pragma unroll
            for (int r = 0; r < 16; ++r) { ex[r] = fexp((fin[r] - m) * rs_); sum += ex[r]; }
            if (w == 0) WSP(float, WS_RSTD)[t0 + lane] = rs_;
            const float inv = frcp(sum);
            LDS_WAIT();
            const LAS unsigned char* myb = (const LAS unsigned char*)mys;
#pragma unroll
            for (int r = 0; r < 16; ++r) { const unsigned code = __builtin_bit_cast(unsigned, fin[r]) & 255u; const unsigned i1 = myb[code >> 4], i2 = myb[16 + (code & 15u)];
                idxl[lane * 128 + w * 16 + r] = (unsigned short)(i1 * 128u + i2); gatel[lane * 128 + w * 16 + r] = ex[r] * inv; }
        }
        __syncthreads();
        for (int e = F.tid; e < 1024; e += 512) *(GAS v4u*)(WSP(unsigned char, WS_IDX) + (size_t)t0 * 256 + e * 16) = *(const LAS v4u*)((const LAS unsigned char*)idxl + e * 16);
        for (int e = F.tid; e < 2048; e += 512) *(GAS v4u*)(WSP(unsigned char, WS_W) + (size_t)t0 * 512 + e * 16) = *(const LAS v4u*)((const LAS unsigned char*)gatel + e * 16);
    }
    __syncthreads(); }
}
__device__ __forceinline__ void cvt16(v4u p, float* v) {
    const unsigned wds[4] = {p.x, p.y, p.z, p.w};
#pragma unroll
    for (int q = 0; q < 4; ++q) { const f32x2 lo = __builtin_amdgcn_cvt_pk_f32_fp8((int)wds[q], false), hi = __builtin_amdgcn_cvt_pk_f32_fp8((int)wds[q], true); v[4 * q] = lo.x; v[4 * q + 1] = lo.y; v[4 * q + 2] = hi.x; v[4 * q + 3] = hi.y; }
}
__device__ __forceinline__ unsigned peer_ticket(Frame& F, int cw, unsigned x) { unsigned t = 0; if (F.lane == 0) t = __hip_atomic_fetch_add((gu32*)(F.ap->ws + WS_CTL) + cw + x * 64, 1u, RLX_AGENT); return t; }
typedef __bf16 bf16x2v __attribute__((ext_vector_type(2)));
template <bool DRY> __device__ __forceinline__ void p_peer_u2(Frame& F, int l, int cset = 0) {
    constexpr int TPT = 8, NTASK = TT / TPT;
    LAS unsigned char* wl = F.lds + F.wave * 6144;
    LAS unsigned short* idxT = (LAS unsigned short*)wl;
    LAS unsigned char* hT = wl + 2048;
    LAS unsigned* pst = (LAS unsigned*)(wl + 4096);
    const int lane = F.lane, g = lane >> 3, c = lane & 7, r16 = lane & 15, kc = lane >> 4, row16 = lane >> 2, c4 = lane & 3, baddr = 4 * (4 * r16 + kc);
    const unsigned char* U8 = (const unsigned char*)F.ap->ws + ((MK_U8_EARLY && l == 1) ? WS_WIN : WS_U8);
    const unsigned x0 = MK_X0; const int cw = CW_PEER + ((DRY ? 4 : cset) + l * 2 + 0) * 8 * 64;
    const int wdst = ((2 * lane) & 7) * 16 + (lane >> 2);
    if constexpr (!DRY && MK_V8_IN_U) { if (F.wave >= NWAVES - 2) tables_items<true>(F, l, ((size_t)F.vcu * 2 + (F.wave - (NWAVES - 2))) * 64 + lane, (size_t)F.G * 2 * 64); }
    for (unsigned so = 0; so < 8; ++so) { const unsigned x = (x0 + so) & 7u;
      unsigned cur = (unsigned)__builtin_amdgcn_readfirstlane((int)peer_ticket(F, cw, x));
      unsigned pr[TPT]; v4u h0;
#define PU2_LOADTASK(task) do { const size_t t0_ = (size_t)((task) < (unsigned)NTASK ? (task) : (unsigned)NTASK - 1u) * TPT; \
          _Pragma("unroll") for (int k = 0; k < TPT; ++k) pr[k] = *(const GAS unsigned*)(WSP(unsigned, WS_IDX) + (t0_ + k) * 64 + lane); \
          const unsigned char* hp = F.ap->ws + WS_XW8 + (t0_ + g) * DM + 128 * (int)x + 16 * c;        \
          h0 = *(const GAS v4u*)hp; } while (0)
      PU2_LOADTASK(cur);
      while (cur < (unsigned)NTASK) {
        const unsigned nxtv = peer_ticket(F, cw, x);
        const size_t tk0 = (size_t)cur * TPT;
        {
#pragma unroll
          for (int k = 0; k < TPT; ++k) ((LAS unsigned*)idxT)[k * 64 + lane] = pr[k];
          *(LAS v4u*)(hT + lane * 16) = h0; }
        LDS_WAIT();
        v4u rA[8], rB[8];
        v4u* pbase = WSP(v4u, WS_UP) + ((tk0 >> 2) * 8 + x) * 64 + lane;
        const unsigned char* ubase = U8 + (size_t)x * (16384 * 128) + 16 * c4;
#define PU2_ISSUE(R, k, ih) do { const v2u iq = *(const LAS v2u*)(idxT + (k) * 128 + row16 * 8 + 4 * (ih)); const unsigned iw[2] = {iq.x, iq.y}; \
            _Pragma("unroll") for (int i = 0; i < 4; ++i) { const unsigned e = (i & 1) ? (iw[i >> 1] >> 16) : (iw[i >> 1] & 0xffffu); R[2 * i] = *(const GAS v4u*)(ubase + (size_t)e * 128); R[2 * i + 1] = *(const GAS v4u*)(ubase + (size_t)e * 128 + 64); } } while (0)
#define BP_(v_) __builtin_amdgcn_ds_bpermute(baddr, (int)(v_))
#define PU2_DOT(R, ih) do { _Pragma("unroll") for (int i = 0; i < 4; ++i) { const pg8::i32x8_t a8 = {BP_(R[2 * i].x), BP_(R[2 * i].y), BP_(R[2 * i].z), BP_(R[2 * i].w), BP_(R[2 * i + 1].x), BP_(R[2 * i + 1].y), BP_(R[2 * i + 1].z), BP_(R[2 * i + 1].w)}; \
                acc[4 * (ih) + i] = __builtin_amdgcn_mfma_scale_f32_16x16x128_f8f6f4(a8, hb, (f32x4){0.f, 0.f, 0.f, 0.f}, 0, 0, 0, 0x7f7f7f7f, 1, 0x7f7f7f7f); } } while (0)
        PU2_ISSUE(rA, 0, 0);
        unsigned nxt_ = 0u;
        auto token_ = [&](auto last_c, int k) { constexpr bool LAST_ = decltype(last_c)::value;
            PU2_ISSUE(rB, k, 1);
            if constexpr (LAST_) { nxt_ = (unsigned)__builtin_amdgcn_readfirstlane((int)nxtv); }
            pg8::i32x8_t hb; { const v4u hl0 = *(const LAS v4u*)(hT + k * 128 + kc * 16), hl1 = *(const LAS v4u*)(hT + k * 128 + 64 + kc * 16);
              hb = (pg8::i32x8_t){(int)hl0.x, (int)hl0.y, (int)hl0.z, (int)hl0.w, (int)hl1.x, (int)hl1.y, (int)hl1.z, (int)hl1.w}; }
            if constexpr (LAST_) PU2_LOADTASK(nxt_);
            f32x4 acc[8];
            PU2_DOT(rA, 0);
            if constexpr (!LAST_) PU2_ISSUE(rA, k + 1, 0);
            PU2_DOT(rB, 1);
            f32x4 sel = acc[0];
#pragma unroll
            for (int m = 1; m < 8; ++m) { const bool hit = (lane & 7) == m; sel[0] = hit ? acc[m][0] : sel[0]; sel[1] = hit ? acc[m][1] : sel[1]; sel[2] = hit ? acc[m][2] : sel[2]; sel[3] = hit ? acc[m][3] : sel[3]; }
            float s[2]; s[0] = (lane & 8) ? sel[2] : sel[0]; s[1] = (lane & 8) ? sel[3] : sel[1];
            pst[lane * 4 + (k & 3)] = pk2(s[0], s[1]);
            if ((k & 3) == 3) { const v4u po = *(const LAS v4u*)(pst + lane * 4); if constexpr (!DRY) *(GAS v4u*)(pbase + (size_t)(k >> 2) * 512) = po; else asm volatile("" :: "v"(po)); }
        };
#pragma unroll 1
        for (int k = 0; k < TPT - 1; ++k) token_(std::false_type{}, k);
        token_(std::true_type{}, TPT - 1);
#undef PU2_ISSUE
#undef PU2_DOT
#undef BP_
        LDS_WAIT();
        cur = nxt_;
      }
#undef PU2_LOADTASK
    }
}
template <bool DRY> __device__ __forceinline__ void p_reduce_u(Frame& F) {
    const int gw = F.vcu * NWAVES + F.wave, NGW = F.G * NWAVES, lane = F.lane;
    const int p0 = 16 * (lane & 7) + 4 * (lane >> 4) + 2 * ((lane >> 3) & 1), j0 = 8 * (p0 & 15) + (p0 >> 4), j1 = j0 + 8;
    for (int tb = gw * 4; tb < TT; tb += NGW * 4) {
        f32x2 v[4][8]; float g0[4], g1[4], rs[4]; unsigned wpk[4];
#pragma unroll
        for (int x = 0; x < 8; ++x) { const v4u w4 = *(const GAS v4u*)(WSP(v4u, WS_UP) + ((size_t)(tb >> 2) * 8 + x) * 64 + lane); const unsigned ww[4] = {w4.x, w4.y, w4.z, w4.w};
#pragma unroll
            for (int q = 0; q < 4; ++q) v[q][x] = (f32x2){bflo(ww[q]), bfhi(ww[q])}; }
#pragma unroll
        for (int q = 0; q < 4; ++q) { const size_t t = (size_t)tb + q;
            g0[q] = WSP(float, WS_W)[t * 128 + j0]; g1[q] = WSP(float, WS_W)[t * 128 + j1]; rs[q] = WSP(float, WS_RSTD)[t]; }
#pragma unroll
        for (int q = 0; q < 4; ++q) { const size_t t = (size_t)tb + q;
            const f32x2 sm = ((v[q][0] + v[q][1]) + (v[q][2] + v[q][3])) + ((v[q][4] + v[q][5]) + (v[q][6] + v[q][7]));
            const float sc = rs[q] * (1.0f / 256.0f);   const float w0 = g0[q] * geluf_(sm[0] * sc), w1 = g1[q] * geluf_(sm[1] * sc);
            wpk[q] = pk2(w0, w1); }
        { const v4u wo = {wpk[0], wpk[1], wpk[2], wpk[3]};
          if constexpr (!DRY) *(GAS v4u*)(WSP(v4u, WS_W2) + (size_t)(tb >> 2) * 64 + lane) = wo; else asm volatile("" :: "v"(wo)); }
    }
}
template <bool DRY> __device__ __forceinline__ void p_peer_v(Frame& F, int l) {
    constexpr int TPT = 8, NTASK = TT / TPT;
    LAS unsigned char* wl = F.lds + F.wave * 6144;
    LAS unsigned short* idxT = (LAS unsigned short*)wl;
    LAS float* wT = (LAS float*)(wl + 2048);
    const int lane = F.lane, g = lane >> 3, c = lane & 7;
    const unsigned char* V8 = WSP(unsigned char, WS_V8);
    const unsigned x0 = MK_X0; const int cw = CW_PEER + ((DRY ? 4 : 0) + l * 2 + 1) * 8 * 64;
    const int colo = 16 * c + ((lane >> 5) & 1) * 8 + ((lane >> 4) & 1) * 4 + ((lane >> 3) & 1) * 2;
    const int wdst = ((2 * lane) & 7) * 16 + (lane >> 2);
    const int wp0 = 16 * (lane & 7) + 4 * (lane >> 4) + 2 * ((lane >> 3) & 1);
    if constexpr (!DRY && MK_U8_EARLY && MK_UCOL) { if (l == 0 && F.wave >= NWAVES - 2) tables_items<false>(F, 1, ((size_t)F.vcu * 2 + (F.wave - (NWAVES - 2))) * 64 + lane, (size_t)F.G * 2 * 64, WS_WIN); }
    if constexpr (!DRY && MK_W1_LATE) { if (l == 0 && F.wave >= NWAVES - 2) { LAS float* scr = (LAS float*)(F.lds + 65536 + (F.wave - (NWAVES - 2)) * 16640);
        for (int it = F.vcu * 2 + (F.wave - (NWAVES - 2)); it < WT_PER_LAYER; it += F.G * 2) wt_item(F, 1, it, scr); } }
    for (unsigned so = 0; so < 8; ++so) { const unsigned x = (x0 + so) & 7u;
      unsigned cur = (unsigned)__builtin_amdgcn_readfirstlane((int)peer_ticket(F, cw, x));
      unsigned pr[TPT]; v4u wq[2];
#define PV_LOADTASK(task) do { const size_t t0_ = (size_t)((task) < (unsigned)NTASK ? (task) : (unsigned)NTASK - 1u) * TPT; \
          _Pragma("unroll") for (int k = 0; k < TPT; ++k) { pr[k] = *(const GAS unsigned*)(WSP(unsigned, WS_IDX) + (t0_ + k) * 64 + lane); } wq[0] = *(const GAS v4u*)(WSP(v4u, WS_W2) + (t0_ >> 2) * 64 + lane); wq[1] = *(const GAS v4u*)(WSP(v4u, WS_W2) + ((t0_ >> 2) + 1) * 64 + lane); } while (0)
      PV_LOADTASK(cur);
      while (cur < (unsigned)NTASK) {
        const unsigned nxtv = peer_ticket(F, cw, x);
        const size_t tk0 = (size_t)cur * TPT;
        {
#pragma unroll
          for (int k = 0; k < TPT; ++k) { idxT[k * 128 + wdst] = (unsigned short)(pr[k] & 0xffffu); idxT[k * 128 + wdst + 16] = (unsigned short)(pr[k] >> 16);
              { const unsigned wb = wq[k >> 2][k & 3]; *(LAS v2u*)(wT + k * 128 + wp0) = (v2u){wb << 16, wb & 0xffff0000u}; } } }
        LDS_WAIT();
        v4u rA[8], rB[8]; unsigned xv; f32x2 acc2[8];
        bf16* xbase = WSP(bf16, WS_XB) + tk0 * DM + 128 * (int)x + colo;
        float w1a = 0.f, w1b = 0.f; if (l == 0) { const float* wp_ = F.ap->in[I_N1] + DM + 128 * (int)x + colo; w1a = wp_[0]; w1b = wp_[1]; }
        const unsigned char* vbase = V8 + (size_t)x * (16384 * 128) + 16 * c;
#define PV_ISSUE(R, k, ih) do { const v4u iq = *(const LAS v4u*)(idxT + (k) * 128 + g * 16 + 8 * (ih)); const unsigned iw[4] = {iq.x, iq.y, iq.z, iq.w}; \
            _Pragma("unroll") for (int i = 0; i < 8; ++i) { const unsigned e = (i & 1) ? (iw[i >> 1] >> 16) : (iw[i >> 1] & 0xffffu); R[i] = *(const GAS v4u*)(vbase + (size_t)e * 128); } } while (0)
#define PV_ACC(R, k, ih) do { const f32x4 wq0 = *(const LAS f32x4*)(wT + (k) * 128 + g * 16 + 8 * (ih)), wq1 = *(const LAS f32x4*)(wT + (k) * 128 + g * 16 + 8 * (ih) + 4); \
            const float wa[8] = {wq0.x, wq0.y, wq0.z, wq0.w, wq1.x, wq1.y, wq1.z, wq1.w}; \
            _Pragma("unroll") for (int i = 0; i < 8; ++i) { const f32x2 w2 = {wa[i], wa[i]}; const unsigned rq[4] = {R[i].x, R[i].y, R[i].z, R[i].w}; \
                _Pragma("unroll") for (int q = 0; q < 4; ++q) { acc2[2 * q] = __builtin_elementwise_fma(__builtin_amdgcn_cvt_pk_f32_fp8((int)rq[q], false), w2, acc2[2 * q]); \
                                                               acc2[2 * q + 1] = __builtin_elementwise_fma(__builtin_amdgcn_cvt_pk_f32_fp8((int)rq[q], true), w2, acc2[2 * q + 1]); } } } while (0)
        PV_ISSUE(rA, 0, 0);
        unsigned nxt_ = 0u;
        auto token_ = [&](auto last_c, int k) { constexpr bool LAST_ = decltype(last_c)::value;
            PV_ISSUE(rB, k, 1); xv = *(const GAS unsigned*)(xbase + (size_t)k * DM);
            if constexpr (LAST_) { nxt_ = (unsigned)__builtin_amdgcn_readfirstlane((int)nxtv); PV_LOADTASK(nxt_); }
#pragma unroll
            for (int q = 0; q < 8; ++q) acc2[q] = (f32x2){0.f, 0.f};
            PV_ACC(rA, k, 0);
            if constexpr (!LAST_) PV_ISSUE(rA, k + 1, 0);
            PV_ACC(rB, k, 1);
            float acc[16];
#pragma unroll
            for (int q = 0; q < 8; ++q) { acc[2 * q] = acc2[q][0]; acc[2 * q + 1] = acc2[q][1]; }
#pragma unroll
            for (int i = 0; i < 8; ++i) acc[i] = hsum32(acc[i], acc[i + 8]);
#pragma unroll
            for (int i = 0; i < 4; ++i) acc[i] = hsum16(acc[i], acc[i + 4]);
#pragma unroll
            for (int i = 0; i < 2; ++i) acc[i] = hsum8(acc[i], acc[i + 2], (lane & 8) != 0);
            const float o0 = bflo(xv) + acc[0] * (1.0f / 32.0f), o1 = bfhi(xv) + acc[1] * (1.0f / 32.0f);
            const unsigned xo = pk2(o0, o1);
            if constexpr (!DRY) *(GAS unsigned*)(xbase + (size_t)k * DM) = xo; else asm volatile("" :: "v"(xo));
            if (l == 0) { const unsigned yw = MK_FP8_INPROJ1 ? (pk4f8(o0 * w1a, o1 * w1b, 0.f, 0.f) & 0xffffu) : pk2(o0 * w1a, o1 * w1b); const float ss = wave_sum(o0 * o0 + o1 * o1, lane);
                if constexpr (!DRY) { if (MK_FP8_INPROJ1) *(GAS unsigned short*)((unsigned char*)XNP + (tk0 + k) * DM + 128 * (int)x + colo) = (unsigned short)yw; else *(GAS unsigned*)(XNP + (tk0 + k) * DM + 128 * (int)x + colo) = yw; if (lane == 0) WSP(float, WS_SSQ1)[(tk0 + k) * 8 + x] = ss; } else asm volatile("" :: "v"(yw), "v"(ss)); }
        };
#pragma unroll 1
        for (int k = 0; k < TPT - 1; ++k) token_(std::false_type{}, k);
        token_(std::true_type{}, TPT - 1);
#undef PV_ISSUE
#undef PV_ACC
        LDS_WAIT();
        cur = nxt_;
      }
#undef PV_LOADTASK
    }
}
template <bool DRY> __device__ __forceinline__ void p_rownorm(Frame& F, int l, bool last) {
    const int gw = F.vcu * NWAVES + F.wave, NGW = F.G * NWAVES;
    const bf16* X = WSP(bf16, WS_XB);
    v2u nx[4];
    { const GAS v2u* x0 = (const GAS v2u*)(X + (size_t)gw * DM) + F.lane;
#pragma unroll
      for (int j = 0; j < 4; ++j) nx[j] = x0[64 * j]; }
    for (int m = gw; m < TT; m += NGW) {
        GAS f32x4* xr = (GAS f32x4*)(F.ap->out + (size_t)m * DM) + F.lane;
        f32x4 v[4];
#pragma unroll
        for (int j = 0; j < 4; ++j) v[j] = (f32x4){bflo(nx[j].x), bfhi(nx[j].x), bflo(nx[j].y), bfhi(nx[j].y)};
        if (m + NGW < TT) { const GAS v2u* xn_ = (const GAS v2u*)(X + (size_t)(m + NGW) * DM) + F.lane;
#pragma unroll
            for (int j = 0; j < 4; ++j) nx[j] = xn_[64 * j]; }
        float s = 0.f;
#pragma unroll
        for (int j = 0; j < 4; ++j) s += (v[j].x * v[j].x + v[j].y * v[j].y) + (v[j].z * v[j].z + v[j].w * v[j].w);
        const float rstd = frsq(wave_sum(s, F.lane) * (1.f / DM) + EPS);
#pragma unroll
        for (int j = 0; j < 4; ++j) { const f32x4 wv = *(const GAS f32x4*)(F.ap->in[I_FN] + 4 * F.lane + 256 * j); const f32x4 ov = v[j] * rstd * wv; if constexpr (!DRY) xr[64 * j] = ov; else asm volatile("" :: "v"(ov)); }
    }
    __syncthreads();
}

#ifndef MK_PHASE_MASK
#define MK_PHASE_MASK 0x3ff
#endif
#ifndef MK_DBLBAR
#define MK_DBLBAR 0
#endif
#ifndef MK_SP2
#define MK_SP2 true
#endif
#ifndef MK_REPEAT_SP
#define MK_REPEAT_SP -1
#endif
#ifndef MK_MIX_SUB
#define MK_MIX_SUB 7
#endif
#define MIXS(k) ((MK_MIX_SUB >> (k)) & 1)
#define REP(k) (MK_REPEAT_SP == (k))
#define PHM(k) ((MK_PHASE_MASK >> (k)) & 1)
#ifndef MK_STOP_PHASE
#define MK_STOP_PHASE (22 + 2 * MK_UCOL)
#endif
constexpr int N_PHASES = MK_STOP_PHASE;
#define MK_LAUNDER() do { { KArgs ap = (KArgs)__builtin_amdgcn_kernarg_segment_ptr(); asm volatile("" : "+s"(ap)); F.ap = ap; } { int w0 = wave0; asm volatile("" : "+s"(w0)); int ln; asm volatile("v_mbcnt_lo_u32_b32 %0, -1, 0\n\tv_mbcnt_hi_u32_b32 %0, -1, %0" : "=v"(ln)); F.wave = w0; F.lane = ln; F.tid = w0 * 64 + ln; } { int G = gridDim.x, bx = blockIdx.x; asm volatile("" : "+s"(G), "+s"(bx)); F.G = G; F.vcu = (G % 8 == 0) ? (bx % 8) * (G / 8) + bx / 8 : bx; F.bx = bx; } { LAS unsigned char* lp = (LAS unsigned char*)lds; asm volatile("" : "+s"(lp)); F.lds = lp; } } while (0)
__global__ void __launch_bounds__(NWAVES * 64, 2) fwd_kernel(Args args) {
    extern __shared__ __attribute__((aligned(16))) unsigned char lds[];
    Frame F;
#if MK_BARRIER == 1
    { LAS unsigned* z = (LAS unsigned*)((LAS unsigned char*)lds + LDSCTL_OFF); for (int u = threadIdx.x; u < (LDS_BYTES - LDSCTL_OFF) / 4; u += NWAVES * 64) z[u] = 0u; }
    __syncthreads();
    const int wave0 = __builtin_amdgcn_readfirstlane((int)threadIdx.x >> 6);
    (void)xcd_barrier_post((unsigned*)(args.ws + WS_CTL) + CW_BAR, (volatile LAS unsigned*)((LAS unsigned char*)lds + MISC_OFF) + 8, (int)threadIdx.x);
#endif
    int rep_ph = -1;
    for (int ph = args.ph_lo; ph < args.ph_hi; ++ph) {
        MK_LAUNDER();
        {
        if (ph == 0) { if (PHM(0)) for (int r_ = 0; r_ < (REP(12) ? 2 : 1); ++r_) p0_prologue(F); }
        else {
            constexpr int NS0 = 10 + MK_UCOL;
            const int l = (ph - 1) >= NS0 ? 1 : 0; int sp = (ph - 1) - NS0 * l; if (sp >= 6) ++sp;
            if (MK_UCOL) { if (sp == 10) sp = 12; else if (sp > 10) --sp; }
            if (sp == 0) { if (PHM(1)) {
                LAS float* rsl = (LAS float*)(F.lds + RING_BYTES); const int xg = F.bx & 7;
                for (int r = F.tid; r < 2048; r += 512) { float v = (MK_I8_INPROJ0 && l == 0) ? WSP(float, WS_SSQ1)[(size_t)xg * 2048 + r] : 1.f;
                    if (l > 0) { const float* pp = WSP(float, WS_SSQ1) + ((size_t)xg * 2048 + r) * 8; const f32x4 a = *(const GAS f32x4*)pp, b = *(const GAS f32x4*)(pp + 4); v = frsq((((a.x + a.y) + (a.z + a.w)) + ((b.x + b.y) + (b.z + b.w))) * (1.f / DM) + EPS); }
                    rsl[r] = v; }
                __syncthreads();
                pg8::Gemm g{XNP, WSP(bf16, WS_WIN + (size_t)l * 16 * MiB), TT, NP + 256, DM}; pg8::StaticOrder S; S.init(TT, NP + 256, F.G, F.bx);
                pg8::EpiProj E{WSP(bf16, WS_PROJ), NP, WSP(float, WS_DT), rsl, (F.G % 8 == 0) ? xg : -1, WSP(float, WS_SSQ1), l > 0};
                if (MK_I8_INPROJ0 && l == 0) { pg8::Gemm g8{XNP, WSP(bf16, WS_WIN), TT, NP + 256, DM / 2};
                    pg8::EpiProjI8 EI{WSP(bf16, WS_PROJ), NP, WSP(float, WS_DT), rsl, (const float*)(F.ap->ws + WS_CTL) + CW_CMAX, (F.G % 8 == 0) ? xg : -1, WSP(float, WS_SSQ1)};
                    pg8::gemm_phase<pg8::EpiProjI8, pg8::StaticOrder, true, MK_SP2, false, 0, true>(F.lds, g8, S, EI, F.tid); }
                else if (MK_FP8_INPROJ0 && l == 0) { pg8::Gemm g8{XNP, WSP(bf16, WS_WIN), TT, NP + 256, DM / 2};
                    pg8::EpiProj0 E0{WSP(bf16, WS_PROJ), NP, WSP(float, WS_DT)};
                    pg8::gemm_phase<pg8::EpiProj0, pg8::StaticOrder, true, MK_SP2, true, -6>(F.lds, g8, S, E0, F.tid); }
                else if (MK_FP8_INPROJ1 && l == 1) { pg8::Gemm g8{XNP, WSP(bf16, WS_WIN + (size_t)16 * MiB), TT, NP + 256, DM / 2};
                    pg8::gemm_phase<pg8::EpiProj, pg8::StaticOrder, true, MK_SP2, true, -6>(F.lds, g8, S, E, F.tid); }
                else pg8::gemm_phase<pg8::EpiProj, pg8::StaticOrder, true, MK_SP2>(F.lds, g, S, E, F.tid);
            } } else if (sp == 1) { if (PHM(2)) {
                for (int r_ = 0; r_ < (REP(1) ? 2 : 1); ++r_)
                { const bool odd_ = MK_PAR_MIX1 && (F.vcu & 1) != 0;
                  if (odd_) { for (int q_ = 0; q_ < (MK_REPEAT_SP == 22 ? 2 : 1); ++q_) p_sb_attn(F); __syncthreads(); }
                  MK_LAUNDER();
                  for (int q_ = 0; q_ < (MK_REPEAT_SP == 20 ? 2 : 1); ++q_) for (int u = F.vcu; u < 1024; u += F.G) hg_local_unit(F, l, u >> 9, (u >> 7) & 3, u & 127);
                  for (int q_ = 0; q_ < (MK_REPEAT_SP == 21 ? 2 : 1); ++q_) for (int u = F.vcu; u < 256; u += F.G) ssd_local_unit(F, l, u >> 7, (u >> 1) & 63, u & 1);
                  MK_LAUNDER();
                  if (!odd_) { __syncthreads(); for (int q_ = 0; q_ < (MK_REPEAT_SP == 22 ? 2 : 1); ++q_) p_sb_attn(F); } }
            } } else if (sp == 2) { if (PHM(3)) {
                if (REP(2)) p_scan<true>(F);
                p_scan<false>(F);
            } } else if (sp == 3) { if (PHM(4)) {
                for (int r_ = 0; r_ < (REP(3) ? 2 : 1); ++r_) {
                hg_out_units(F, l, F.vcu, F.G);
                for (int u = F.vcu; u < 256; u += F.G) ssd_out_unit(F, l, u >> 7, (u >> 1) & 63, u & 1); }
            } } else if (sp == 4) { if (PHM(5)) {
                pg8::Gemm g{WSP(bf16, WS_Y), WSP(bf16, WS_WBR + (size_t)l * 3 * MiB), 3 * TT, 3 * DM, 512}; pg8::MergeOrder S{F.vcu, F.G};
                pg8::EpiMerge2 E{WSP(bf16, WS_PROJ) + C_GATE, NP, XNP, DM};
                pg8::gemm_phase<pg8::EpiMerge2, pg8::MergeOrder, true, MK_SP2>(F.lds, g, S, E, F.tid);
            } } else if (sp == 5) { if (PHM(6)) {
                pg8::Gemm g{XNP, WSP(bf16, WS_WOUT + (size_t)l * 2 * MiB), TT, DM, DM}; pg8::StaticOrder S; S.init(TT, DM, F.G, F.bx);
                if (l == 0) { pg8::EpiResNorm<true> E{F.ap->in[I_X], WSP(bf16, WS_XB), DM, F.ap->in[I_N2] + (size_t)l * DM, WSP(bf16, WS_XW), WSP(float, WS_SSQ), MK_FP8_PEERQ0 ? F.ap->ws + WS_XW8 : (unsigned char*)nullptr};
                    pg8::gemm_phase<pg8::EpiResNorm<true>, pg8::StaticOrder, true, MK_SP2>(F.lds, g, S, E, F.tid); }
                else { pg8::EpiResNorm<false> E{WSP(bf16, WS_XB), WSP(bf16, WS_XB), DM, F.ap->in[I_N2] + (size_t)l * DM, WSP(bf16, WS_XW), WSP(float, WS_SSQ), MK_FP8_PEERQ1 ? F.ap->ws + WS_XW8 : (unsigned char*)nullptr};
                    pg8::gemm_phase<pg8::EpiResNorm<false>, pg8::StaticOrder, true, MK_SP2>(F.lds, g, S, E, F.tid); }
            } } else if (sp == 7) { if (PHM(8)) {
                pg8::Gemm g{WSP(bf16, WS_WEFF + (size_t)l * 4 * MiB), WSP(bf16, WS_XB), 2048, TT, DM}; pg8::StaticOrder S; S.init(2048, TT, F.G, F.bx);
                pg8::EpiF16 E{WSP(_Float16, WS_ST), TT};
                if (l == 1 ? (MK_FP8_PEERQ1 != 0) : (MK_FP8_PEERQ0 != 0)) { pg8::Gemm g8{WSP(bf16, WS_WEFF + (size_t)l * 4 * MiB), (const pg8::bf16_t*)(F.ap->ws + WS_XW8), 2048, TT, DM / 2};
                    pg8::gemm_phase<pg8::EpiF16, pg8::StaticOrder, true, MK_SP2, true, -6>(F.lds, g8, S, E, F.tid); }
                else pg8::gemm_phase<pg8::EpiF16, pg8::StaticOrder, true, MK_SP2>(F.lds, g, S, E, F.tid);
            } } else if (sp == 8) { if (PHM(9)) for (int r_ = 0; r_ < (REP(8) ? 2 : 1); ++r_) p_select(F, l);
            } else if (sp == 12) { if (PHM(9)) { if (REP(14)) p_reduce_u<true>(F); p_reduce_u<false>(F); }
            } else if (sp == 9 && MK_UCOL) { if (PHM(9) && MIXS(0)) { if (REP(9)) p_peer_u2<true>(F, l); if (REP(16)) p_peer_u2<false>(F, l, 4); p_peer_u2<false>(F, l); }
            } else if (sp == 10) { if (PHM(9) && MIXS(1)) { if (REP(10)) p_peer_v<true>(F, l); p_peer_v<false>(F, l); }
            } else { if (PHM(9)) { if (REP(11)) p_rownorm<true>(F, l, true); p_rownorm<false>(F, l, true); }
            }
        }
        }
        if ((MK_REPEAT_SP == 0 || MK_REPEAT_SP == 4 || MK_REPEAT_SP == 7) && ph > 0 && (((ph - 1) >= 10 + MK_UCOL ? ph - 11 - MK_UCOL : ph - 1) + ((((ph - 1) >= 10 + MK_UCOL ? ph - 11 - MK_UCOL : ph - 1)) >= 6 ? 1 : 0)) == MK_REPEAT_SP && rep_ph != ph) { rep_ph = ph; --ph; __syncthreads(); continue; }
#if MK_BARRIER == 1
        if (ph + 1 < args.ph_hi) { if (args.ph_hi - args.ph_lo == 2) cg::this_grid().sync();
            else { XcdBarrier bar; bar.bar = (unsigned*)(F.ap->ws + WS_CTL) + CW_BAR; bar.x = xb_xcc_id(); bar.st = (volatile LAS unsigned*)((LAS unsigned char*)lds + MISC_OFF) + 8; xcd_barrier(bar, F.tid); if (MK_DBLBAR) xcd_barrier(bar, F.tid); } }
#else
        if (ph + 1 < args.ph_hi) cg::this_grid().sync();
#endif
    }
}

extern "C" void kernel_launch(void* const* d_in, const int* in_sizes, int n_in, void* d_out, int out_size, void* d_ws, size_t ws_size, hipStream_t stream) {
    static int grid = 0;
    if (grid == 0) {
        if (n_in != 21 || out_size != TT * DM || ws_size < WS_END) { fprintf(stderr, "kernel_launch: unexpected shapes (n_in %d out %d ws %zu)\n", n_in, out_size, ws_size); grid = -1; return; }
        int dev = 0, cus = 0, per_cu = 0;
        if (hipGetDevice(&dev) != hipSuccess || hipDeviceGetAttribute(&cus, hipDeviceAttributeMultiprocessorCount, dev) != hipSuccess) { grid = -1; return; }
        if (hipFuncSetAttribute((const void*)fwd_kernel, hipFuncAttributeMaxDynamicSharedMemorySize, LDS_BYTES) != hipSuccess) { fprintf(stderr, "kernel_launch: hipFuncSetAttribute failed\n"); grid = -1; return; }
        if (hipOccupancyMaxActiveBlocksPerMultiprocessor(&per_cu, (const void*)fwd_kernel, NWAVES * 64, LDS_BYTES) != hipSuccess || per_cu < 1) { fprintf(stderr, "kernel_launch: occupancy query says %d\n", per_cu); (void)hipGetLastError(); per_cu = 1; }
        grid = cus;
        if (grid > 256) grid = 256;
    }
    if (grid < 0) return;
#if MK_BARRIER == 1
    if (hipMemsetAsync((char*)d_ws + WS_CTL, 0, CTL_ZERO_BYTES, stream) != hipSuccess) { fprintf(stderr, "kernel_launch: memset failed\n"); return; }
#endif
    Args a{};
    for (int i = 0; i < 21; ++i) a.in[i] = (const float*)d_in[i];
    a.out = (float*)d_out; a.ws = (unsigned char*)d_ws;
#if MK_N_LAUNCHES == 1
    a.ph_lo = 0; a.ph_hi = N_PHASES;
    void* kargs[] = {&a};
    hipError_t e = hipLaunchCooperativeKernel((const void*)fwd_kernel, dim3(grid), dim3(NWAVES * 64), kargs, LDS_BYTES, stream);
    if (e != hipSuccess) fprintf(stderr, "kernel_launch: cooperative launch failed: %s (grid %d)\n", hipGetErrorString(e), grid);
#else
    for (int ph = 0; ph < N_PHASES; ++ph) { a.ph_lo = ph; a.ph_hi = ph + 1;
        hipLaunchKernelGGL(fwd_kernel, dim3(grid), dim3(NWAVES * 64), LDS_BYTES, stream, a); }
#ifdef MK_DIAG
    a.ph_lo = MK_DIAG; a.ph_hi = MK_DIAG + 1; hipLaunchKernelGGL(fwd_kernel, dim3(grid), dim3(NWAVES * 64), LDS_BYTES, stream, a);
#endif
#endif
}
```
